# Optimizing an MI355X kernel written in HIP

```python
import math
import jax, jax.numpy as jnp
from jax import lax
import numpy as np

D_MODEL = 1024
BATCH = 2
SEQ = 8192
DEPTH = 1

EPS = 1e-6
DA_HEADS = 4
DA_HEAD_DIM = D_MODEL // 16
DA_V_DIM = 2 * DA_HEAD_DIM
DA_QK = DA_HEADS * 2 * DA_HEAD_DIM
DA_WIDTH = DA_HEADS * DA_V_DIM
Q_BLOCK = 128
GDN_HEADS = 4
GDN_HEAD_DIM = D_MODEL // 8
GDN_WIDTH = GDN_HEADS * GDN_HEAD_DIM
GDN_CONV = 4
GDN_CHUNK = 64
D_MIX = DA_WIDTH + GDN_WIDTH
SPLITS = [
    DA_QK,
    2 * DA_QK,
    2 * DA_QK + DA_WIDTH,
    2 * DA_QK + DA_WIDTH + GDN_WIDTH,
    2 * DA_QK + DA_WIDTH + 2 * GDN_WIDTH,
    2 * DA_QK + DA_WIDTH + 3 * GDN_WIDTH,
    2 * DA_QK + DA_WIDTH + 3 * GDN_WIDTH + GDN_HEADS,
    2 * DA_QK + DA_WIDTH + 3 * GDN_WIDTH + 2 * GDN_HEADS,
]
D_IN_PROJ = SPLITS[-1] + GDN_WIDTH
D_FF = ((8 * D_MODEL // 3 + 127) // 128) * 128
FFN_CONV = 3

kernel_name = "hybrid_diffattn_gdn_convffn"


def rms_norm(x, g):
    x32 = x.astype(jnp.float32)
    y = x32 * lax.rsqrt(jnp.mean(x32 * x32, axis=-1, keepdims=True) + EPS)
    return (y * g.astype(jnp.float32)).astype(x.dtype)


def l2_normalize(x):
    x32 = x.astype(jnp.float32)
    return x32 * lax.rsqrt(jnp.sum(x32 * x32, axis=-1, keepdims=True) + EPS)


def causal_depthwise_conv(x, w):
    K = w.shape[0]
    S = x.shape[1]
    xp = jnp.pad(x, ((0, 0), (K - 1, 0), (0, 0)))
    y = xp[:, 0:S] * w[0]
    for j in range(1, K):
        y = y + xp[:, j:j + S] * w[j]
    return y


def alibi_slopes(n_heads):
    return jnp.exp2(-8.0 * jnp.arange(1, n_heads + 1, dtype=jnp.float32) / n_heads)


def diff_attention(q, k, v, lam):
    B, S = q.shape[0], q.shape[1]
    nblk = S // Q_BLOCK
    qb = (q * DA_HEAD_DIM ** -0.5).reshape(B, nblk, Q_BLOCK, DA_HEADS, 2, DA_HEAD_DIM)
    qb = jnp.moveaxis(qb, 1, 0)
    slopes = alibi_slopes(DA_HEADS)
    key_pos = jnp.arange(S)

    def block(args):
        qi, idx = args
        q_pos = idx * Q_BLOCK + jnp.arange(Q_BLOCK)
        dist = q_pos[:, None] - key_pos[None, :]
        s = jnp.einsum('bqhcd,bkhcd->bhcqk', qi, k).astype(jnp.float32)
        s = s - slopes[None, :, None, None, None] * dist.astype(jnp.float32)
        s = jnp.where(dist >= 0, s, -jnp.inf)
        p = jax.nn.softmax(s, axis=-1)
        a = p[:, :, 0] - lam * p[:, :, 1]
        return jnp.einsum('bhqk,bkhd->bqhd', a.astype(v.dtype), v)

    out = lax.map(block, (qb, jnp.arange(nblk)))
    return jnp.moveaxis(out, 0, 1).reshape(B, S, DA_HEADS, DA_V_DIM)


def gated_delta_rule(q, k, v, g, beta):
    B, S, H, Dk = q.shape
    Dv = v.shape[-1]
    C = GDN_CHUNK
    N = S // C
    q = q * Dk ** -0.5

    def to_chunks(t):
        t = jnp.swapaxes(t, 1, 2)
        return t.reshape(B, H, N, C, *t.shape[3:])

    qc, kc, vc = to_chunks(q), to_chunks(k), to_chunks(v)
    gc = jnp.cumsum(to_chunks(g), axis=-1)
    bc = to_chunks(beta)
    tril = jnp.tril(jnp.ones((C, C), dtype=bool))
    strict = jnp.tril(jnp.ones((C, C), dtype=bool), -1)
    decay = jnp.exp(jnp.where(tril, gc[..., :, None] - gc[..., None, :], -jnp.inf))
    kb = kc * bc[..., None]
    vb = vc * bc[..., None]
    L = jnp.where(strict, jnp.einsum('bhnid,bhnjd->bhnij', kb, kc) * decay, 0.0)
    eye = jnp.eye(C, dtype=jnp.float32)
    T = lax.linalg.triangular_solve(eye + L, jnp.broadcast_to(eye, L.shape),
                                    left_side=True, lower=True, unit_diagonal=True)
    u = jnp.einsum('bhnij,bhnjd->bhnid', T, vb)
    w = jnp.einsum('bhnij,bhnjd->bhnid', T, kb * jnp.exp(gc)[..., None])
    qk = jnp.where(tril, jnp.einsum('bhnid,bhnjd->bhnij', qc, kc) * decay, 0.0)
    q_dec = qc * jnp.exp(gc)[..., None]
    k_dec = kc * jnp.exp(gc[..., -1:] - gc)[..., None]
    g_last = jnp.exp(gc[..., -1])

    def step(state, xs):
        qk_i, q_dec_i, k_dec_i, u_i, w_i, gl_i = xs
        v_new = u_i - jnp.einsum('bhck,bhkv->bhcv', w_i, state)
        o = jnp.einsum('bhck,bhkv->bhcv', q_dec_i, state) + jnp.einsum('bhij,bhjv->bhiv', qk_i, v_new)
        state = state * gl_i[..., None, None] + jnp.einsum('bhck,bhcv->bhkv', k_dec_i, v_new)
        return state, o

    xs = tuple(jnp.moveaxis(t, 2, 0) for t in (qk, q_dec, k_dec, u, w, g_last))
    state0 = jnp.zeros((B, H, Dk, Dv), dtype=jnp.float32)
    _, o = lax.scan(step, state0, xs)
    return jnp.transpose(o, (1, 0, 3, 2, 4)).reshape(B, S, H, Dv)


def setup_inputs(seed: int = 0) -> dict:
    key = jax.random.key(seed)
    ks = jax.random.split(key, 20)
    f32 = jnp.float32

    def nrm(k, shape, scale):
        return jax.random.normal(k, shape, dtype=f32) * scale

    def gain(k, n):
        return 1.0 + 0.02 * jax.random.normal(k, (DEPTH, n), dtype=f32)

    dt = jnp.exp(jax.random.uniform(ks[9], (DEPTH, GDN_HEADS), dtype=f32,
                                    minval=math.log(1e-3), maxval=math.log(1e-1)))
    return {
        "x": jax.random.normal(ks[0], (BATCH, SEQ, D_MODEL), dtype=f32),
        "attn_norm_g": gain(ks[1], D_MODEL),
        "w_in": nrm(ks[2], (DEPTH, D_MODEL, D_IN_PROJ), D_MODEL ** -0.5),
        "da_lambda_q1": nrm(ks[3], (DEPTH, DA_HEAD_DIM), 0.1),
        "da_lambda_k1": nrm(ks[4], (DEPTH, DA_HEAD_DIM), 0.1),
        "da_lambda_q2": nrm(ks[5], (DEPTH, DA_HEAD_DIM), 0.1),
        "da_lambda_k2": nrm(ks[6], (DEPTH, DA_HEAD_DIM), 0.1),
        "da_subln_g": gain(ks[7], DA_V_DIM),
        "gdn_conv_w": nrm(ks[8], (DEPTH, GDN_CONV, 3 * GDN_WIDTH), GDN_CONV ** -0.5),
        "gdn_a_log": jnp.log(jax.random.uniform(ks[10], (DEPTH, GDN_HEADS), dtype=f32, minval=1.0, maxval=16.0)),
        "gdn_dt_bias": dt + jnp.log(-jnp.expm1(-dt)),
        "gdn_norm_g": gain(ks[11], GDN_HEAD_DIM),
        "w_out": nrm(ks[12], (DEPTH, D_MIX, D_MODEL), D_MIX ** -0.5),
        "ffn_norm_g": gain(ks[13], D_MODEL),
        "w_up": nrm(ks[14], (DEPTH, D_MODEL, 2 * D_FF), D_MODEL ** -0.5),
        "ffn_conv_w": nrm(ks[15], (DEPTH, FFN_CONV, 2 * D_FF), FFN_CONV ** -0.5),
        "ffn_conv_b": nrm(ks[16], (DEPTH, 2 * D_FF), 0.02),
        "w_down": nrm(ks[17], (DEPTH, D_FF, D_MODEL), D_FF ** -0.5),
        "final_norm_g": 1.0 + 0.02 * jax.random.normal(ks[18], (D_MODEL,), dtype=f32),
    }


def reference(x, attn_norm_g, w_in, da_lambda_q1, da_lambda_k1, da_lambda_q2, da_lambda_k2,
              da_subln_g, gdn_conv_w, gdn_a_log, gdn_dt_bias, gdn_norm_g, w_out,
              ffn_norm_g, w_up, ffn_conv_w, ffn_conv_b, w_down, final_norm_g):
    B, S, _ = x.shape
    f32 = jnp.float32
    for l in range(DEPTH):
        lam_init = 0.8 - 0.6 * math.exp(-0.3 * l)
        h = rms_norm(x, attn_norm_g[l])
        proj = h @ w_in[l]
        dq, dk, dv, gq, gk, gv, ga, gb, gz = jnp.split(proj, SPLITS, axis=-1)

        lam = (jnp.exp(jnp.sum(da_lambda_q1[l].astype(f32) * da_lambda_k1[l].astype(f32)))
               - jnp.exp(jnp.sum(da_lambda_q2[l].astype(f32) * da_lambda_k2[l].astype(f32)))
               + lam_init)
        qa = dq.reshape(B, S, DA_HEADS, 2, DA_HEAD_DIM)
        ka = dk.reshape(B, S, DA_HEADS, 2, DA_HEAD_DIM)
        va = dv.reshape(B, S, DA_HEADS, DA_V_DIM)
        oa = diff_attention(qa, ka, va, lam)
        oa = (rms_norm(oa, da_subln_g[l]) * (1.0 - lam_init)).reshape(B, S, DA_WIDTH)

        qkv = jax.nn.silu(causal_depthwise_conv(jnp.concatenate([gq, gk, gv], axis=-1), gdn_conv_w[l]))
        qg, kg, vg = jnp.split(qkv, [GDN_WIDTH, 2 * GDN_WIDTH], axis=-1)
        qg = l2_normalize(qg.reshape(B, S, GDN_HEADS, GDN_HEAD_DIM))
        kg = l2_normalize(kg.reshape(B, S, GDN_HEADS, GDN_HEAD_DIM))
        vg = vg.reshape(B, S, GDN_HEADS, GDN_HEAD_DIM).astype(f32)
        beta = jax.nn.sigmoid(gb.astype(f32))
        g = -jnp.exp(gdn_a_log[l].astype(f32)) * jax.nn.softplus(ga.astype(f32) + gdn_dt_bias[l].astype(f32))
        og = gated_delta_rule(qg, kg, vg, g, beta).astype(x.dtype)
        z = gz.reshape(B, S, GDN_HEADS, GDN_HEAD_DIM)
        og = (rms_norm(og, gdn_norm_g[l]) * jax.nn.silu(z)).reshape(B, S, GDN_WIDTH)

        x = x + jnp.concatenate([oa, og], axis=-1) @ w_out[l]

        h = rms_norm(x, ffn_norm_g[l])
        up = causal_depthwise_conv(h @ w_up[l], ffn_conv_w[l]) + ffn_conv_b[l]
        gate, val = jnp.split(up, [D_FF], axis=-1)
        x = x + (jax.nn.silu(gate) * val) @ w_down[l]
    return rms_norm(x, final_norm_g)
```

```cpp
#include <hip/hip_runtime.h>
#include <cstdio>
#include <cstdint>
namespace pg8 {
#define PG8_LAS __attribute__((address_space(3)))
typedef unsigned short bf16_t;
typedef short bf16x8 __attribute__((ext_vector_type(8)));
typedef float f32x4 __attribute__((ext_vector_type(4)));
typedef unsigned u32x4 __attribute__((ext_vector_type(4)));
constexpr int BM = 256, BK = 64, HALF = 128, HTB = HALF * BK * 2  , STAGE_BYTES = 8 * HTB, NXCD = 8, WGM = 8;

__host__ __device__ __forceinline__ int lds_byte(int r, int c) { const int st = (r >> 4) * 2 + (c >> 5), rr = r & 15, cc = c & 31, ob = rr * 64 + cc * 2; return st * 1024 + (ob ^ (((ob >> 9) & 1) << 5)); }
__host__ __device__ __forceinline__ void stage_rc(int b, int& R, int& C) { const int st = b / 1024, sb = b % 1024, swz = sb ^ (((sb >> 9) & 1) << 5); R = (st >> 1) * 16 + swz / 64; C = (st & 1) * 32 + (swz % 64) / 2; }
__host__ __device__ __forceinline__ int perm32(int rho) { const int n = rho >> 4, i = rho & 15; return 8 * (i >> 2) + 4 * n + (i & 3); }

struct Unit { int pm, pn; };
struct Gemm { const bf16_t* A; const bf16_t* Bt; int M, N, K; };

struct StaticOrder {
    int nM, nN, nwg, G, c;
    __host__ __device__ void init(int M, int N, int G_, int c_) { nM = M / BM; nN = N / BM; nwg = nM * nN; G = G_; c = c_; }
    __host__ __device__ bool next(int i, Unit& u) const {
        const long L = (long)i * G + c; if (L >= nwg) return false;
        int wgid = (int)L; { const int q = nwg / NXCD, r = nwg % NXCD, xcd = wgid % NXCD, off = wgid / NXCD; wgid = (xcd < r ? xcd * (q + 1) : r * (q + 1) + (xcd - r) * q) + off; }
        const int nig = WGM * nN, gid = wgid / nig, fm = gid * WGM, gsz = (nM - fm) < WGM ? (nM - fm) : WGM;
        u.pm = fm + ((wgid % nig) % gsz); u.pn = (wgid % nig) / gsz; return true;
    }
    __device__ __forceinline__ void a_ready(const Unit&) const {}
    __device__ __forceinline__ void done(const Unit&) const {}
};

__device__ __forceinline__ unsigned cvt_pk_bf16(float lo, float hi) { unsigned r; asm volatile("v_cvt_pk_bf16_f32 %0, %1, %2" : "=v"(r) : "v"(lo), "v"(hi)); return r; }
typedef float f32x2 __attribute__((ext_vector_type(2)));
__device__ __forceinline__ f32x2 gelu_pk(f32x2 v) {
    const f32x2 av = __builtin_elementwise_abs(v), d = av * 0.2316418882f + 1.0f;
    f32x2 t; t.x = __builtin_amdgcn_rcpf(d.x); t.y = __builtin_amdgcn_rcpf(d.y);
    f32x2 q = t * 0.5307027145f + (-0.7265760135f); q = q * t + 0.7107068705f; q = q * t + (-0.142248368f); q = q * t + 0.127414796f; q = q * t;
    const f32x2 s = (v * v) * (-0.72134752044f);
    f32x2 e; e.x = __builtin_amdgcn_exp2f(s.x); e.y = __builtin_amdgcn_exp2f(s.y);
    const f32x2 m = v * (q * e), r = v - m;
    f32x2 o; o.x = v.x < 0.f ? m.x : r.x; o.y = v.y < 0.f ? m.y : r.y; return o;
}

template <int ACT  > struct EpiBf16 {
    static constexpr bool PERM = true, AFTER_DRAIN = false; static_assert(ACT == 0 || ACT == 1, "EpiBf16: ACT is 0 (none) or 1 (gelu_pk)");
    bf16_t* O; int ldc; const float* bias; int split_cols; size_t split_stride; float scale0;
    __device__ __forceinline__ void operator()(const f32x4 (&acc)[2][2][4][2], const Unit& u, int wr, int wc, int fr, int fq) const {
        const int row0 = u.pm * BM + wr * 64 + fr; int colt = u.pn * BM; bf16_t* base = O;
        float sc = 1.f; if (split_cols) { const int t = colt / split_cols; base += (size_t)t * split_stride; colt -= t * split_cols; if (t == 0) sc = scale0; }
        const int col0 = colt + wc * 32 + 8 * fq, bcol0 = u.pn * BM + wc * 32 + 8 * fq;
        f32x4 bv[2][2];
#pragma unroll
        for (int bj = 0; bj < 2; ++bj)
#pragma unroll
            for (int n = 0; n < 2; ++n) bv[bj][n] = bias ? *(const f32x4*)(bias + bcol0 + bj * HALF + 4 * n) : (f32x4){0.f, 0.f, 0.f, 0.f};
#pragma unroll
        for (int ai = 0; ai < 2; ++ai)
#pragma unroll
            for (int m = 0; m < 4; ++m) { bf16_t* rowp = base + (size_t)(row0 + ai * HALF + m * 16) * ldc + col0;
#pragma unroll
                for (int bj = 0; bj < 2; ++bj) { f32x4 v0 = acc[ai][bj][m][0] + bv[bj][0], v1 = acc[ai][bj][m][1] + bv[bj][1];
                    if (ACT == 1) { f32x2 a = gelu_pk((f32x2){v0[0], v0[1]}), b = gelu_pk((f32x2){v0[2], v0[3]}), c = gelu_pk((f32x2){v1[0], v1[1]}), d = gelu_pk((f32x2){v1[2], v1[3]});
                        v0 = (f32x4){a.x, a.y, b.x, b.y}; v1 = (f32x4){c.x, c.y, d.x, d.y}; }
                    v0 = v0 * sc; v1 = v1 * sc; u32x4 w; w.x = cvt_pk_bf16(v0[0], v0[1]); w.y = cvt_pk_bf16(v0[2], v0[3]); w.z = cvt_pk_bf16(v1[0], v1[1]); w.w = cvt_pk_bf16(v1[2], v1[3]);
                    *(u32x4*)(rowp + bj * HALF) = w; } }
    }
};

struct EpiProj {
    static constexpr bool PERM = true, AFTER_DRAIN = false;
    bf16_t* PA; bf16_t* PG; float scale0;
    __device__ __forceinline__ void operator()(const f32x4 (&acc)[2][2][4][2], const Unit& u, int wr, int wc, int fr, int fq) const {
        const int row0 = u.pm * BM + wr * 64 + fr;
        bf16_t* base; int ldc, colt;
        if (u.pn < 8) { base = PA; ldc = 2048; colt = u.pn * BM; } else { base = PG; ldc = 1536; colt = (u.pn - 8) * BM; }
        const float sc = (u.pn < 2) ? scale0 : 1.f;
        const int col0 = colt + wc * 32 + 8 * fq;
#pragma unroll
        for (int ai = 0; ai < 2; ++ai)
#pragma unroll
            for (int m = 0; m < 4; ++m) { bf16_t* rowp = base + (size_t)(row0 + ai * HALF + m * 16) * ldc + col0;
#pragma unroll
                for (int bj = 0; bj < 2; ++bj) { f32x4 v0 = acc[ai][bj][m][0] * sc, v1 = acc[ai][bj][m][1] * sc;
                    u32x4 w; w.x = cvt_pk_bf16(v0[0], v0[1]); w.y = cvt_pk_bf16(v0[2], v0[3]); w.z = cvt_pk_bf16(v1[0], v1[1]); w.w = cvt_pk_bf16(v1[2], v1[3]);
                    *(u32x4*)(rowp + bj * HALF) = w; } }
    }
};
struct EpiResF32 {
    static constexpr bool PERM = false, AFTER_DRAIN = false;
    const float* base; float* out; int ldc;
    __device__ __forceinline__ void operator()(const f32x4 (&acc)[2][2][4][2], const Unit& u, int wr, int wc, int fr, int fq) const {
        const int col0 = u.pn * BM + wc * 32 + 4 * fq;
#pragma unroll
        for (int ai = 0; ai < 2; ++ai)
#pragma unroll
            for (int m = 0; m < 4; ++m) { const size_t off = (size_t)(u.pm * BM + ai * HALF + wr * 64 + m * 16 + fr) * ldc + col0;
#pragma unroll
                for (int bj = 0; bj < 2; ++bj)
#pragma unroll
                    for (int n = 0; n < 2; ++n) { const f32x4 bs = *(const f32x4*)(base + off + bj * HALF + n * 16); *(f32x4*)(out + off + bj * HALF + n * 16) = bs + acc[ai][bj][m][n]; } }
    }
};
__device__ __forceinline__ float dpp_ror1(float v) { return __builtin_bit_cast(float, __builtin_amdgcn_update_dpp(0, __builtin_bit_cast(int, v), 0x121, 0xf, 0xf, false)); }
__device__ __forceinline__ float dpp_ror2(float v) { return __builtin_bit_cast(float, __builtin_amdgcn_update_dpp(0, __builtin_bit_cast(int, v), 0x122, 0xf, 0xf, false)); }
__device__ __forceinline__ float silu_f(float x) { return x * __builtin_amdgcn_rcpf(1.0f + __expf(-x)); }
struct EpiConvGLU {
    static constexpr bool PERM = true, AFTER_DRAIN = false;
    bf16_t* G; const float* cw; const float* cb; float* halo; PG8_LAS float* xh;
    __device__ __forceinline__ void operator()(const f32x4 (&acc)[2][2][4][2], const Unit& u, int wr, int wc, int fr, int fq) const {
        const int csb = wc * 32 + 8 * fq;
        if (fr >= 14) {
#pragma unroll
            for (int ai = 0; ai < 2; ++ai)
#pragma unroll
                for (int bj = 0; bj < 2; ++bj)
#pragma unroll
                    for (int n = 0; n < 2; ++n) *(PG8_LAS f32x4*)(xh + (((2 * ai + wr) * 2 + (fr - 14)) * 256 + bj * 128 + csb + 4 * n)) = acc[ai][bj][3][n];
        }
        if (wr == 0 && fr < 2) {
#pragma unroll
            for (int bj = 0; bj < 2; ++bj)
#pragma unroll
                for (int n = 0; n < 2; ++n) *(f32x4*)(halo + ((size_t)(u.pm * 4 + fr) * 5632 + u.pn * 256 + bj * 128 + csb + 4 * n)) = acc[0][bj][0][n];
        }
        if (wr == 1 && fr >= 14) {
#pragma unroll
            for (int bj = 0; bj < 2; ++bj)
#pragma unroll
                for (int n = 0; n < 2; ++n) *(f32x4*)(halo + ((size_t)(u.pm * 4 + 2 + (fr - 14)) * 5632 + u.pn * 256 + bj * 128 + csb + 4 * n)) = acc[1][bj][3][n];
        }
        asm volatile("s_waitcnt lgkmcnt(0)" ::: "memory"); __builtin_amdgcn_s_barrier(); asm volatile("" ::: "memory");
        const bool seqstart = (u.pm & 31) == 0;
#pragma unroll
        for (int n = 0; n < 2; ++n) {
            const int chg = u.pn * 128 + csb + 4 * n, chv = 2816 + chg;
            const f32x4 g0 = *(const f32x4*)(cw + chg), g1 = *(const f32x4*)(cw + 5632 + chg), g2 = *(const f32x4*)(cw + 2 * 5632 + chg), gb = *(const f32x4*)(cb + chg);
            const f32x4 v0 = *(const f32x4*)(cw + chv), v1 = *(const f32x4*)(cw + 5632 + chv), v2 = *(const f32x4*)(cw + 2 * 5632 + chv), vb = *(const f32x4*)(cb + chv);
#pragma unroll
            for (int ai = 0; ai < 2; ++ai) {
                const int g = 2 * ai + wr;
                f32x4 hg = (f32x4){0.f, 0.f, 0.f, 0.f}, hv = hg;
                if (g > 0) { hg = *(const PG8_LAS f32x4*)(xh + (((g - 1) * 2 + (fr & 1)) * 256 + csb + 4 * n)); hv = *(const PG8_LAS f32x4*)(xh + (((g - 1) * 2 + (fr & 1)) * 256 + 128 + csb + 4 * n)); }
#pragma unroll
                for (int m = 0; m < 4; ++m) {
                    const f32x4 pg = (m == 0) ? hg : acc[ai][0][m == 0 ? 0 : m - 1][n], pv = (m == 0) ? hv : acc[ai][1][m == 0 ? 0 : m - 1][n];
                    const f32x4 cg = acc[ai][0][m][n], cv = acc[ai][1][m][n];
                    float og[4];
#pragma unroll
                    for (int e = 0; e < 4; ++e) {
                        const float g_p1 = dpp_ror1(fr == 15 ? pg[e] : cg[e]), g_p2 = dpp_ror2(fr >= 14 ? pg[e] : cg[e]);
                        const float v_p1 = dpp_ror1(fr == 15 ? pv[e] : cv[e]), v_p2 = dpp_ror2(fr >= 14 ? pv[e] : cv[e]);
                        const float ug = g2[e] * cg[e] + g1[e] * g_p1 + g0[e] * g_p2 + gb[e];
                        const float uv = v2[e] * cv[e] + v1[e] * v_p1 + v0[e] * v_p2 + vb[e];
                        og[e] = silu_f(ug) * uv;
                    }
                    typedef unsigned u32x2v __attribute__((ext_vector_type(2)));
                    u32x2v w; w.x = cvt_pk_bf16(og[0], og[1]); w.y = cvt_pk_bf16(og[2], og[3]);
                    const bool skip = (g == 0) && (m == 0) && (fr < 2) && !seqstart;
                    if (!skip) *(u32x2v*)(G + (size_t)(u.pm * BM + ai * HALF + wr * 64 + m * 16 + fr) * 2816 + chg) = w;
                }
            }
        }
    }
};
template <class Epi, class Sched, bool ALIGN_EPI = false, bool SP2 = false>
__device__ __forceinline__ void gemm_phase(PG8_LAS unsigned char* lds, const Gemm g, const Sched& S, const Epi& E) {
    int tid_l = threadIdx.x; asm volatile("" : "+v"(tid_l));
    const int tid = tid_l, wid = __builtin_amdgcn_readfirstlane(tid >> 6), lane = tid & 63, wr = wid >> 2, wc = wid & 3, fr = lane & 15, fq = lane >> 4;
    const int K = g.K, nt = K / BK;
    unsigned voffA[2], voffB[2];
#pragma unroll
    for (int i = 0; i < 2; ++i) { int R, C; stage_rc(tid * 16 + i * 8192, R, C); const int Rb = Epi::PERM ? ((R & ~31) + perm32(R & 31)) : R;
        voffA[i] = (unsigned)(R * K + C) * 2u; voffB[i] = (unsigned)(Rb * K + C) * 2u; }
    const size_t kstep = (size_t)(BK * 2);
    const size_t hstep = (size_t)HALF * K * 2;
    const size_t tstep = 2 * hstep;
    const unsigned ldsw = (unsigned)wid * 1024u;
    const int aoff = lds_byte(wr * 64 + fr, fq * 8), boff = lds_byte(wc * 32 + fr, fq * 8);
#define PG8_SA(b, h) (((b) * 2 + (h)) * HTB)
#define PG8_SB(b, h) ((4 + (b) * 2 + (h)) * HTB)
#define PG8_STAGE(bufoff, gbase, voff) do { _Pragma("unroll") for (int _i = 0; _i < 2; ++_i) \
        __builtin_amdgcn_global_load_lds((const unsigned*)((const char*)(gbase) + (voff)[_i]), (PG8_LAS unsigned*)(lds + (bufoff) + ldsw + _i * 8192), 16, 0, 0); } while (0)
#define PG8_LDA(dst, b, h) do { _Pragma("unroll") for (int m = 0; m < 4; ++m) _Pragma("unroll") for (int k = 0; k < 2; ++k) dst[m][k] = *(const PG8_LAS bf16x8*)(lds + PG8_SA(b, h) + aoff + m * 2048 + k * 1024); } while (0)
#define PG8_LDB(dst, b, h) do { _Pragma("unroll") for (int n = 0; n < 2; ++n) _Pragma("unroll") for (int k = 0; k < 2; ++k) dst[n][k] = *(const PG8_LAS bf16x8*)(lds + PG8_SB(b, h) + boff + n * 2048 + k * 1024); } while (0)
#define PG8_MMA(ai, bj, At, Bt) do { __builtin_amdgcn_s_setprio(1); _Pragma("unroll") for (int m = 0; m < 4; ++m) _Pragma("unroll") for (int n = 0; n < 2; ++n) _Pragma("unroll") for (int k = 0; k < 2; ++k) \
        acc[ai][bj][m][n] = __builtin_amdgcn_mfma_f32_16x16x32_bf16(Bt[n][k], At[m][k], acc[ai][bj][m][n], 0, 0, 0); __builtin_amdgcn_s_setprio(0); } while (0)
#define PG8_WAIT_V(n) asm volatile("s_waitcnt vmcnt(" #n ")" ::: "memory")
#define PG8_WAIT_L(n) asm volatile("s_waitcnt lgkmcnt(" #n ")" ::: "memory")
#define PG8_BAR __builtin_amdgcn_s_barrier()
#define PG8_SCHED __builtin_amdgcn_sched_barrier(0)
    Unit cur, nxt; int ui = 0;
    if (!S.next(0, cur)) return;
    f32x4 acc[2][2][4][2];
#pragma unroll
    for (int a = 0; a < 2; ++a)
#pragma unroll
        for (int b = 0; b < 2; ++b)
#pragma unroll
            for (int m = 0; m < 4; ++m)
#pragma unroll
                for (int n = 0; n < 2; ++n) acc[a][b][m][n] = (f32x4){0.f, 0.f, 0.f, 0.f};
    bf16x8 At[4][2], B0[2][2], B1[2][2];
    const char* cA = (const char*)g.A + (size_t)cur.pm * tstep; const char* cB = (const char*)g.Bt + (size_t)cur.pn * tstep;
    S.a_ready(cur);
    if constexpr (SP2) {
        PG8_STAGE(PG8_SB(0, 0), cB, voffB); PG8_STAGE(PG8_SB(0, 1), cB + hstep, voffB); PG8_STAGE(PG8_SA(0, 0), cA, voffA); PG8_STAGE(PG8_SA(0, 1), cA + hstep, voffA);
        if (wr == 1) PG8_BAR;
        PG8_WAIT_V(2); PG8_BAR;
        PG8_STAGE(PG8_SB(1, 0), cB + kstep, voffB); PG8_STAGE(PG8_SA(1, 0), cA + kstep, voffA); PG8_STAGE(PG8_SB(1, 1), cB + hstep + kstep, voffB);
        PG8_WAIT_V(6); PG8_BAR;
    } else {
        PG8_STAGE(PG8_SB(0, 0), cB, voffB); PG8_STAGE(PG8_SA(0, 0), cA, voffA); PG8_STAGE(PG8_SB(0, 1), cB + hstep, voffB); PG8_STAGE(PG8_SA(0, 1), cA + hstep, voffA);
        if (wr == 1) PG8_BAR;
        PG8_WAIT_V(4); PG8_BAR;
        PG8_STAGE(PG8_SB(1, 0), cB + kstep, voffB); PG8_STAGE(PG8_SA(1, 0), cA + kstep, voffA); PG8_STAGE(PG8_SB(1, 1), cB + hstep + kstep, voffB);
        PG8_WAIT_V(6); PG8_BAR;
    }
    for (;;) {
        const bool has_next = S.next(ui + 1, nxt);
        const char* nA = has_next ? (const char*)g.A + (size_t)nxt.pm * tstep : cA; const char* nB = has_next ? (const char*)g.Bt + (size_t)nxt.pn * tstep : cB;
        for (int t = 0; t < nt; t += 2) {
            const bool last = (t == nt - 2);
            const char* a1 = cA + (size_t)(t + 1) * kstep;
            const char* a2 = last ? nA : cA + (size_t)(t + 2) * kstep; const char* b2 = last ? nB : cB + (size_t)(t + 2) * kstep;
            const char* a3 = a2 + kstep; const char* b3 = b2 + kstep;
            if (last && has_next) S.a_ready(nxt);
            if constexpr (SP2) {
            PG8_LDB(B0, 0, 0); PG8_LDB(B1, 0, 1); PG8_SCHED; PG8_LDA(At, 0, 0); PG8_STAGE(PG8_SA(1, 1), a1 + hstep, voffA);
            PG8_WAIT_V(8); PG8_WAIT_L(0); PG8_BAR; PG8_MMA(0, 0, At, B0); PG8_MMA(0, 1, At, B1); PG8_BAR; PG8_SCHED;
            PG8_LDA(At, 0, 1); PG8_STAGE(PG8_SB(0, 0), b2, voffB); PG8_STAGE(PG8_SB(0, 1), b2 + hstep, voffB); PG8_STAGE(PG8_SA(0, 0), a2, voffA);
            PG8_WAIT_V(8); PG8_WAIT_L(0); PG8_BAR; PG8_MMA(1, 0, At, B0); PG8_MMA(1, 1, At, B1); PG8_BAR; PG8_SCHED;
            PG8_LDB(B0, 1, 0); PG8_LDB(B1, 1, 1); PG8_SCHED; PG8_LDA(At, 1, 0); PG8_STAGE(PG8_SA(0, 1), a2 + hstep, voffA);
            PG8_WAIT_V(8); PG8_WAIT_L(0); PG8_BAR; PG8_MMA(0, 0, At, B0); PG8_MMA(0, 1, At, B1); PG8_BAR; PG8_SCHED;
            PG8_LDA(At, 1, 1); PG8_STAGE(PG8_SB(1, 0), b3, voffB); PG8_STAGE(PG8_SB(1, 1), b3 + hstep, voffB); PG8_STAGE(PG8_SA(1, 0), a3, voffA);
            PG8_WAIT_V(8); PG8_WAIT_L(0); PG8_BAR; PG8_MMA(1, 0, At, B0); PG8_MMA(1, 1, At, B1); PG8_BAR; PG8_SCHED;
            } else {
            PG8_LDB(B0, 0, 0); PG8_SCHED; PG8_LDA(At, 0, 0); PG8_STAGE(PG8_SA(1, 1), a1 + hstep, voffA);
            PG8_WAIT_L(8); PG8_BAR; PG8_WAIT_L(0); PG8_MMA(0, 0, At, B0); PG8_BAR; PG8_SCHED;
            PG8_LDB(B1, 0, 1); PG8_STAGE(PG8_SB(0, 0), b2, voffB);
            PG8_BAR; PG8_WAIT_L(0); PG8_MMA(0, 1, At, B1); PG8_BAR;
            PG8_LDA(At, 0, 1); PG8_STAGE(PG8_SA(0, 0), a2, voffA);
            PG8_BAR; PG8_WAIT_L(0); PG8_MMA(1, 0, At, B0); PG8_BAR; PG8_SCHED;
            PG8_STAGE(PG8_SB(0, 1), b2 + hstep, voffB);
            PG8_WAIT_V(6); PG8_BAR; PG8_MMA(1, 1, At, B1); PG8_BAR;
            PG8_LDB(B0, 1, 0); PG8_SCHED; PG8_LDA(At, 1, 0); PG8_STAGE(PG8_SA(0, 1), a2 + hstep, voffA);
            PG8_WAIT_L(8); PG8_BAR; PG8_WAIT_L(0); PG8_MMA(0, 0, At, B0); PG8_BAR; PG8_SCHED;
            PG8_LDB(B1, 1, 1); PG8_STAGE(PG8_SB(1, 0), b3, voffB);
            PG8_BAR; PG8_WAIT_L(0); PG8_MMA(0, 1, At, B1); PG8_BAR;
            PG8_LDA(At, 1, 1); PG8_STAGE(PG8_SA(1, 0), a3, voffA);
            PG8_BAR; PG8_WAIT_L(0); PG8_MMA(1, 0, At, B0); PG8_BAR; PG8_SCHED;
            PG8_STAGE(PG8_SB(1, 1), b3 + hstep, voffB);
            PG8_WAIT_V(6); PG8_BAR; PG8_MMA(1, 1, At, B1); PG8_BAR;
            }
        }
        if constexpr (ALIGN_EPI) { if (wr == 0) PG8_BAR; }
        if constexpr (!Epi::AFTER_DRAIN) { E(acc, cur, wr, wc, fr, fq); S.done(cur); }
        if (!has_next) break;
#pragma unroll
        for (int a = 0; a < 2; ++a)
#pragma unroll
            for (int b = 0; b < 2; ++b)
#pragma unroll
                for (int m = 0; m < 4; ++m)
#pragma unroll
                    for (int n = 0; n < 2; ++n) acc[a][b][m][n] = (f32x4){0.f, 0.f, 0.f, 0.f};
        cur = nxt; cA = nA; cB = nB; ++ui;
        if constexpr (ALIGN_EPI) { if (wr == 1) PG8_BAR; }
    }
    PG8_WAIT_V(0);
    if constexpr (!ALIGN_EPI) { if (wr == 0) PG8_BAR; }
    PG8_BAR;
    if constexpr (Epi::AFTER_DRAIN) { E.fused(acc, cur, wr, wc, fr, fq, lds, wid, lane); S.done(cur); }
#undef PG8_SA
#undef PG8_SB
#undef PG8_STAGE
#undef PG8_LDA
#undef PG8_LDB
#undef PG8_MMA
#undef PG8_WAIT_V
#undef PG8_WAIT_L
#undef PG8_BAR
#undef PG8_SCHED
}
}

#ifndef PG8_SP2
#define PG8_SP2 true
#endif
#ifndef PG8_ALIGN
#define PG8_ALIGN true
#endif
#include <hip/hip_bf16.h>
#include <cmath>
namespace attn_body {
using bf16=__hip_bfloat16;
using bf16x8=__attribute__((ext_vector_type(8)))short;
using s16x4=__attribute__((ext_vector_type(4)))short;
using f32x16=__attribute__((ext_vector_type(16)))float;
using u32x4=__attribute__((ext_vector_type(4)))unsigned;
constexpr int BATCH=2,NHEAD=16,SEQ=8192,D=64,DM=2048,OPITCH=1024;
constexpr int NW=8,QBLK=32,QB=QBLK*NW,KVBLK=64,NQB=SEQ/QB;
constexpr int ATTN_PITCH=DM, ATTN_UNIT_ROWS=QB;
__device__ __forceinline__ int crow(int r,int hi){return (r&3)+8*(r>>2)+4*hi;}
#define SBAR() __builtin_amdgcn_sched_barrier(0)
__device__ __forceinline__ void cmask(f32x16&p0,f32x16&p1,int jb,int qrel,int hi){
  const float NEG=-INFINITY; int kb=64*jb+4*hi;
  #pragma unroll
  for(int r=0;r<16;++r){int kv=kb+(r&3)+8*(r>>2); if(kv>qrel)p0[r]=NEG; if(kv+32>qrel)p1[r]=NEG;}
}

constexpr int NSLOT=3, SLOTB=8192;
constexpr int LDS_K=0, LDS_V=NSLOT*SLOTB, LDS_WS=2*NSLOT*SLOTB, LDS_OST=LDS_WS+NW*64*4, LDS_BYTES=LDS_OST+NW*4096;
constexpr float C2=0.125f*1.4426950408889634f;
__device__ __forceinline__ void glds16(const void*gsrc,unsigned lds_dst){unsigned keep;
  asm volatile("s_mov_b32 %0, m0\n\ts_mov_b32 m0, %2\n\ts_nop 0\n\tglobal_load_lds_dwordx4 %1, off\n\ts_mov_b32 m0, %0":"=&s"(keep):"v"(gsrc),"s"(lds_dst):"memory");}
__device__ __forceinline__ float max3f(float a,float b,float c){float r;asm("v_max3_f32 %0, %1, %2, %3":"=v"(r):"v"(a),"v"(b),"v"(c));return r;}
__device__ __forceinline__ float max2f(float a,float b){float r;asm("v_max_f32_e32 %0, %1, %2":"=v"(r):"v"(a),"v"(b));return r;}
__device__ __forceinline__ float fadd_s(float a,float b){float r;asm("v_add_f32_e32 %0, %1, %2":"=v"(r):"v"(a),"v"(b));return r;}
__device__ __forceinline__ float fsub_s(float a,float b){float r;asm("v_sub_f32_e32 %0, %1, %2":"=v"(r):"v"(a),"v"(b));return r;}
typedef float f32x2_t __attribute__((ext_vector_type(2))); typedef __bf16 bf16x2_t __attribute__((ext_vector_type(2)));
__device__ __forceinline__ unsigned cvtpk_s(float lo,float hi){f32x2_t v={lo,hi};bf16x2_t b=__builtin_convertvector(v,bf16x2_t);return __builtin_bit_cast(unsigned,b);}
typedef unsigned u32x2_t __attribute__((ext_vector_type(2)));
__device__ __forceinline__ unsigned bfb(float x){return cvtpk_s(x,0.f)&0xffffu;}
__device__ __forceinline__ float bff(unsigned b){return __uint_as_float(b<<16);}
#define MFMA8(a,b,c) __builtin_amdgcn_mfma_f32_32x32x8bf16_1k((a),(b),(c),0,0,0)
#define WAIT_BAR(N) asm volatile("s_waitcnt vmcnt(" #N ") lgkmcnt(0)\n\ts_barrier":::"memory")

__device__ __forceinline__ void qkt(f32x16&p0,f32x16&p1,const char*Kslot,const bf16x8*qr,const s16x4 kx0,const s16x4 kx1,const s16x4 qx,int r32,int hi){
  const f32x16 Z=f32x16{}; p0=MFMA8(kx0,qx,Z); p1=MFMA8(kx1,qx,Z);
  const char*kb=Kslot+hi*1024+r32*16;
  #pragma unroll
  for(int d0=0;d0<4;++d0){
    const bf16x8 b0=*reinterpret_cast<const bf16x8*>(kb+d0*2048);
    const bf16x8 b1=*reinterpret_cast<const bf16x8*>(kb+d0*2048+512);
    {p0=__builtin_amdgcn_mfma_f32_32x32x16_bf16(b0,qr[d0],p0,0,0,0);p1=__builtin_amdgcn_mfma_f32_32x32x16_bf16(b1,qr[d0],p1,0,0,0);}}
}
typedef __attribute__((address_space(3))) const char* lds_cptr;
typedef short v4i16_t __attribute__((ext_vector_type(4)));
__device__ __forceinline__ void kload8(bf16x8*kf,lds_cptr kp){
  kf[0]=*(const __attribute__((address_space(3))) bf16x8*)(kp);      kf[1]=*(const __attribute__((address_space(3))) bf16x8*)(kp+512);
  kf[2]=*(const __attribute__((address_space(3))) bf16x8*)(kp+2048); kf[3]=*(const __attribute__((address_space(3))) bf16x8*)(kp+2560);
  kf[4]=*(const __attribute__((address_space(3))) bf16x8*)(kp+4096); kf[5]=*(const __attribute__((address_space(3))) bf16x8*)(kp+4608);
  kf[6]=*(const __attribute__((address_space(3))) bf16x8*)(kp+6144); kf[7]=*(const __attribute__((address_space(3))) bf16x8*)(kp+6656);
}
__device__ __forceinline__ void kload2(bf16x8*kf,lds_cptr kp,int j){ kf[2*j]=*(const __attribute__((address_space(3))) bf16x8*)(kp+j*2048); kf[2*j+1]=*(const __attribute__((address_space(3))) bf16x8*)(kp+j*2048+512); }
__device__ __forceinline__ s16x4 vtr(lds_cptr p){ return __builtin_bit_cast(s16x4,__builtin_amdgcn_ds_read_tr16_b64_v4i16((__attribute__((address_space(3))) v4i16_t*)p)); }
__device__ __forceinline__ float rowmax(const f32x16&p0,const f32x16&p1){
  float a=max3f(p0[0],p0[1],p1[0]),b=max3f(p0[2],p0[3],p1[1]);a=max3f(a,p1[2],p1[3]);
  #pragma unroll
  for(int r=4;r<16;r+=4){a=max3f(a,p0[r],p0[r+1]);b=max3f(b,p0[r+2],p0[r+3]);a=max3f(a,p1[r],p1[r+1]);b=max3f(b,p1[r+2],p1[r+3]);}
  const float m=max2f(a,b);
  auto rr=__builtin_amdgcn_permlane32_swap(__float_as_uint(m),__float_as_uint(m),false,false);
  return max2f(__uint_as_float(rr[0]),__uint_as_float(rr[1]));
}
__device__ __forceinline__ void pv(f32x16*o,int vb,bf16x8 pa0,bf16x8 pa1,bf16x8 pa2,bf16x8 pa3){
  #pragma unroll
  for(int d0=0;d0<2;++d0){s16x4 lo[4],hi[4];
    #pragma unroll
    for(int ks=0;ks<4;++ks){
      asm volatile("ds_read_b64_tr_b16 %0,%1 offset:%c2":"=&v"(lo[ks]):"v"(vb),"i"(d0*4096+ks*1024):"memory");
      asm volatile("ds_read_b64_tr_b16 %0,%1 offset:%c2":"=&v"(hi[ks]):"v"(vb),"i"(d0*4096+ks*1024+512):"memory");}
    asm volatile("s_waitcnt lgkmcnt(0)":::"memory");SBAR();
    #define PK(k) (bf16x8){lo[k][0],lo[k][1],lo[k][2],lo[k][3],hi[k][0],hi[k][1],hi[k][2],hi[k][3]}
    o[d0]=__builtin_amdgcn_mfma_f32_32x32x16_bf16(pa0,PK(0),o[d0],0,0,0);
    o[d0]=__builtin_amdgcn_mfma_f32_32x32x16_bf16(pa1,PK(1),o[d0],0,0,0);
    o[d0]=__builtin_amdgcn_mfma_f32_32x32x16_bf16(pa2,PK(2),o[d0],0,0,0);
    o[d0]=__builtin_amdgcn_mfma_f32_32x32x16_bf16(pa3,PK(3),o[d0],0,0,0);
    #undef PK
  }
}

#ifndef ATTN_STORE16
#define ATTN_STORE16(p,v) (*(u32x4*)(p)=(v))
#endif
template<int THRL> __device__ __forceinline__ void attn_unit(int b,int h,int cm,int vh,int qb,const bf16*__restrict__ P,bf16*O,char*shm){
  const int tid=threadIdx.x,lane=tid&63,r32=lane&31,hi=lane>>5; const int wid=__builtin_amdgcn_readfirstlane(tid>>6);
  const long rowbase=(long)b*SEQ; const int q0=qb*QB;
  const bf16*Qw=P+(rowbase+q0+wid*QBLK)*DM+h*128+cm*64;
  const bf16*Kh=P+rowbase*DM+512+h*128+cm*64,*Vh=P+rowbase*DM+1024+h*128+vh*64;
  const unsigned lds0=(unsigned)(uintptr_t)shm;
  float*wsf=(float*)(shm+LDS_WS)+wid*64;
  const bf16*ksrc=Kh+(long)lane*DM+wid*8;
  const bf16*vsrc=Vh+(long)(16*(wid&3)+(lane>>2))*DM+(wid>>2)*32+(lane&3)*8;
  const unsigned kdst=lds0+LDS_K+wid*1024, vdst=lds0+LDS_V+wid*1024;
  #define DMA_K(t,slot) glds16(ksrc+(long)(t)*KVBLK*DM,(unsigned)__builtin_amdgcn_readfirstlane(kdst+(slot)))
  #define DMA_V(t,slot) glds16(vsrc+(long)(t)*KVBLK*DM,(unsigned)__builtin_amdgcn_readfirstlane(vdst+(slot)))
  const int vb0=(int)(lds0+LDS_V)+((lane>>4)&1)*32+(lane&3)*8+(4*hi+((lane&15)>>2))*64;
  const char*Kbase=shm+LDS_K; bf16x8 kf[8];
  const lds_cptr shm3=(lds_cptr)shm; const lds_cptr kp0=shm3+LDS_K+hi*1024+r32*16; const lds_cptr vp0=shm3+LDS_V+((lane>>4)&1)*32+(lane&3)*8+(4*hi+((lane&15)>>2))*64;
  const int NT=(q0+QB)/KVBLK;
  DMA_K(0,0);DMA_V(0,0);DMA_K(1,SLOTB);
  bf16x8 qr[4];
  #pragma unroll
  for(int d0=0;d0<4;++d0)qr[d0]=*reinterpret_cast<const bf16x8*>(&Qw[(long)r32*DM+d0*16+hi*8]);
  float mhat=0.f,l_reg=0.f;f32x16 o[2];o[0]=f32x16{};o[1]=f32x16{};
  s16x4 qx,kx0,kx1; unsigned jp0,jp1;
  { const float sl2=exp2f(-2.0f*(float)(h+1))*1.4426950408889634f; const unsigned s0=bfb(sl2); const float r1=sl2-bff(s0); const unsigned s1=bfb(r1); const float r2=r1-bff(s1); const unsigned s2=bfb(r2);
    const unsigned a0=s0|(s1<<16), a1=s2|(bfb(64.f*bff(s0))<<16), b0=bfb(64.f*bff(s1))|(bfb(64.f*bff(s2))<<16);
    u32x2_t qq; qq.x=hi?b0:a0; qq.y=hi?0u:a1; qx=__builtin_bit_cast(s16x4,qq);
    jp0=bfb((float)r32); jp1=bfb((float)(r32+32)); }
  #define KXSET(t) do{ const unsigned tb_=__float_as_uint((float)(t))>>16; u32x2_t k0_,k1_; \
    k0_.x=hi?(tb_|(tb_<<16)):(jp0|(jp0<<16)); k0_.y=hi?0x3f803f80u:(jp0|(tb_<<16)); k1_.x=hi?(tb_|(tb_<<16)):(jp1|(jp1<<16)); k1_.y=hi?0x3f803f80u:(jp1|(tb_<<16)); \
    kx0=__builtin_bit_cast(s16x4,k0_); kx1=__builtin_bit_cast(s16x4,k1_); }while(0)
  #define SETRHO(newr,eff) do{ const float nx_=-(newr); const unsigned nh_=bfb(nx_); const float nl_f=nx_-bff(nh_); const unsigned nl_=bfb(nl_f); eff=-(bff(nh_)+bff(nl_)); \
    if(hi){ u32x2_t q_=__builtin_bit_cast(u32x2_t,qx); q_.y=nh_|(nl_<<16); qx=__builtin_bit_cast(s16x4,q_); } }while(0)
  const int qrel=wid*QBLK+r32;
  #define CMASK(P0,P1,t) do{int jb_=(t)-(NT-4); if(jb_>=0)cmask(P0,P1,jb_,qrel,hi);}while(0)
  bool resc=false;
  #define START(P0,P1) do{ const float rm=rowmax(P0,P1); resc=false; \
    { float dl; SETRHO(rm,dl); mhat=dl; \
      _Pragma("unroll") for(int r=0;r<16;++r){P0[r]=fsub_s(P0[r],dl);P1[r]=fsub_s(P1[r],dl);} } \
    _Pragma("unroll") for(int r=0;r<16;++r)P0[r]=__builtin_amdgcn_exp2f(P0[r]); }while(0)
  #define RESC() do{ if(resc){ asm volatile("s_waitcnt lgkmcnt(0)":::"memory"); \
      _Pragma("unroll") for(int d_=0;d_<2;++d_) _Pragma("unroll") for(int r=0;r<16;++r)o[d_][r]*=wsf[crow(r,hi)]; } }while(0)
  f32x16 pA0,pA1,pB0,pB1;
  int sl_prev=0,sl_cur=0,sl_next=SLOTB;
  #define ROT() do{sl_prev=sl_cur;sl_cur=sl_next;sl_next=(sl_next==(NSLOT-1)*SLOTB)?0:sl_next+SLOTB;}while(0)
  DMA_K(2,2*SLOTB);
  WAIT_BAR(3);
  KXSET(0); qkt(pA0,pA1,Kbase,qr,kx0,kx1,qx,r32,hi);asm volatile("s_nop 15\n\ts_nop 7":"+v"(pA0),"+v"(pA1));CMASK(pA0,pA1,0);
  START(pA0,pA1);
  _Pragma("unroll") for(int r=0;r<16;++r)pA1[r]=__builtin_amdgcn_exp2f(pA1[r]);
  WAIT_BAR(0);
  DMA_K(3,0);DMA_V(1,SLOTB);
  ROT();
  kload8(kf,kp0+sl_cur);
  WAIT_BAR(2);
  s16x4 vlo[8],vhi[8]; u32x4 pw0,pw1,pw2,pw3;
  #define PKW(P,B) cvtpk_s(P[B],P[B+1])
  #define PAF(k) __builtin_bit_cast(bf16x8,pw##k)
  #define VFR(i) (bf16x8){vlo[i][0],vlo[i][1],vlo[i][2],vlo[i][3],vhi[i][0],vhi[i][1],vhi[i][2],vhi[i][3]}
  #define PIN(x) asm volatile("":"+v"(x))
  #define MX3(a,b,c) __builtin_fmaxf(__builtin_fmaxf((a),(b)),(c))
  #define GAPA(MF,A0,A1,A2,A3,W0,W1,PW) do{ MF; sacc+=A0; sacc+=A1; sacc+=A2; sacc+=A3; PIN(sacc); W0; W1; PIN(PW); SBAR(); }while(0)
  #define EX(v) __builtin_amdgcn_exp2f(v)
  #define GAPB(MF,X,B) do{ MF; X[B]=EX(X[B]); X[B+1]=EX(X[B+1]); X[B+2]=EX(X[B+2]); X[B+3]=EX(X[B+3]); PIN(X); SBAR(); }while(0)
  #define VRD(i) do{ vlo[i]=vtr(vp_+(((i)>>2)*4096+((i)&3)*1024)); vhi[i]=vtr(vp_+(((i)>>2)*4096+((i)&3)*1024+512)); }while(0)
  #define KRD(G,j) do{ if(G){ kload2(kf,kp0+sl_next,j); SBAR(); } }while(0)
  #define STEP(C0,C1,P0,P1,t,GK,GV,GL) do{ SBAR(); \
    const lds_cptr vp_=vp0+sl_prev; \
    KXSET(t); { const f32x16 Z_=f32x16{}; C0=MFMA8(kx0,qx,Z_); C1=MFMA8(kx1,qx,Z_); } SBAR(); \
    VRD(0); SBAR(); float sacc=(P0[0]+P0[1]); \
    GAPA(C0=__builtin_amdgcn_mfma_f32_32x32x16_bf16(kf[0],qr[0],C0,0,0,0), P0[2],P0[3],P0[4],P0[5],     pw0[0]=PKW(P0,0), pw0[1]=PKW(P0,2), pw0); \
    VRD(4); SBAR(); GAPA(C1=__builtin_amdgcn_mfma_f32_32x32x16_bf16(kf[1],qr[0],C1,0,0,0), P0[6],P0[7],P0[8],P0[9],     pw0[2]=PKW(P0,4), pw0[3]=PKW(P0,6), pw0); \
    VRD(1); SBAR(); GAPA(C0=__builtin_amdgcn_mfma_f32_32x32x16_bf16(kf[2],qr[1],C0,0,0,0),   P0[10],P0[11],P0[12],P0[13], pw1[0]=PKW(P0,8), pw1[1]=PKW(P0,10), pw1); \
    VRD(5); SBAR(); GAPA(C1=__builtin_amdgcn_mfma_f32_32x32x16_bf16(kf[3],qr[1],C1,0,0,0),   P0[14],P0[15],P1[0],P1[1],   pw1[2]=PKW(P0,12),pw1[3]=PKW(P0,14), pw1); \
    VRD(2); SBAR(); GAPA(C0=__builtin_amdgcn_mfma_f32_32x32x16_bf16(kf[4],qr[2],C0,0,0,0),   P1[2],P1[3],P1[4],P1[5],     pw2[0]=PKW(P1,0), pw2[1]=PKW(P1,2), pw2); \
    VRD(6); SBAR(); GAPA(C1=__builtin_amdgcn_mfma_f32_32x32x16_bf16(kf[5],qr[2],C1,0,0,0),   P1[6],P1[7],P1[8],P1[9],     pw2[2]=PKW(P1,4), pw2[3]=PKW(P1,6), pw2); \
    VRD(3); SBAR(); GAPA(C0=__builtin_amdgcn_mfma_f32_32x32x16_bf16(kf[6],qr[3],C0,0,0,0),   P1[10],P1[11],P1[12],P1[13], pw3[0]=PKW(P1,8), pw3[1]=PKW(P1,10), pw3); \
    VRD(7); SBAR(); GAPA(C1=__builtin_amdgcn_mfma_f32_32x32x16_bf16(kf[7],qr[3],C1,0,0,0),   P1[14],P1[15],0.f,0.f,       pw3[2]=PKW(P1,12),pw3[3]=PKW(P1,14), pw3); \
    l_reg+=sacc; \
    if(GK){DMA_K((t)+3,sl_cur);} if(GV){DMA_V((t)+1,sl_next);} \
    CMASK(C0,C1,t); \
    { float a=MX3(C0[0],C0[1],C1[0]),b=MX3(C0[2],C0[3],C1[1]); a=MX3(a,C1[2],C1[3]); \
      _Pragma("unroll") for(int r=4;r<16;r+=4){a=MX3(a,C0[r],C0[r+1]);b=MX3(b,C0[r+2],C0[r+3]);a=MX3(a,C1[r],C1[r+1]);b=MX3(b,C1[r+2],C1[r+3]);} \
      float rm=__builtin_fmaxf(a,b); { auto rr=__builtin_amdgcn_permlane32_swap(__float_as_uint(rm),__float_as_uint(rm),false,false); rm=__builtin_fmaxf(__uint_as_float(rr[0]),__uint_as_float(rr[1])); } \
      resc=false; \
      if(__builtin_expect(__any(rm>(float)THRL),0)){ const float nr_=mhat+__builtin_fmaxf(rm,0.f); float ne_; SETRHO(nr_,ne_); const float dl=ne_-mhat; mhat=ne_; \
        _Pragma("unroll") for(int r=0;r<16;++r){C0[r]-=dl;C1[r]-=dl;} \
        const float f=__builtin_amdgcn_exp2f(-dl); l_reg*=f; if(hi==0)wsf[r32]=f; resc=true; } } \
    SBAR(); \
    GAPB(o[0]=__builtin_amdgcn_mfma_f32_32x32x16_bf16(PAF(0),VFR(0),o[0],0,0,0), C0,0); \
    GAPB(o[1]=__builtin_amdgcn_mfma_f32_32x32x16_bf16(PAF(0),VFR(4),o[1],0,0,0), C0,4); \
    KRD(GL,0); GAPB(o[0]=__builtin_amdgcn_mfma_f32_32x32x16_bf16(PAF(1),VFR(1),o[0],0,0,0), C0,8); \
    KRD(GL,1); GAPB(o[1]=__builtin_amdgcn_mfma_f32_32x32x16_bf16(PAF(1),VFR(5),o[1],0,0,0), C0,12); \
    KRD(GL,2); GAPB(o[0]=__builtin_amdgcn_mfma_f32_32x32x16_bf16(PAF(2),VFR(2),o[0],0,0,0), C1,0); \
    KRD(GL,3); GAPB(o[1]=__builtin_amdgcn_mfma_f32_32x32x16_bf16(PAF(2),VFR(6),o[1],0,0,0), C1,4); \
    GAPB(o[0]=__builtin_amdgcn_mfma_f32_32x32x16_bf16(PAF(3),VFR(3),o[0],0,0,0), C1,8); \
    GAPB(o[1]=__builtin_amdgcn_mfma_f32_32x32x16_bf16(PAF(3),VFR(7),o[1],0,0,0), C1,12); \
    }while(0)
  int t=1;
  #undef CMASK
  #define CMASK(P0,P1,t) do{}while(0)
  for(;t+5<NT;t+=2){
    STEP(pB0,pB1,pA0,pA1,t,true,true,true);     WAIT_BAR(2); RESC(); ROT();
    STEP(pA0,pA1,pB0,pB1,t+1,true,true,true);   WAIT_BAR(2); RESC(); ROT();
  }
  #undef CMASK
  #define CMASK(P0,P1,t) do{int jb_=(t)-(NT-4); if(jb_>=0)cmask(P0,P1,jb_,qrel,hi);}while(0)
  #define ENDW(tt) do{ if((tt)+3<NT){WAIT_BAR(2);} else if((tt)+2<NT){WAIT_BAR(1);} else {WAIT_BAR(0);} }while(0)
  for(;t+1<NT;t+=2){
    STEP(pB0,pB1,pA0,pA1,t,(t+3<NT),(t+1<NT),(t+1<NT));       ENDW(t);   RESC(); ROT();
    STEP(pA0,pA1,pB0,pB1,t+1,(t+4<NT),(t+2<NT),(t+2<NT));     ENDW(t+1); RESC(); ROT();
  }
  STEP(pB0,pB1,pA0,pA1,NT-1,false,false,false); RESC();
  { float sacc=pB0[0]+pB0[1]; _Pragma("unroll") for(int r=2;r<16;++r)sacc+=pB0[r]; _Pragma("unroll") for(int r=0;r<16;++r)sacc+=pB1[r]; l_reg+=sacc;
    pw0=(u32x4){PKW(pB0,0),PKW(pB0,2),PKW(pB0,4),PKW(pB0,6)};pw1=(u32x4){PKW(pB0,8),PKW(pB0,10),PKW(pB0,12),PKW(pB0,14)};pw2=(u32x4){PKW(pB1,0),PKW(pB1,2),PKW(pB1,4),PKW(pB1,6)};pw3=(u32x4){PKW(pB1,8),PKW(pB1,10),PKW(pB1,12),PKW(pB1,14)};
    SBAR(); pv(o,vb0+sl_cur,PAF(0),PAF(1),PAF(2),PAF(3)); }
  #undef PKW
  #undef PAF
  #undef VFR
  #undef PIN
  #undef MX3
  #undef GAPA
  #undef GAPB
  #undef EX
  #undef VRD
  #undef KRD
  #undef STEP
  #undef ENDW
  {auto rr=__builtin_amdgcn_permlane32_swap(__float_as_uint(l_reg),__float_as_uint(l_reg),false,false);l_reg=__uint_as_float(rr[0])+__uint_as_float(rr[1]);}
  if(hi==0)wsf[32+r32]=l_reg;asm volatile("s_waitcnt lgkmcnt(0)":::"memory");
  float rli[16];
  #pragma unroll
  for(int r=0;r<16;++r)rli[r]=__builtin_amdgcn_rcpf(wsf[32+crow(r,hi)]);
  bf16*Ow=O+(rowbase+q0+wid*QBLK)*OPITCH+cm*512+h*128+vh*64;
  { bf16*stg=(bf16*)(shm+LDS_OST)+wid*2048;
    #pragma unroll
    for(int r=0;r<16;++r){const int orow=crow(r,hi);
      #pragma unroll
      for(int d0=0;d0<2;++d0)stg[orow*64+d0*32+r32]=__float2bfloat16(o[d0][r]*rli[r]);}
    asm volatile("s_waitcnt lgkmcnt(0)":::"memory");
    #pragma unroll
    for(int i=0;i<4;++i){const int row=i*8+(lane>>3),ch=lane&7; const u32x4 v=*(const u32x4*)(stg+row*64+ch*8); ATTN_STORE16(Ow+(long)row*OPITCH+ch*8,v);} }
  asm volatile("s_waitcnt lgkmcnt(0)\n\ts_barrier":::"memory");
  #undef DMA_K
  #undef DMA_V
  #undef KXSET
  #undef SETRHO
  #undef CMASK
  #undef START
  #undef RESC
  #undef ROT
}
constexpr int ATTN_LDS_BYTES=LDS_BYTES;
#undef SBAR
#undef WAIT_BAR
}
#define GAS __attribute__((address_space(1)))
#define LAS __attribute__((address_space(3)))
typedef unsigned short bf16;
typedef unsigned v4u __attribute__((ext_vector_type(4)));
typedef float f32x4 __attribute__((ext_vector_type(4)));
typedef short bf16x8 __attribute__((ext_vector_type(8)));
typedef GAS unsigned gu32;
typedef GAS unsigned long long gu64;
#define RLX_AGENT __ATOMIC_RELAXED, __HIP_MEMORY_SCOPE_AGENT
#define LDS_WAIT() asm volatile("s_waitcnt lgkmcnt(0)" ::: "memory")
#define VM_WAIT() asm volatile("s_waitcnt vmcnt(0)" ::: "memory")
__device__ __forceinline__ unsigned long long rt() { return __builtin_amdgcn_s_memrealtime(); }
__device__ __forceinline__ unsigned f2bf(float f) { unsigned u = __builtin_bit_cast(unsigned, f); return (u + 0x7fffu + ((u >> 16) & 1u)) >> 16; }
__device__ __forceinline__ unsigned pk2(float lo, float hi) { return f2bf(lo) | (f2bf(hi) << 16); }

#define XB_TMO      128
#define XB_XCNT(j)  (256  + 64 * (j))
#define XB_XSUB(j)  (1280 + 64 * (j))
#define XB_XGEN(j)  (2304 + 64 * (j))
#define XB_TOP      3328
#define XB_TOPGEN   3392
#define XCD_BAR_WORDS 3456
#define XB_SPIN_CAP (1u << 18)

__device__ __forceinline__ unsigned xb_ld(unsigned* p)              { return __hip_atomic_load(p, __ATOMIC_RELAXED, __HIP_MEMORY_SCOPE_AGENT); }
__device__ __forceinline__ unsigned xb_add(unsigned* p, unsigned v) { return __hip_atomic_fetch_add(p, v, __ATOMIC_RELAXED, __HIP_MEMORY_SCOPE_AGENT); }
__device__ __forceinline__ unsigned xb_xcc_id() { return (unsigned)__builtin_amdgcn_s_getreg((3 << 11) | 20) & 0xFu; }
#define XB_SPIN(cond, bar) do { unsigned _sp = 0; while (cond) { __builtin_amdgcn_s_sleep(1); \
    if ((++_sp & 255u) == 0u) { if (xb_ld(&(bar)[XB_TMO])) break; if (_sp > XB_SPIN_CAP) { atomicAdd(&(bar)[XB_TMO], 1u); break; } } } } while (0)

struct XcdBarrier {
    unsigned* bar; unsigned x;
    volatile LAS unsigned* st;
};

__device__ __forceinline__ XcdBarrier xcd_barrier_post(unsigned* bar, volatile LAS unsigned* st) {
    XcdBarrier b; b.bar = bar; b.x = xb_xcc_id(); b.st = st;
    if (threadIdx.x == 0) (void)xb_add(&bar[XB_XCNT(b.x)], 1u);
    return b;
}
__device__ __forceinline__ void xcd_barrier_complete(unsigned* bar, unsigned x, unsigned& nloc, unsigned& nx) {
    const unsigned G = gridDim.x * gridDim.y * gridDim.z;
    unsigned sum, cnt, mine, sp = 0u;
    for (;;) {
        sum = 0u; cnt = 0u; mine = 0u;
#pragma unroll
        for (unsigned j = 0; j < 16; ++j) { const unsigned c = xb_ld(&bar[XB_XCNT(j)]); sum += c; cnt += (c > 0u) ? 1u : 0u; mine = (j == x) ? c : mine; }
        if (sum == G) break;
        __builtin_amdgcn_s_sleep(1);
        if ((++sp & 255u) == 0u) { if (xb_ld(&bar[XB_TMO])) break; if (sp > XB_SPIN_CAP) { atomicAdd(&bar[XB_TMO], 1u); break; } }
    }
    nloc = mine > 0u ? mine : 1u; nx = cnt > 0u ? cnt : 1u;
}

__device__ __forceinline__ void xcd_barrier(const XcdBarrier& b) {
    asm volatile("s_waitcnt vmcnt(0)" ::: "memory");
    __syncthreads();
    if (threadIdx.x == 0) {
        unsigned* bar = b.bar;
        __builtin_amdgcn_s_waitcnt(0);
        unsigned nloc = b.st[0], nx = b.st[1];
        if (nloc == 0u) { xcd_barrier_complete(bar, b.x, nloc, nx); b.st[0] = nloc; b.st[1] = nx; }
        const unsigned old = xb_add(&bar[XB_XSUB(b.x)], 1u);
        const unsigned gen = old / nloc;
        if (old + 1u == (gen + 1u) * nloc) {
            __builtin_amdgcn_fence(__ATOMIC_RELEASE, "agent");
            asm volatile("s_waitcnt vmcnt(0)" ::: "memory");
            const unsigned og = xb_add(&bar[XB_TOP], 1u);
            const unsigned tg = og / nx;
            if (og + 1u == (tg + 1u) * nx) xb_add(&bar[XB_TOPGEN], 1u);
            else XB_SPIN(xb_ld(&bar[XB_TOPGEN]) == tg, bar);
            __builtin_amdgcn_fence(__ATOMIC_ACQUIRE, "agent");
            xb_add(&bar[XB_XGEN(b.x)], 1u);
            asm volatile("s_waitcnt vmcnt(0)" ::: "memory");
        } else {
            XB_SPIN(xb_ld(&bar[XB_XGEN(b.x)]) == gen, bar);
            __builtin_amdgcn_fence(__ATOMIC_ACQUIRE, "agent");
            asm volatile("s_waitcnt vmcnt(0)" ::: "memory");
        }
    }
    __syncthreads();
}

#include <hip/hip_cooperative_groups.h>
namespace cg = cooperative_groups;
constexpr int NWAVES = 8;
constexpr int SEQ = 8192, D = 1024, M = 16384, DFF = 2816, NUP = 5632, NINP = 3592, NPROJ = 3584;
constexpr float EPS = 1e-6f;
constexpr size_t MiB = 1u << 20;
constexpr size_t WS_CTL = 0, CTL_ZERO_BYTES = 1 * MiB;
constexpr size_t WS_WIN = 2 * MiB, WS_WO = 9 * MiB, WS_WUP = 11 * MiB, WS_WDN = 22 * MiB, WS_GAB = 28 * MiB, WS_HALO = 29 * MiB, WS_GL = 35 * MiB;
constexpr size_t WS_XN = 36 * MiB;
constexpr size_t WS_PREP = 36 * MiB;
constexpr size_t WS_G = 68 * MiB;
constexpr size_t WS_PA = 124 * MiB;
constexpr size_t WS_PG = 188 * MiB;
constexpr size_t WS_OATT = 188 * MiB;
constexpr size_t WS_OG = 220 * MiB;
constexpr size_t WS_X1 = 188 * MiB;
constexpr size_t WS_END = 252 * MiB;
constexpr int CW_QUEUE = 64;
constexpr int CW_BAR = 4096;
constexpr int PREP_STRIDE = 90112, PO_W = 0, PO_QD = 16384, PO_KDT = 32768, PO_QK = 49152, PO_U = 57344;
constexpr int RING_BYTES = 131072, XH_OFF = RING_BYTES, MISC_OFF = XH_OFF + 8192, LDS_BYTES = 147456;

struct Frame {
    LAS unsigned char* lds; volatile LAS unsigned* MISC;
    int vcu, G;
};
__device__ __forceinline__ float wave_sum(float v) {
#pragma unroll
    for (int o = 1; o < 64; o <<= 1) v += __shfl_xor(v, o);
    return v;
}
__device__ __forceinline__ float bf2f(unsigned short b) { return __uint_as_float(((unsigned)b) << 16); }
typedef float f32x2m_t __attribute__((ext_vector_type(2))); typedef __bf16 bf16x2m_t __attribute__((ext_vector_type(2)));
__device__ __forceinline__ unsigned cvtpk(float lo, float hi) { f32x2m_t v = {lo, hi}; bf16x2m_t b = __builtin_convertvector(v, bf16x2m_t); return __builtin_bit_cast(unsigned, b); }

__device__ __forceinline__ void p0_transpose_item(const float* W, int pitch, int col0, int k0, bf16* WT, int n0, int K, LAS float* scr, int lane) {
#pragma unroll 8
    for (int i = 0; i < 32; ++i) { const int kk = 2 * i + (lane >> 5); scr[kk * 33 + (lane & 31)] = W[(size_t)(k0 + kk) * pitch + col0 + (lane & 31)]; }
    LDS_WAIT(); asm volatile("" ::: "memory");
    const int c = lane & 7;
#pragma unroll
    for (int j = 0; j < 4; ++j) { const int n = (lane >> 3) + 8 * j; const LAS float* s = scr + (8 * c) * 33 + n;
        v4u o; o.x = pk2(s[0 * 33], s[1 * 33]); o.y = pk2(s[2 * 33], s[3 * 33]); o.z = pk2(s[4 * 33], s[5 * 33]); o.w = pk2(s[6 * 33], s[7 * 33]);
        *(GAS v4u*)(WT + (size_t)(n0 + n) * K + k0 + 8 * c) = o; }
    LDS_WAIT(); asm volatile("" ::: "memory");
}
__device__ __forceinline__ void rms_row(const float* xrow, const float* gain, int lane, f32x4 (&v)[4]) {
    const GAS f32x4* xr = (const GAS f32x4*)xrow + lane; const GAS f32x4* gr = (const GAS f32x4*)gain + lane;
    float s = 0.f;
#pragma unroll
    for (int j = 0; j < 4; ++j) { v[j] = xr[64 * j]; s += (v[j].x * v[j].x + v[j].y * v[j].y) + (v[j].z * v[j].z + v[j].w * v[j].w); }
    const float r = 1.0f / sqrtf(wave_sum(s) * (1.f / D) + EPS);
#pragma unroll
    for (int j = 0; j < 4; ++j) { const f32x4 g = gr[64 * j]; v[j] = v[j] * r * g; }
}
__device__ __forceinline__ void store_row_bf16(bf16* orow, int lane, const f32x4 (&v)[4]) {
    GAS unsigned long long* o8 = (GAS unsigned long long*)orow + lane;
#pragma unroll
    for (int j = 0; j < 4; ++j) o8[64 * j] = (unsigned long long)cvtpk(v[j].x, v[j].y) | ((unsigned long long)cvtpk(v[j].z, v[j].w) << 32);
}

namespace gdn {
typedef float f32x16 __attribute__((ext_vector_type(16)));
constexpr int KP = 136, L_KBF = 0, L_KBB = 17408, L_QBF = 34816, L_KDEC = 52224, L_R = 69632, RP = 132, L_LM = 103424, LP = 68, L_GC = 120832, L_BETA = 121088;
__device__ __forceinline__ int crow(int r, int hi) { return (r & 3) + 8 * (r >> 2) + 4 * hi; }
#define GDN_BAR() asm volatile("s_waitcnt lgkmcnt(0)\n\ts_barrier" ::: "memory")
__device__ __forceinline__ void prep_chunk(LAS unsigned char* lds, int tid, int chunk, const bf16* PG, const float* GAB, const float* convw, const float* a_log, const float* dt_bias,
                                           unsigned char* prep, float* GL) {
    const int lane = tid & 63, wid = __builtin_amdgcn_readfirstlane(tid >> 6);
    const int bh = chunk >> 7, n = chunk & 127, b = bh >> 2, h = bh & 3; const int row0 = b * SEQ + n * 64;
    LAS float* gcs = (LAS float*)(lds + L_GC); LAS float* betas = (LAS float*)(lds + L_BETA);
    unsigned char* cb = prep + (size_t)chunk * PREP_STRIDE;
    if (wid == 0) {
        const float ga = GAB[(size_t)(row0 + lane) * 8 + h], gb = GAB[(size_t)(row0 + lane) * 8 + 4 + h];
        const float xs = ga + dt_bias[h]; const float sp = xs > 20.f ? xs : log1pf(__expf(xs));
        float g = -__expf(a_log[h]) * sp;
#pragma unroll
        for (int o = 1; o < 64; o <<= 1) { const float t = __shfl_up(g, o); if (lane >= o) g += t; }
        gcs[lane] = g; betas[lane] = 1.0f / (1.0f + __expf(-gb));
        if (lane == 63) GL[chunk] = __expf(g);
    }
    GDN_BAR();
    const float gc_last = gcs[63];
    {
        const int sub = tid & 15, pl = tid >> 4;
#pragma unroll
        for (int tensor = 0; tensor < 3; ++tensor) {
            const int col = tensor * 512 + h * 128 + sub * 8;
            f32x4 wv[4][2];
#pragma unroll
            for (int j = 0; j < 4; ++j) { wv[j][0] = *(const f32x4*)(convw + j * 1536 + col); wv[j][1] = *(const f32x4*)(convw + j * 1536 + col + 4); }
#pragma unroll
            for (int ph = 0; ph < 2; ++ph) {
                const int p = ph * 32 + pl;
                float y[8];
#pragma unroll
                for (int e = 0; e < 8; ++e) y[e] = 0.f;
#pragma unroll
                for (int j = 0; j < 4; ++j) {
                    const int pr = p - 3 + j;
                    v4u raw = (v4u){0u, 0u, 0u, 0u};
                    if (n > 0 || pr >= 0) raw = *(const GAS v4u*)(PG + (size_t)(row0 + pr) * 1536 + col);
#pragma unroll
                    for (int q = 0; q < 4; ++q) { y[2 * q] += wv[j][q >> 1][(2 * q) & 3] * __uint_as_float(raw[q] << 16); y[2 * q + 1] += wv[j][q >> 1][(2 * q + 1) & 3] * __uint_as_float(raw[q] & 0xffff0000u); }
                }
                float ss = 0.f;
#pragma unroll
                for (int e = 0; e < 8; ++e) { y[e] = pg8::silu_f(y[e]); ss += y[e] * y[e]; }
                const float gcp = gcs[p], bp = betas[p];
                if (tensor < 2) {
                    ss += __shfl_xor(ss, 1); ss += __shfl_xor(ss, 2); ss += __shfl_xor(ss, 4); ss += __shfl_xor(ss, 8);
                    float rn = 1.0f / sqrtf(ss + EPS); if (tensor == 0) rn *= 0.08838834764831845f;
#pragma unroll
                    for (int e = 0; e < 8; ++e) y[e] *= rn;
                    v4u o; o.x = cvtpk(y[0], y[1]); o.y = cvtpk(y[2], y[3]); o.z = cvtpk(y[4], y[5]); o.w = cvtpk(y[6], y[7]);
                    if (tensor == 0) {
                        *(LAS v4u*)(lds + L_QBF + (p * KP + sub * 8) * 2) = o;
                        const float eg = __expf(gcp); v4u d; d.x = cvtpk(y[0] * eg, y[1] * eg); d.y = cvtpk(y[2] * eg, y[3] * eg); d.z = cvtpk(y[4] * eg, y[5] * eg); d.w = cvtpk(y[6] * eg, y[7] * eg);
                        *(GAS v4u*)(cb + PO_QD + (p * 128 + sub * 8) * 2) = d;
                    } else {
                        *(LAS v4u*)(lds + L_KBF + (p * KP + sub * 8) * 2) = o;
                        v4u kb; kb.x = cvtpk(y[0] * bp, y[1] * bp); kb.y = cvtpk(y[2] * bp, y[3] * bp); kb.z = cvtpk(y[4] * bp, y[5] * bp); kb.w = cvtpk(y[6] * bp, y[7] * bp);
                        *(LAS v4u*)(lds + L_KBB + (p * KP + sub * 8) * 2) = kb;
                        const float ed = __expf(gc_last - gcp); v4u kd; kd.x = cvtpk(y[0] * ed, y[1] * ed); kd.y = cvtpk(y[2] * ed, y[3] * ed); kd.z = cvtpk(y[4] * ed, y[5] * ed); kd.w = cvtpk(y[6] * ed, y[7] * ed);
                        *(LAS v4u*)(lds + L_KDEC + (p * KP + sub * 8) * 2) = kd;
                    }
                } else {
                    LAS float* R = (LAS float*)(lds + L_R) + p * RP + sub * 8;
                    *(LAS f32x4*)R = (f32x4){y[0] * bp, y[1] * bp, y[2] * bp, y[3] * bp}; *(LAS f32x4*)(R + 4) = (f32x4){y[4] * bp, y[5] * bp, y[6] * bp, y[7] * bp};
                }
            }
        }
    }
    GDN_BAR();
    {
        const int isqk = wid >> 2, tile = wid & 3, ti = tile >> 1, tj = tile & 1, r32 = lane & 31, hi = lane >> 5;
        bf16* qkg = (bf16*)(cb + PO_QK);
        if (!(ti == 0 && tj == 1)) {
            f32x16 acc = f32x16{};
            const LAS unsigned char* ap = lds + (isqk ? L_QBF : L_KBB) + ((32 * ti + r32) * KP + hi * 8) * 2;
            const LAS unsigned char* bp = lds + L_KBF + ((32 * tj + r32) * KP + hi * 8) * 2;
#pragma unroll
            for (int ks = 0; ks < 8; ++ks) acc = __builtin_amdgcn_mfma_f32_32x32x16_bf16(*(const LAS bf16x8*)(ap + ks * 32), *(const LAS bf16x8*)(bp + ks * 32), acc, 0, 0, 0);
            const int j = 32 * tj + r32; const float gcj = gcs[j];
#pragma unroll
            for (int r = 0; r < 16; ++r) {
                const int i = 32 * ti + crow(r, hi);
                const bool keep = isqk ? (j <= i) : (j < i);
                const float val = keep ? acc[r] * __expf(gcs[i] - gcj) : 0.f;
                if (isqk) qkg[i * 64 + j] = (bf16)f2bf(val); else ((LAS float*)(lds + L_LM))[i * LP + j] = val;
            }
        } else if (isqk) {
#pragma unroll
            for (int r = 0; r < 16; ++r) qkg[crow(r, hi) * 64 + 32 + r32] = 0;
        }
    }
    GDN_BAR();
    if (wid < 4) {
        const int c = tid; float x[64];
        int z_; asm volatile("v_mov_b32 %0, 0" : "=v"(z_));
        const LAS float* Lm = (const LAS float*)(lds + L_LM) + z_; const LAS float* gcv = gcs + z_;
        if (c < 128) {
#pragma unroll
            for (int p = 0; p < 64; ++p) x[p] = ((const LAS float*)(lds + L_R))[p * RP + c];
        } else {
#pragma unroll
            for (int p = 0; p < 64; ++p) x[p] = bf2f(((const LAS bf16*)(lds + L_KBB))[p * KP + (c - 128)]) * __expf(gcv[p]);
        }
#pragma unroll
        for (int i = 1; i < 64; ++i) {
            float a = x[i];
#pragma unroll
            for (int jj = 0; jj < (i + 3) / 4; ++jj) { const f32x4 l = *(const LAS f32x4*)(Lm + i * LP + 4 * jj);
#pragma unroll
                for (int e = 0; e < 4; ++e) if (4 * jj + e < i) a -= l[e] * x[4 * jj + e]; }
            x[i] = a;
        }
        if (c < 128) {
            float* ug = (float*)(cb + PO_U);
#pragma unroll
            for (int p = 0; p < 64; ++p) ug[p * 128 + c] = x[p];
        } else {
            bf16* wg = (bf16*)(cb + PO_W);
#pragma unroll
            for (int p = 0; p < 64; ++p) wg[p * 128 + (c - 128)] = (bf16)f2bf(x[p]);
        }
    } else {
        const int t2 = tid - 256;
#pragma unroll
        for (int it = 0; it < 2; ++it) {
            const int item = t2 + 256 * it, dk = item & 127, pgp = item >> 7;
            const LAS bf16* src = (const LAS bf16*)(lds + L_KDEC) + (16 * pgp) * KP + dk;
            unsigned w[8];
#pragma unroll
            for (int q = 0; q < 8; ++q) w[q] = (unsigned)src[(2 * q) * KP] | ((unsigned)src[(2 * q + 1) * KP] << 16);
            GAS v4u* dst = (GAS v4u*)(cb + PO_KDT + (dk * 64 + 16 * pgp) * 2);
            dst[0] = (v4u){w[0], w[1], w[2], w[3]}; dst[1] = (v4u){w[4], w[5], w[6], w[7]};
        }
    }
    GDN_BAR();
}

__device__ __forceinline__ void scan(LAS unsigned char* lds, int tid, int bh, int s, const unsigned char* prep, const float* GL, bf16* OG) {
    const int lane = tid & 63, wid = __builtin_amdgcn_readfirstlane(tid >> 6), r32 = lane & 31, hi = lane >> 5;
    const int b = bh >> 2, h = bh & 3;
    constexpr int SP = 136, VP = 72, L_ST = 0, L_VN = 32 * SP * 2;
    for (int i = tid; i < (32 * SP * 2 + 32 * VP * 2) / 4; i += 512) ((LAS unsigned*)lds)[i] = 0u;
    f32x16 Sacc = f32x16{};
    const int role = wid < 2 ? 0 : (wid < 4 ? 1 : 2);
    const int rb = wid & 1, db = wid & 3;
    const unsigned char* base = prep + (size_t)(bh * 128) * PREP_STRIDE;
    const unsigned char* pA = base + (role == 0 ? PO_W : PO_QD) + ((32 * rb + r32) * 128 + 8 * hi) * 2;
    const unsigned char* pB = base + (role == 1 ? PO_QK + ((32 * rb + r32) * 64 + 8 * hi) * 2 : PO_KDT + ((32 * db + r32) * 64 + 8 * hi) * 2);
    const unsigned char* pU = base + PO_U + (32 * rb * 128 + 32 * s + r32) * 4;
    bf16x8 fa[8], fb[4]; float uu[16]; float gl = 1.f;
#define SCAN_LOAD(ci) do { const size_t off_ = (size_t)(ci) * PREP_STRIDE; \
        if (role < 2) { _Pragma("unroll") for (int ks = 0; ks < 8; ++ks) fa[ks] = *(const GAS bf16x8*)(pA + off_ + ks * 32); } \
        if (role > 0) { _Pragma("unroll") for (int ks = 0; ks < 4; ++ks) fb[ks] = *(const GAS bf16x8*)(pB + off_ + ks * 32); } \
        if (role == 0) { _Pragma("unroll") for (int r = 0; r < 16; ++r) uu[r] = *(const GAS float*)(pU + off_ + crow(r, hi) * 512); } \
        if (role == 2) gl = GL[bh * 128 + (ci)]; } while (0)
    SCAN_LOAD(0);
    GDN_BAR();
    const LAS unsigned char* stp = lds + L_ST + (r32 * SP + 8 * hi) * 2;
    const LAS unsigned char* vnp = lds + L_VN + (r32 * VP + 8 * hi) * 2;
    for (int i = 0; i < 128; ++i) {
        bf16x8 ca[8], cbb[4]; float cu[16]; const float cgl = gl;
#pragma unroll
        for (int k = 0; k < 8; ++k) ca[k] = fa[k];
#pragma unroll
        for (int k = 0; k < 4; ++k) cbb[k] = fb[k];
#pragma unroll
        for (int r = 0; r < 16; ++r) cu[r] = uu[r];
        if (i + 1 < 128) SCAN_LOAD(i + 1);
        f32x16 acc = f32x16{};
        if (role < 2) {
#pragma unroll
            for (int ks = 0; ks < 8; ++ks) acc = __builtin_amdgcn_mfma_f32_32x32x16_bf16(ca[ks], *(const LAS bf16x8*)(stp + ks * 32), acc, 0, 0, 0);
            if (role == 0) {
                typedef unsigned u32x2v __attribute__((ext_vector_type(2)));
#pragma unroll
                for (int q = 0; q < 4; ++q) { u32x2v w; w.x = cvtpk(cu[4 * q] - acc[4 * q], cu[4 * q + 1] - acc[4 * q + 1]); w.y = cvtpk(cu[4 * q + 2] - acc[4 * q + 2], cu[4 * q + 3] - acc[4 * q + 3]);
                    *(LAS u32x2v*)(lds + L_VN + (r32 * VP + 32 * rb + 8 * q + 4 * hi) * 2) = w; }
            }
        }
        GDN_BAR();
        if (role == 1) {
#pragma unroll
            for (int ks = 0; ks < 4; ++ks) acc = __builtin_amdgcn_mfma_f32_32x32x16_bf16(cbb[ks], *(const LAS bf16x8*)(vnp + ks * 32), acc, 0, 0, 0);
            bf16* og = OG + (size_t)(b * SEQ + i * 64 + 32 * rb) * 512 + h * 128 + 32 * s + r32;
#pragma unroll
            for (int r = 0; r < 16; ++r) og[(size_t)crow(r, hi) * 512] = (bf16)f2bf(acc[r]);
        } else if (role == 2) {
            Sacc = Sacc * cgl;
#pragma unroll
            for (int ks = 0; ks < 4; ++ks) Sacc = __builtin_amdgcn_mfma_f32_32x32x16_bf16(cbb[ks], *(const LAS bf16x8*)(vnp + ks * 32), Sacc, 0, 0, 0);
            typedef unsigned u32x2v __attribute__((ext_vector_type(2)));
#pragma unroll
            for (int q = 0; q < 4; ++q) { u32x2v w; w.x = cvtpk(Sacc[4 * q], Sacc[4 * q + 1]); w.y = cvtpk(Sacc[4 * q + 2], Sacc[4 * q + 3]);
                *(LAS u32x2v*)(lds + L_ST + (r32 * SP + 32 * db + 8 * q + 4 * hi) * 2) = w; }
        }
        GDN_BAR();
    }
#undef SCAN_LOAD
}
}

struct Args { const float* in[19]; float* out; unsigned char* ws; };
__global__ void __launch_bounds__(NWAVES * 64, 2) mega_fwd(Args) {
    extern __shared__ __attribute__((aligned(16))) unsigned char lds[];
    cg::grid_group grid = cg::this_grid();
    Frame F;
    F.lds = (LAS unsigned char*)lds; F.MISC = (volatile LAS unsigned*)(F.lds + MISC_OFF);
    F.G = gridDim.x; { const int bx = blockIdx.x; F.vcu = (F.G % 8 == 0) ? (bx % 8) * (F.G / 8) + bx / 8 : bx; }
#define KARGP() const __attribute__((address_space(4))) unsigned long long* kp_ = (const __attribute__((address_space(4))) unsigned long long*)__builtin_amdgcn_kernarg_segment_ptr(); asm volatile("" : "+s"(kp_))
#define INP(k) ((const float*)(GAS const float*)(kp_[k]))
#define WSB ((unsigned char*)(GAS unsigned char*)(kp_[20]))
#define OUT ((float*)(GAS float*)(kp_[19]))
#define in_x INP(0)
#define attn_g INP(1)
#define w_in INP(2)
#define lq1 INP(3)
#define lk1 INP(4)
#define lq2 INP(5)
#define lk2 INP(6)
#define subln_g INP(7)
#define gconv_w INP(8)
#define a_log INP(9)
#define dt_bias INP(10)
#define gnorm_g INP(11)
#define w_out INP(12)
#define ffn_g INP(13)
#define w_up INP(14)
#define fconv_w INP(15)
#define fconv_b INP(16)
#define w_down INP(17)
#define final_g INP(18)
#define WinT ((bf16*)(WSB + WS_WIN))
#define WoT ((bf16*)(WSB + WS_WO))
#define WupT ((bf16*)(WSB + WS_WUP))
#define WdnT ((bf16*)(WSB + WS_WDN))
#define GAB ((float*)(WSB + WS_GAB))
#define HALO ((float*)(WSB + WS_HALO))
#define GL ((float*)(WSB + WS_GL))
#define XN ((bf16*)(WSB + WS_XN))
#define PREP (WSB + WS_PREP)
#define Gb ((bf16*)(WSB + WS_G))
#define PA ((bf16*)(WSB + WS_PA))
#define PGb ((bf16*)(WSB + WS_PG))
#define OATT ((bf16*)(WSB + WS_OATT))
#define OGb ((bf16*)(WSB + WS_OG))
#define X1 ((float*)(WSB + WS_X1))
#define CTLP ((gu32*)(GAS unsigned*)(kp_[20]))
    for (int u = threadIdx.x; u < (LDS_BYTES - MISC_OFF) / 4; u += NWAVES * 64) ((LAS unsigned*)(F.lds + MISC_OFF))[u] = 0u;
    __syncthreads();
    { KARGP(); (void)xcd_barrier_post((unsigned*)(CTLP + CW_BAR), F.MISC + 8); }
    grid.sync();
#define GRID_BAR() do { const __attribute__((address_space(4))) unsigned long long* kq_ = (const __attribute__((address_space(4))) unsigned long long*)__builtin_amdgcn_kernarg_segment_ptr(); asm volatile("" : "+s"(kq_)); \
        XcdBarrier b_; b_.bar = (unsigned*)(GAS unsigned*)(kq_[20]) + CW_BAR; b_.x = xb_xcc_id(); b_.st = F.MISC + 8; xcd_barrier(b_); } while (0)
#define PHASE_IDS() int tid = threadIdx.x; asm volatile("" : "+v"(tid)); const int lane = tid & 63, wave = __builtin_amdgcn_readfirstlane(tid >> 6); const int gw = F.vcu * NWAVES + wave, NGW = F.G * NWAVES; (void)lane; (void)gw; (void)NGW; KARGP()

    {
        PHASE_IDS();
        LAS float* scr = (LAS float*)(F.lds + wave * 16384);
        constexpr int I_IN = 112 * 16, I_O = 32 * 16, I_UP = 176 * 16, I_DN = 32 * 44, NITEMS = I_IN + I_O + I_UP + I_DN;
        for (int it = gw; it < NITEMS; it += NGW) {
            int r = it;
            if (r < I_IN) { const int nb = r % 112, kb = r / 112, n0 = 32 * nb; const int c0 = n0 < 1536 ? n0 : (n0 < 2048 ? 3080 + (n0 - 1536) : 1536 + (n0 - 2048));
                p0_transpose_item(w_in, NINP, c0, 64 * kb, WinT, n0, D, scr, lane); continue; } r -= I_IN;
            if (r < I_O) { const int nb = r % 32, kb = r / 32; p0_transpose_item(w_out, D, 32 * nb, 64 * kb, WoT, 32 * nb, D, scr, lane); continue; } r -= I_O;
            if (r < I_UP) { const int nb = r % 176, kb = r / 176; const int c0 = ((nb >> 2) & 1) * DFF + 128 * (nb >> 3) + 32 * (nb & 3);
                p0_transpose_item(w_up, NUP, c0, 64 * kb, WupT, 32 * nb, D, scr, lane); continue; } r -= I_UP;
            { const int nb = r % 32, kb = r / 32; p0_transpose_item(w_down, D, 32 * nb, 64 * kb, WdnT, 32 * nb, DFF, scr, lane); }
        }
        __syncthreads();
        LAS float* Wab = (LAS float*)F.lds;
        for (int i = tid; i < 2048; i += NWAVES * 64) { const int k = i >> 1, hf = i & 1; *(LAS f32x4*)(Wab + k * 8 + 4 * hf) = *(const f32x4*)(w_in + (size_t)k * NINP + 3072 + 4 * hf); }
        __syncthreads();
        for (int m = gw; m < M; m += NGW) {
            f32x4 v[4]; rms_row(in_x + (size_t)m * D, attn_g, lane, v);
            store_row_bf16(XN + (size_t)m * D, lane, v);
            float d8[8];
#pragma unroll
            for (int e = 0; e < 8; ++e) d8[e] = 0.f;
#pragma unroll
            for (int j = 0; j < 4; ++j)
#pragma unroll
                for (int q = 0; q < 4; ++q) { const int k = 4 * lane + 256 * j + q; const f32x4 wa = *(const LAS f32x4*)(Wab + k * 8), wb = *(const LAS f32x4*)(Wab + k * 8 + 4); const float hv = v[j][q];
                    d8[0] += hv * wa.x; d8[1] += hv * wa.y; d8[2] += hv * wa.z; d8[3] += hv * wa.w; d8[4] += hv * wb.x; d8[5] += hv * wb.y; d8[6] += hv * wb.z; d8[7] += hv * wb.w; }
#pragma unroll
            for (int e = 0; e < 8; ++e) d8[e] = wave_sum(d8[e]);
            if (lane == 0) { *(f32x4*)(GAB + (size_t)m * 8) = (f32x4){d8[0], d8[1], d8[2], d8[3]}; *(f32x4*)(GAB + (size_t)m * 8 + 4) = (f32x4){d8[4], d8[5], d8[6], d8[7]}; }
        }
    }
    GRID_BAR();
    {
        KARGP();
        pg8::Gemm g{XN, WinT, M, NPROJ, D}; pg8::StaticOrder S; S.init(M, NPROJ, F.G, (int)blockIdx.x);
        pg8::EpiProj E{PA, PGb, attn_body::C2};
        pg8::gemm_phase<pg8::EpiProj, pg8::StaticOrder, true, true>(F.lds, g, S, E);
    }
    GRID_BAR();
    { PHASE_IDS(); for (int ch = F.vcu; ch < 1024; ch += F.G) gdn::prep_chunk(F.lds, tid, ch, PGb, GAB, gconv_w, a_log, dt_bias, PREP, GL); }
    GRID_BAR();
    {
        PHASE_IDS();
        if ((int)blockIdx.x >= F.G - 32) { const int si = (int)blockIdx.x - (F.G - 32); gdn::scan(F.lds, tid, si >> 2, si & 3, PREP, GL, OGb); }
        for (;;) {
            if (tid == 0) F.MISC[4] = __hip_atomic_fetch_add(CTLP + CW_QUEUE, 1u, __ATOMIC_RELAXED, __HIP_MEMORY_SCOPE_AGENT);
            __syncthreads();
            const int u = (int)F.MISC[4];
            __syncthreads();
            if (u >= 1024) break;
            const int qb = 31 - (u >> 5), vhd = u & 31;
            attn_body::attn_unit<16>(vhd >> 4, (vhd >> 2) & 3, (vhd >> 1) & 1, vhd & 1, qb, (const attn_body::bf16*)PA, (attn_body::bf16*)OATT, (char*)lds);
        }
    }
    GRID_BAR();
    {
        PHASE_IDS();
        float s1 = lq1[lane] * lk1[lane], s2 = lq2[lane] * lk2[lane];
        const float lam = __expf(wave_sum(s1)) - __expf(wave_sum(s2)) + 0.2f;
        const int a0 = 8 * lane, dd = 8 * (lane & 15);
        float sg[8], gg[8];
#pragma unroll
        for (int e = 0; e < 8; ++e) { sg[e] = subln_g[dd + e] * 0.8f; gg[e] = gnorm_g[dd + e]; }
        for (int m = gw; m < M; m += NGW) {
            const v4u o0 = *(const GAS v4u*)(OATT + (size_t)m * 1024 + a0), o1 = *(const GAS v4u*)(OATT + (size_t)m * 1024 + 512 + a0);
            const v4u og = *(const GAS v4u*)(OGb + (size_t)m * 512 + a0), zz = *(const GAS v4u*)(PA + (size_t)m * 2048 + 1536 + a0);
            float oa[8], ob[8], zf[8]; float ssa = 0.f, ssb = 0.f;
#pragma unroll
            for (int q = 0; q < 4; ++q) {
                oa[2 * q] = __uint_as_float(o0[q] << 16) - lam * __uint_as_float(o1[q] << 16); oa[2 * q + 1] = __uint_as_float(o0[q] & 0xffff0000u) - lam * __uint_as_float(o1[q] & 0xffff0000u);
                ob[2 * q] = __uint_as_float(og[q] << 16); ob[2 * q + 1] = __uint_as_float(og[q] & 0xffff0000u);
                zf[2 * q] = __uint_as_float(zz[q] << 16); zf[2 * q + 1] = __uint_as_float(zz[q] & 0xffff0000u);
            }
#pragma unroll
            for (int e = 0; e < 8; ++e) { ssa += oa[e] * oa[e]; ssb += ob[e] * ob[e]; }
#pragma unroll
            for (int o = 1; o < 16; o <<= 1) { ssa += __shfl_xor(ssa, o); ssb += __shfl_xor(ssb, o); }
            const float ra = 1.0f / sqrtf(ssa * (1.f / 128.f) + EPS), rb = 1.0f / sqrtf(ssb * (1.f / 128.f) + EPS);
            float ya[8], yb[8];
#pragma unroll
            for (int e = 0; e < 8; ++e) { ya[e] = oa[e] * ra * sg[e]; yb[e] = ob[e] * rb * gg[e] * pg8::silu_f(zf[e]); }
            *(GAS v4u*)(XN + (size_t)m * 1024 + a0) = (v4u){cvtpk(ya[0], ya[1]), cvtpk(ya[2], ya[3]), cvtpk(ya[4], ya[5]), cvtpk(ya[6], ya[7])};
            *(GAS v4u*)(XN + (size_t)m * 1024 + 512 + a0) = (v4u){cvtpk(yb[0], yb[1]), cvtpk(yb[2], yb[3]), cvtpk(yb[4], yb[5]), cvtpk(yb[6], yb[7])};
        }
    }
    GRID_BAR();
    {
        KARGP();
        pg8::Gemm g{XN, WoT, M, D, D}; pg8::StaticOrder S; S.init(M, D, F.G, (int)blockIdx.x);
        pg8::EpiResF32 E{in_x, X1, D};
        pg8::gemm_phase<pg8::EpiResF32, pg8::StaticOrder, true, true>(F.lds, g, S, E);
    }
    GRID_BAR();
    { PHASE_IDS(); for (int m = gw; m < M; m += NGW) { f32x4 v[4]; rms_row(X1 + (size_t)m * D, ffn_g, lane, v); store_row_bf16(XN + (size_t)m * D, lane, v); } }
    GRID_BAR();
    {
        KARGP();
        pg8::Gemm g{XN, WupT, M, NUP, D}; pg8::StaticOrder S; S.init(M, NUP, F.G, (int)blockIdx.x);
        pg8::EpiConvGLU E{Gb, fconv_w, fconv_b, HALO, (PG8_LAS float*)(F.lds + XH_OFF)};
        pg8::gemm_phase<pg8::EpiConvGLU, pg8::StaticOrder, true, true>(F.lds, g, S, E);
    }
    GRID_BAR();
    {
        PHASE_IDS();
        const int gt = blockIdx.x * (NWAVES * 64) + tid, NT = F.G * NWAVES * 64;
        for (int it = gt; it < 64 * DFF; it += NT) {
            const int pm = it / DFF, c = it % DFF; if ((pm & 31) == 0) continue;
            const int j = c >> 7, i = c & 127, cg_ = 256 * j + i, cv_ = cg_ + 128;
            const float* hp = HALO + (size_t)(pm - 1) * 4 * NUP; const float* hc = HALO + (size_t)pm * 4 * NUP;
            const float gm2 = hp[2 * NUP + cg_], gm1 = hp[3 * NUP + cg_], g0 = hc[cg_], g1 = hc[NUP + cg_];
            const float vm2 = hp[2 * NUP + cv_], vm1 = hp[3 * NUP + cv_], v0 = hc[cv_], v1 = hc[NUP + cv_];
            const float wg0 = fconv_w[c], wg1 = fconv_w[NUP + c], wg2 = fconv_w[2 * NUP + c], bg = fconv_b[c];
            const float wv0 = fconv_w[DFF + c], wv1 = fconv_w[NUP + DFF + c], wv2 = fconv_w[2 * NUP + DFF + c], bv = fconv_b[DFF + c];
            const float ug0 = wg0 * gm2 + wg1 * gm1 + wg2 * g0 + bg, ug1 = wg0 * gm1 + wg1 * g0 + wg2 * g1 + bg;
            const float uv0 = wv0 * vm2 + wv1 * vm1 + wv2 * v0 + bv, uv1 = wv0 * vm1 + wv1 * v0 + wv2 * v1 + bv;
            Gb[(size_t)(pm * 256) * DFF + c] = (bf16)f2bf(pg8::silu_f(ug0) * uv0);
            Gb[(size_t)(pm * 256 + 1) * DFF + c] = (bf16)f2bf(pg8::silu_f(ug1) * uv1);
        }
    }
    GRID_BAR();
    {
        KARGP();
        pg8::Gemm g{Gb, WdnT, M, D, DFF}; pg8::StaticOrder S; S.init(M, D, F.G, (int)blockIdx.x);
        pg8::EpiResF32 E{X1, OUT, D};
        pg8::gemm_phase<pg8::EpiResF32, pg8::StaticOrder, true, true>(F.lds, g, S, E);
    }
    GRID_BAR();
    { PHASE_IDS();
    for (int m = gw; m < M; m += NGW) {
        f32x4 v[4]; rms_row(OUT + (size_t)m * D, final_g, lane, v);
        GAS f32x4* o = (GAS f32x4*)(OUT + (size_t)m * D) + lane;
#pragma unroll
        for (int j = 0; j < 4; ++j) o[64 * j] = v[j];
    } }
}

extern "C" void kernel_launch(void* const* d_in, const int* in_sizes, int n_in, void* d_out, int out_size, void* d_ws, size_t ws_size, hipStream_t stream) {
    static int grid = 0;
    if (grid == 0) {
        if (n_in != 19 || ws_size < WS_END) { fprintf(stderr, "kernel_launch: unexpected inputs (n_in %d, ws %zu)\n", n_in, ws_size); grid = -1; return; }
        int dev = 0, cus = 0, per_cu = 0;
        hipGetDevice(&dev); hipDeviceGetAttribute(&cus, hipDeviceAttributeMultiprocessorCount, dev);
        hipFuncSetAttribute((const void*)mega_fwd, hipFuncAttributeMaxDynamicSharedMemorySize, LDS_BYTES);
        hipOccupancyMaxActiveBlocksPerMultiprocessor(&per_cu, (const void*)mega_fwd, NWAVES * 64, LDS_BYTES);
        (void)hipGetLastError();
        if (per_cu < 1) per_cu = 1;
        grid = cus;
        if (grid > 256) grid = 256;
    }
    if (grid < 0) return;
    hipMemsetAsync((char*)d_ws + WS_CTL, 0, CTL_ZERO_BYTES, stream);
    Args a{};
    for (int i = 0; i < 19; ++i) a.in[i] = (const float*)d_in[i];
    a.out = (float*)d_out; a.ws = (unsigned char*)d_ws;
    void* kargs[] = {&a};
    hipError_t e = hipLaunchCooperativeKernel((const void*)mega_fwd, dim3(grid), dim3(NWAVES * 64), kargs, LDS_BYTES, stream);
    if (e != hipSuccess) fprintf(stderr, "cooperative launch failed: %s (grid %d)\n", hipGetErrorString(e), grid);
}
```

```cpp
#include <hip/hip_runtime.h>
#include <cstdio>
#include <cstdint>
namespace pg8 {
#define PG8_LAS __attribute__((address_space(3)))
typedef unsigned short bf16_t;
typedef short bf16x8 __attribute__((ext_vector_type(8)));
typedef float f32x4 __attribute__((ext_vector_type(4)));
typedef unsigned u32x4 __attribute__((ext_vector_type(4)));
constexpr int BM = 256, BK = 64, HALF = 128, HTB = HALF * BK * 2  , STAGE_BYTES = 8 * HTB, NXCD = 8, WGM = 8;

__host__ __device__ __forceinline__ int lds_byte(int r, int c) { const int st = (r >> 4) * 2 + (c >> 5), rr = r & 15, cc = c & 31, ob = rr * 64 + cc * 2; return st * 1024 + (ob ^ (((ob >> 9) & 1) << 5)); }
__host__ __device__ __forceinline__ void stage_rc(int b, int& R, int& C) { const int st = b / 1024, sb = b % 1024, swz = sb ^ (((sb >> 9) & 1) << 5); R = (st >> 1) * 16 + swz / 64; C = (st & 1) * 32 + (swz % 64) / 2; }
__host__ __device__ __forceinline__ int perm32(int rho) { const int n = rho >> 4, i = rho & 15; return 8 * (i >> 2) + 4 * n + (i & 3); }

struct Unit { int pm, pn; };
struct Gemm { const bf16_t* A; const bf16_t* Bt; int M, N, K; };

struct StaticOrder {
    int nM, nN, nwg, G, c;
    __host__ __device__ void init(int M, int N, int G_, int c_) { nM = M / BM; nN = N / BM; nwg = nM * nN; G = G_; c = c_; }
    __host__ __device__ bool next(int i, Unit& u) const {
        const long L = (long)i * G + c; if (L >= nwg) return false;
        int wgid = (int)L; { const int q = nwg / NXCD, r = nwg % NXCD, xcd = wgid % NXCD, off = wgid / NXCD; wgid = (xcd < r ? xcd * (q + 1) : r * (q + 1) + (xcd - r) * q) + off; }
        const int nig = WGM * nN, gid = wgid / nig, fm = gid * WGM, gsz = (nM - fm) < WGM ? (nM - fm) : WGM;
        u.pm = fm + ((wgid % nig) % gsz); u.pn = (wgid % nig) / gsz; return true;
    }
    __device__ __forceinline__ void a_ready(const Unit&) const {}
    __device__ __forceinline__ void done(const Unit&) const {}
};

__device__ __forceinline__ unsigned cvt_pk_bf16(float lo, float hi) { unsigned r; asm volatile("v_cvt_pk_bf16_f32 %0, %1, %2" : "=v"(r) : "v"(lo), "v"(hi)); return r; }
typedef float f32x2 __attribute__((ext_vector_type(2)));
__device__ __forceinline__ f32x2 gelu_pk(f32x2 v) {
    const f32x2 av = __builtin_elementwise_abs(v), d = av * 0.2316418882f + 1.0f;
    f32x2 t; t.x = __builtin_amdgcn_rcpf(d.x); t.y = __builtin_amdgcn_rcpf(d.y);
    f32x2 q = t * 0.5307027145f + (-0.7265760135f); q = q * t + 0.7107068705f; q = q * t + (-0.142248368f); q = q * t + 0.127414796f; q = q * t;
    const f32x2 s = (v * v) * (-0.72134752044f);
    f32x2 e; e.x = __builtin_amdgcn_exp2f(s.x); e.y = __builtin_amdgcn_exp2f(s.y);
    const f32x2 m = v * (q * e), r = v - m;
    f32x2 o; o.x = v.x < 0.f ? m.x : r.x; o.y = v.y < 0.f ? m.y : r.y; return o;
}

template <int ACT  > struct EpiBf16 {
    static constexpr bool PERM = true, AFTER_DRAIN = false; static_assert(ACT == 0 || ACT == 1, "EpiBf16: ACT is 0 (none) or 1 (gelu_pk)");
    bf16_t* O; int ldc; const float* bias; int split_cols; size_t split_stride; float scale0;
    __device__ __forceinline__ void operator()(const f32x4 (&acc)[2][2][4][2], const Unit& u, int wr, int wc, int fr, int fq) const {
        const int row0 = u.pm * BM + wr * 64 + fr; int colt = u.pn * BM; bf16_t* base = O;
        float sc = 1.f; if (split_cols) { const int t = colt / split_cols; base += (size_t)t * split_stride; colt -= t * split_cols; if (t == 0) sc = scale0; }
        const int col0 = colt + wc * 32 + 8 * fq, bcol0 = u.pn * BM + wc * 32 + 8 * fq;
        f32x4 bv[2][2];
#pragma unroll
        for (int bj = 0; bj < 2; ++bj)
#pragma unroll
            for (int n = 0; n < 2; ++n) bv[bj][n] = bias ? *(const f32x4*)(bias + bcol0 + bj * HALF + 4 * n) : (f32x4){0.f, 0.f, 0.f, 0.f};
#pragma unroll
        for (int ai = 0; ai < 2; ++ai)
#pragma unroll
            for (int m = 0; m < 4; ++m) { bf16_t* rowp = base + (size_t)(row0 + ai * HALF + m * 16) * ldc + col0;
#pragma unroll
                for (int bj = 0; bj < 2; ++bj) { f32x4 v0 = acc[ai][bj][m][0] + bv[bj][0], v1 = acc[ai][bj][m][1] + bv[bj][1];
                    if (ACT == 1) { f32x2 a = gelu_pk((f32x2){v0[0], v0[1]}), b = gelu_pk((f32x2){v0[2], v0[3]}), c = gelu_pk((f32x2){v1[0], v1[1]}), d = gelu_pk((f32x2){v1[2], v1[3]});
                        v0 = (f32x4){a.x, a.y, b.x, b.y}; v1 = (f32x4){c.x, c.y, d.x, d.y}; }
                    v0 = v0 * sc; v1 = v1 * sc; u32x4 w; w.x = cvt_pk_bf16(v0[0], v0[1]); w.y = cvt_pk_bf16(v0[2], v0[3]); w.z = cvt_pk_bf16(v1[0], v1[1]); w.w = cvt_pk_bf16(v1[2], v1[3]);
                    *(u32x4*)(rowp + bj * HALF) = w; } }
    }
};

struct EpiProj {
    static constexpr bool PERM = true, AFTER_DRAIN = false;
    bf16_t* PA; bf16_t* PG; float scale0;
    __device__ __forceinline__ void operator()(const f32x4 (&acc)[2][2][4][2], const Unit& u, int wr, int wc, int fr, int fq) const {
        const int row0 = u.pm * BM + wr * 64 + fr;
        bf16_t* base; int ldc, colt;
        if (u.pn < 8) { base = PA; ldc = 2048; colt = u.pn * BM; } else { base = PG; ldc = 1536; colt = (u.pn - 8) * BM; }
        const float sc = (u.pn < 2) ? scale0 : 1.f;
        const int col0 = colt + wc * 32 + 8 * fq;
#pragma unroll
        for (int ai = 0; ai < 2; ++ai)
#pragma unroll
            for (int m = 0; m < 4; ++m) { bf16_t* rowp = base + (size_t)(row0 + ai * HALF + m * 16) * ldc + col0;
#pragma unroll
                for (int bj = 0; bj < 2; ++bj) { f32x4 v0 = acc[ai][bj][m][0] * sc, v1 = acc[ai][bj][m][1] * sc;
                    u32x4 w; w.x = cvt_pk_bf16(v0[0], v0[1]); w.y = cvt_pk_bf16(v0[2], v0[3]); w.z = cvt_pk_bf16(v1[0], v1[1]); w.w = cvt_pk_bf16(v1[2], v1[3]);
                    *(u32x4*)(rowp + bj * HALF) = w; } }
    }
};
struct EpiResF32 {
    static constexpr bool PERM = false, AFTER_DRAIN = false;
    const float* base; float* out; int ldc;
    __device__ __forceinline__ void operator()(const f32x4 (&acc)[2][2][4][2], const Unit& u, int wr, int wc, int fr, int fq) const {
        const int col0 = u.pn * BM + wc * 32 + 4 * fq;
#pragma unroll
        for (int ai = 0; ai < 2; ++ai)
#pragma unroll
            for (int m = 0; m < 4; ++m) { const size_t off = (size_t)(u.pm * BM + ai * HALF + wr * 64 + m * 16 + fr) * ldc + col0;
#pragma unroll
                for (int bj = 0; bj < 2; ++bj)
#pragma unroll
                    for (int n = 0; n < 2; ++n) { const f32x4 bs = *(const f32x4*)(base + off + bj * HALF + n * 16); *(f32x4*)(out + off + bj * HALF + n * 16) = bs + acc[ai][bj][m][n]; } }
    }
};
__device__ __forceinline__ float dpp_ror1(float v) { return __builtin_bit_cast(float, __builtin_amdgcn_update_dpp(0, __builtin_bit_cast(int, v), 0x121, 0xf, 0xf, false)); }
__device__ __forceinline__ float dpp_ror2(float v) { return __builtin_bit_cast(float, __builtin_amdgcn_update_dpp(0, __builtin_bit_cast(int, v), 0x122, 0xf, 0xf, false)); }
__device__ __forceinline__ float silu_f(float x) { return x * __builtin_amdgcn_rcpf(1.0f + __expf(-x)); }
struct EpiConvGLU {
    static constexpr bool PERM = true, AFTER_DRAIN = false;
    bf16_t* G; const float* cw; const float* cb; float* halo; PG8_LAS float* xh;
    __device__ __forceinline__ void operator()(const f32x4 (&acc)[2][2][4][2], const Unit& u, int wr, int wc, int fr, int fq) const {
        const int csb = wc * 32 + 8 * fq;
        if (fr >= 14) {
#pragma unroll
            for (int ai = 0; ai < 2; ++ai)
#pragma unroll
                for (int bj = 0; bj < 2; ++bj)
#pragma unroll
                    for (int n = 0; n < 2; ++n) *(PG8_LAS f32x4*)(xh + (((2 * ai + wr) * 2 + (fr - 14)) * 256 + bj * 128 + csb + 4 * n)) = acc[ai][bj][3][n];
        }
        if (wr == 0 && fr < 2) {
#pragma unroll
            for (int bj = 0; bj < 2; ++bj)
#pragma unroll
                for (int n = 0; n < 2; ++n) *(f32x4*)(halo + ((size_t)(u.pm * 4 + fr) * 5632 + u.pn * 256 + bj * 128 + csb + 4 * n)) = acc[0][bj][0][n];
        }
        if (wr == 1 && fr >= 14) {
#pragma unroll
            for (int bj = 0; bj < 2; ++bj)
#pragma unroll
                for (int n = 0; n < 2; ++n) *(f32x4*)(halo + ((size_t)(u.pm * 4 + 2 + (fr - 14)) * 5632 + u.pn * 256 + bj * 128 + csb + 4 * n)) = acc[1][bj][3][n];
        }
        asm volatile("s_waitcnt lgkmcnt(0)" ::: "memory"); __builtin_amdgcn_s_barrier(); asm volatile("" ::: "memory");
        const bool seqstart = (u.pm & 31) == 0;
#pragma unroll
        for (int n = 0; n < 2; ++n) {
            const int chg = u.pn * 128 + csb + 4 * n, chv = 2816 + chg;
            const f32x4 g0 = *(const f32x4*)(cw + chg), g1 = *(const f32x4*)(cw + 5632 + chg), g2 = *(const f32x4*)(cw + 2 * 5632 + chg), gb = *(const f32x4*)(cb + chg);
            const f32x4 v0 = *(const f32x4*)(cw + chv), v1 = *(const f32x4*)(cw + 5632 + chv), v2 = *(const f32x4*)(cw + 2 * 5632 + chv), vb = *(const f32x4*)(cb + chv);
#pragma unroll
            for (int ai = 0; ai < 2; ++ai) {
                const int g = 2 * ai + wr;
                f32x4 hg = (f32x4){0.f, 0.f, 0.f, 0.f}, hv = hg;
                if (g > 0) { hg = *(const PG8_LAS f32x4*)(xh + (((g - 1) * 2 + (fr & 1)) * 256 + csb + 4 * n)); hv = *(const PG8_LAS f32x4*)(xh + (((g - 1) * 2 + (fr & 1)) * 256 + 128 + csb + 4 * n)); }
#pragma unroll
                for (int m = 0; m < 4; ++m) {
                    const f32x4 pg = (m == 0) ? hg : acc[ai][0][m == 0 ? 0 : m - 1][n], pv = (m == 0) ? hv : acc[ai][1][m == 0 ? 0 : m - 1][n];
                    const f32x4 cg = acc[ai][0][m][n], cv = acc[ai][1][m][n];
                    float og[4];
#pragma unroll
                    for (int e = 0; e < 4; ++e) {
                        const float g_p1 = dpp_ror1(fr == 15 ? pg[e] : cg[e]), g_p2 = dpp_ror2(fr >= 14 ? pg[e] : cg[e]);
                        const float v_p1 = dpp_ror1(fr == 15 ? pv[e] : cv[e]), v_p2 = dpp_ror2(fr >= 14 ? pv[e] : cv[e]);
                        const float ug = g2[e] * cg[e] + g1[e] * g_p1 + g0[e] * g_p2 + gb[e];
                        const float uv = v2[e] * cv[e] + v1[e] * v_p1 + v0[e] * v_p2 + vb[e];
                        og[e] = silu_f(ug) * uv;
                    }
                    typedef unsigned u32x2v __attribute__((ext_vector_type(2)));
                    u32x2v w; w.x = cvt_pk_bf16(og[0], og[1]); w.y = cvt_pk_bf16(og[2], og[3]);
                    const bool skip = (g == 0) && (m == 0) && (fr < 2) && !seqstart;
                    if (!skip) *(u32x2v*)(G + (size_t)(u.pm * BM + ai * HALF + wr * 64 + m * 16 + fr) * 2816 + chg) = w;
                }
            }
        }
    }
};
template <class Epi, class Sched, bool ALIGN_EPI = false, bool SP2 = false>
__device__ __forceinline__ void gemm_phase(PG8_LAS unsigned char* lds, const Gemm g, const Sched& S, const Epi& E) {
    int tid_l = threadIdx.x; asm volatile("" : "+v"(tid_l));
    const int tid = tid_l, wid = __builtin_amdgcn_readfirstlane(tid >> 6), lane = tid & 63, wr = wid >> 2, wc = wid & 3, fr = lane & 15, fq = lane >> 4;
    const int K = g.K, nt = K / BK;
    unsigned voffA[2], voffB[2];
#pragma unroll
    for (int i = 0; i < 2; ++i) { int R, C; stage_rc(tid * 16 + i * 8192, R, C); const int Rb = Epi::PERM ? ((R & ~31) + perm32(R & 31)) : R;
        voffA[i] = (unsigned)(R * K + C) * 2u; voffB[i] = (unsigned)(Rb * K + C) * 2u; }
    const size_t kstep = (size_t)(BK * 2);
    const size_t hstep = (size_t)HALF * K * 2;
    const size_t tstep = 2 * hstep;
    const unsigned ldsw = (unsigned)wid * 1024u;
    const int aoff = lds_byte(wr * 64 + fr, fq * 8), boff = lds_byte(wc * 32 + fr, fq * 8);
#define PG8_SA(b, h) (((b) * 2 + (h)) * HTB)
#define PG8_SB(b, h) ((4 + (b) * 2 + (h)) * HTB)
#define PG8_STAGE(bufoff, gbase, voff) do { _Pragma("unroll") for (int _i = 0; _i < 2; ++_i) \
        __builtin_amdgcn_global_load_lds((const unsigned*)((const char*)(gbase) + (voff)[_i]), (PG8_LAS unsigned*)(lds + (bufoff) + ldsw + _i * 8192), 16, 0, 0); } while (0)
#define PG8_LDA(dst, b, h) do { _Pragma("unroll") for (int m = 0; m < 4; ++m) _Pragma("unroll") for (int k = 0; k < 2; ++k) dst[m][k] = *(const PG8_LAS bf16x8*)(lds + PG8_SA(b, h) + aoff + m * 2048 + k * 1024); } while (0)
#define PG8_LDB(dst, b, h) do { _Pragma("unroll") for (int n = 0; n < 2; ++n) _Pragma("unroll") for (int k = 0; k < 2; ++k) dst[n][k] = *(const PG8_LAS bf16x8*)(lds + PG8_SB(b, h) + boff + n * 2048 + k * 1024); } while (0)
#define PG8_MMA(ai, bj, At, Bt) do { __builtin_amdgcn_s_setprio(1); _Pragma("unroll") for (int m = 0; m < 4; ++m) _Pragma("unroll") for (int n = 0; n < 2; ++n) _Pragma("unroll") for (int k = 0; k < 2; ++k) \
        acc[ai][bj][m][n] = __builtin_amdgcn_mfma_f32_16x16x32_bf16(Bt[n][k], At[m][k], acc[ai][bj][m][n], 0, 0, 0); __builtin_amdgcn_s_setprio(0); } while (0)
#define PG8_WAIT_V(n) asm volatile("s_waitcnt vmcnt(" #n ")" ::: "memory")
#define PG8_WAIT_L(n) asm volatile("s_waitcnt lgkmcnt(" #n ")" ::: "memory")
#define PG8_BAR __builtin_amdgcn_s_barrier()
#define PG8_SCHED __builtin_amdgcn_sched_barrier(0)
    Unit cur, nxt; int ui = 0;
    if (!S.next(0, cur)) return;
    f32x4 acc[2][2][4][2];
#pragma unroll
    for (int a = 0; a < 2; ++a)
#pragma unroll
        for (int b = 0; b < 2; ++b)
#pragma unroll
            for (int m = 0; m < 4; ++m)
#pragma unroll
                for (int n = 0; n < 2; ++n) acc[a][b][m][n] = (f32x4){0.f, 0.f, 0.f, 0.f};
    bf16x8 At[4][2], B0[2][2], B1[2][2];
    const char* cA = (const char*)g.A + (size_t)cur.pm * tstep; const char* cB = (const char*)g.Bt + (size_t)cur.pn * tstep;
    S.a_ready(cur);
    if constexpr (SP2) {
        PG8_STAGE(PG8_SB(0, 0), cB, voffB); PG8_STAGE(PG8_SB(0, 1), cB + hstep, voffB); PG8_STAGE(PG8_SA(0, 0), cA, voffA); PG8_STAGE(PG8_SA(0, 1), cA + hstep, voffA);
        if (wr == 1) PG8_BAR;
        PG8_WAIT_V(2); PG8_BAR;
        PG8_STAGE(PG8_SB(1, 0), cB + kstep, voffB); PG8_STAGE(PG8_SA(1, 0), cA + kstep, voffA); PG8_STAGE(PG8_SB(1, 1), cB + hstep + kstep, voffB);
        PG8_WAIT_V(6); PG8_BAR;
    } else {
        PG8_STAGE(PG8_SB(0, 0), cB, voffB); PG8_STAGE(PG8_SA(0, 0), cA, voffA); PG8_STAGE(PG8_SB(0, 1), cB + hstep, voffB); PG8_STAGE(PG8_SA(0, 1), cA + hstep, voffA);
        if (wr == 1) PG8_BAR;
        PG8_WAIT_V(4); PG8_BAR;
        PG8_STAGE(PG8_SB(1, 0), cB + kstep, voffB); PG8_STAGE(PG8_SA(1, 0), cA + kstep, voffA); PG8_STAGE(PG8_SB(1, 1), cB + hstep + kstep, voffB);
        PG8_WAIT_V(6); PG8_BAR;
    }
    for (;;) {
        const bool has_next = S.next(ui + 1, nxt);
        const char* nA = has_next ? (const char*)g.A + (size_t)nxt.pm * tstep : cA; const char* nB = has_next ? (const char*)g.Bt + (size_t)nxt.pn * tstep : cB;
        for (int t = 0; t < nt; t += 2) {
            const bool last = (t == nt - 2);
            const char* a1 = cA + (size_t)(t + 1) * kstep;
            const char* a2 = last ? nA : cA + (size_t)(t + 2) * kstep; const char* b2 = last ? nB : cB + (size_t)(t + 2) * kstep;
            const char* a3 = a2 + kstep; const char* b3 = b2 + kstep;
            if (last && has_next) S.a_ready(nxt);
            if constexpr (SP2) {
            PG8_LDB(B0, 0, 0); PG8_LDB(B1, 0, 1); PG8_SCHED; PG8_LDA(At, 0, 0); PG8_STAGE(PG8_SA(1, 1), a1 + hstep, voffA);
            PG8_WAIT_V(8); PG8_WAIT_L(0); PG8_BAR; PG8_MMA(0, 0, At, B0); PG8_MMA(0, 1, At, B1); PG8_BAR; PG8_SCHED;
            PG8_LDA(At, 0, 1); PG8_STAGE(PG8_SB(0, 0), b2, voffB); PG8_STAGE(PG8_SB(0, 1), b2 + hstep, voffB); PG8_STAGE(PG8_SA(0, 0), a2, voffA);
            PG8_WAIT_V(8); PG8_WAIT_L(0); PG8_BAR; PG8_MMA(1, 0, At, B0); PG8_MMA(1, 1, At, B1); PG8_BAR; PG8_SCHED;
            PG8_LDB(B0, 1, 0); PG8_LDB(B1, 1, 1); PG8_SCHED; PG8_LDA(At, 1, 0); PG8_STAGE(PG8_SA(0, 1), a2 + hstep, voffA);
            PG8_WAIT_V(8); PG8_WAIT_L(0); PG8_BAR; PG8_MMA(0, 0, At, B0); PG8_MMA(0, 1, At, B1); PG8_BAR; PG8_SCHED;
            PG8_LDA(At, 1, 1); PG8_STAGE(PG8_SB(1, 0), b3, voffB); PG8_STAGE(PG8_SB(1, 1), b3 + hstep, voffB); PG8_STAGE(PG8_SA(1, 0), a3, voffA);
            PG8_WAIT_V(8); PG8_WAIT_L(0); PG8_BAR; PG8_MMA(1, 0, At, B0); PG8_MMA(1, 1, At, B1); PG8_BAR; PG8_SCHED;
            } else {
            PG8_LDB(B0, 0, 0); PG8_SCHED; PG8_LDA(At, 0, 0); PG8_STAGE(PG8_SA(1, 1), a1 + hstep, voffA);
            PG8_WAIT_L(8); PG8_BAR; PG8_WAIT_L(0); PG8_MMA(0, 0, At, B0); PG8_BAR; PG8_SCHED;
            PG8_LDB(B1, 0, 1); PG8_STAGE(PG8_SB(0, 0), b2, voffB);
            PG8_BAR; PG8_WAIT_L(0); PG8_MMA(0, 1, At, B1); PG8_BAR;
            PG8_LDA(At, 0, 1); PG8_STAGE(PG8_SA(0, 0), a2, voffA);
            PG8_BAR; PG8_WAIT_L(0); PG8_MMA(1, 0, At, B0); PG8_BAR; PG8_SCHED;
            PG8_STAGE(PG8_SB(0, 1), b2 + hstep, voffB);
            PG8_WAIT_V(6); PG8_BAR; PG8_MMA(1, 1, At, B1); PG8_BAR;
            PG8_LDB(B0, 1, 0); PG8_SCHED; PG8_LDA(At, 1, 0); PG8_STAGE(PG8_SA(0, 1), a2 + hstep, voffA);
            PG8_WAIT_L(8); PG8_BAR; PG8_WAIT_L(0); PG8_MMA(0, 0, At, B0); PG8_BAR; PG8_SCHED;
            PG8_LDB(B1, 1, 1); PG8_STAGE(PG8_SB(1, 0), b3, voffB);
            PG8_BAR; PG8_WAIT_L(0); PG8_MMA(0, 1, At, B1); PG8_BAR;
            PG8_LDA(At, 1, 1); PG8_STAGE(PG8_SA(1, 0), a3, voffA);
            PG8_BAR; PG8_WAIT_L(0); PG8_MMA(1, 0, At, B0); PG8_BAR; PG8_SCHED;
            PG8_STAGE(PG8_SB(1, 1), b3 + hstep, voffB);
            PG8_WAIT_V(6); PG8_BAR; PG8_MMA(1, 1, At, B1); PG8_BAR;
            }
        }
        if constexpr (ALIGN_EPI) { if (wr == 0) PG8_BAR; }
        if constexpr (!Epi::AFTER_DRAIN) { E(acc, cur, wr, wc, fr, fq); S.done(cur); }
        if (!has_next) break;
#pragma unroll
        for (int a = 0; a < 2; ++a)
#pragma unroll
            for (int b = 0; b < 2; ++b)
#pragma unroll
                for (int m = 0; m < 4; ++m)
#pragma unroll
                    for (int n = 0; n < 2; ++n) acc[a][b][m][n] = (f32x4){0.f, 0.f, 0.f, 0.f};
        cur = nxt; cA = nA; cB = nB; ++ui;
        if constexpr (ALIGN_EPI) { if (wr == 1) PG8_BAR; }
    }
    PG8_WAIT_V(0);
    if constexpr (!ALIGN_EPI) { if (wr == 0) PG8_BAR; }
    PG8_BAR;
    if constexpr (Epi::AFTER_DRAIN) { E.fused(acc, cur, wr, wc, fr, fq, lds, wid, lane); S.done(cur); }
#undef PG8_SA
#undef PG8_SB
#undef PG8_STAGE
#undef PG8_LDA
#undef PG8_LDB
#undef PG8_MMA
#undef PG8_WAIT_V
#undef PG8_WAIT_L
#undef PG8_BAR
#undef PG8_SCHED
}
}

#ifndef PG8_SP2
#define PG8_SP2 true
#endif
#ifndef PG8_ALIGN
#define PG8_ALIGN true
#endif
#include <hip/hip_bf16.h>
#include <cmath>
namespace attn_body {
using bf16=__hip_bfloat16;
using bf16x8=__attribute__((ext_vector_type(8)))short;
using s16x4=__attribute__((ext_vector_type(4)))short;
using f32x16=__attribute__((ext_vector_type(16)))float;
using u32x4=__attribute__((ext_vector_type(4)))unsigned;
constexpr int BATCH=2,NHEAD=16,SEQ=8192,D=64,DM=2048,OPITCH=1024;
constexpr int NW=8,QBLK=32,QB=QBLK*NW,KVBLK=64,NQB=SEQ/QB;
constexpr int ATTN_PITCH=DM, ATTN_UNIT_ROWS=QB;
__device__ __forceinline__ int crow(int r,int hi){return (r&3)+8*(r>>2)+4*hi;}
#define SBAR() __builtin_amdgcn_sched_barrier(0)
__device__ __forceinline__ void cmask(f32x16&p0,f32x16&p1,int jb,int qrel,int hi){
  const float NEG=-INFINITY; int kb=64*jb+4*hi;
  #pragma unroll
  for(int r=0;r<16;++r){int kv=kb+(r&3)+8*(r>>2); if(kv>qrel)p0[r]=NEG; if(kv+32>qrel)p1[r]=NEG;}
}

constexpr int NSLOT=3, SLOTB=8192;
constexpr int LDS_K=0, LDS_V=NSLOT*SLOTB, LDS_WS=2*NSLOT*SLOTB, LDS_OST=LDS_WS+NW*64*4, LDS_BYTES=LDS_OST+NW*4096;
constexpr float C2=0.125f*1.4426950408889634f;
__device__ __forceinline__ void glds16(const void*gsrc,unsigned lds_dst){unsigned keep;
  asm volatile("s_mov_b32 %0, m0\n\ts_mov_b32 m0, %2\n\ts_nop 0\n\tglobal_load_lds_dwordx4 %1, off\n\ts_mov_b32 m0, %0":"=&s"(keep):"v"(gsrc),"s"(lds_dst):"memory");}
__device__ __forceinline__ float max3f(float a,float b,float c){float r;asm("v_max3_f32 %0, %1, %2, %3":"=v"(r):"v"(a),"v"(b),"v"(c));return r;}
__device__ __forceinline__ float max2f(float a,float b){float r;asm("v_max_f32_e32 %0, %1, %2":"=v"(r):"v"(a),"v"(b));return r;}
__device__ __forceinline__ float fadd_s(float a,float b){float r;asm("v_add_f32_e32 %0, %1, %2":"=v"(r):"v"(a),"v"(b));return r;}
__device__ __forceinline__ float fsub_s(float a,float b){float r;asm("v_sub_f32_e32 %0, %1, %2":"=v"(r):"v"(a),"v"(b));return r;}
typedef float f32x2_t __attribute__((ext_vector_type(2))); typedef __bf16 bf16x2_t __attribute__((ext_vector_type(2)));
__device__ __forceinline__ unsigned cvtpk_s(float lo,float hi){f32x2_t v={lo,hi};bf16x2_t b=__builtin_convertvector(v,bf16x2_t);return __builtin_bit_cast(unsigned,b);}
typedef unsigned u32x2_t __attribute__((ext_vector_type(2)));
__device__ __forceinline__ unsigned bfb(float x){return cvtpk_s(x,0.f)&0xffffu;}
__device__ __forceinline__ float bff(unsigned b){return __uint_as_float(b<<16);}
#define MFMA8(a,b,c) __builtin_amdgcn_mfma_f32_32x32x8bf16_1k((a),(b),(c),0,0,0)
#define WAIT_BAR(N) asm volatile("s_waitcnt vmcnt(" #N ") lgkmcnt(0)\n\ts_barrier":::"memory")

__device__ __forceinline__ void qkt(f32x16&p0,f32x16&p1,const char*Kslot,const bf16x8*qr,const s16x4 kx0,const s16x4 kx1,const s16x4 qx,int r32,int hi){
  const f32x16 Z=f32x16{}; p0=MFMA8(kx0,qx,Z); p1=MFMA8(kx1,qx,Z);
  const char*kb=Kslot+hi*1024+r32*16;
  #pragma unroll
  for(int d0=0;d0<4;++d0){
    const bf16x8 b0=*reinterpret_cast<const bf16x8*>(kb+d0*2048);
    const bf16x8 b1=*reinterpret_cast<const bf16x8*>(kb+d0*2048+512);
    {p0=__builtin_amdgcn_mfma_f32_32x32x16_bf16(b0,qr[d0],p0,0,0,0);p1=__builtin_amdgcn_mfma_f32_32x32x16_bf16(b1,qr[d0],p1,0,0,0);}}
}
typedef __attribute__((address_space(3))) const char* lds_cptr;
typedef short v4i16_t __attribute__((ext_vector_type(4)));
__device__ __forceinline__ void kload8(bf16x8*kf,lds_cptr kp){
  kf[0]=*(const __attribute__((address_space(3))) bf16x8*)(kp);      kf[1]=*(const __attribute__((address_space(3))) bf16x8*)(kp+512);
  kf[2]=*(const __attribute__((address_space(3))) bf16x8*)(kp+2048); kf[3]=*(const __attribute__((address_space(3))) bf16x8*)(kp+2560);
  kf[4]=*(const __attribute__((address_space(3))) bf16x8*)(kp+4096); kf[5]=*(const __attribute__((address_space(3))) bf16x8*)(kp+4608);
  kf[6]=*(const __attribute__((address_space(3))) bf16x8*)(kp+6144); kf[7]=*(const __attribute__((address_space(3))) bf16x8*)(kp+6656);
}
__device__ __forceinline__ void kload2(bf16x8*kf,lds_cptr kp,int j){ kf[2*j]=*(const __attribute__((address_space(3))) bf16x8*)(kp+j*2048); kf[2*j+1]=*(const __attribute__((address_space(3))) bf16x8*)(kp+j*2048+512); }
__device__ __forceinline__ s16x4 vtr(lds_cptr p){ return __builtin_bit_cast(s16x4,__builtin_amdgcn_ds_read_tr16_b64_v4i16((__attribute__((address_space(3))) v4i16_t*)p)); }
__device__ __forceinline__ float rowmax(const f32x16&p0,const f32x16&p1){
  float a=max3f(p0[0],p0[1],p1[0]),b=max3f(p0[2],p0[3],p1[1]);a=max3f(a,p1[2],p1[3]);
  #pragma unroll
  for(int r=4;r<16;r+=4){a=max3f(a,p0[r],p0[r+1]);b=max3f(b,p0[r+2],p0[r+3]);a=max3f(a,p1[r],p1[r+1]);b=max3f(b,p1[r+2],p1[r+3]);}
  const float m=max2f(a,b);
  auto rr=__builtin_amdgcn_permlane32_swap(__float_as_uint(m),__float_as_uint(m),false,false);
  return max2f(__uint_as_float(rr[0]),__uint_as_float(rr[1]));
}
__device__ __forceinline__ void pv(f32x16*o,int vb,bf16x8 pa0,bf16x8 pa1,bf16x8 pa2,bf16x8 pa3){
  #pragma unroll
  for(int d0=0;d0<2;++d0){s16x4 lo[4],hi[4];
    #pragma unroll
    for(int ks=0;ks<4;++ks){
      asm volatile("ds_read_b64_tr_b16 %0,%1 offset:%c2":"=&v"(lo[ks]):"v"(vb),"i"(d0*4096+ks*1024):"memory");
      asm volatile("ds_read_b64_tr_b16 %0,%1 offset:%c2":"=&v"(hi[ks]):"v"(vb),"i"(d0*4096+ks*1024+512):"memory");}
    asm volatile("s_waitcnt lgkmcnt(0)":::"memory");SBAR();
    #define PK(k) (bf16x8){lo[k][0],lo[k][1],lo[k][2],lo[k][3],hi[k][0],hi[k][1],hi[k][2],hi[k][3]}
    o[d0]=__builtin_amdgcn_mfma_f32_32x32x16_bf16(pa0,PK(0),o[d0],0,0,0);
    o[d0]=__builtin_amdgcn_mfma_f32_32x32x16_bf16(pa1,PK(1),o[d0],0,0,0);
    o[d0]=__builtin_amdgcn_mfma_f32_32x32x16_bf16(pa2,PK(2),o[d0],0,0,0);
    o[d0]=__builtin_amdgcn_mfma_f32_32x32x16_bf16(pa3,PK(3),o[d0],0,0,0);
    #undef PK
  }
}

#ifndef ATTN_STORE16
#define ATTN_STORE16(p,v) (*(u32x4*)(p)=(v))
#endif
template<int THRL> __device__ __forceinline__ void attn_unit(int b,int h,int cm,int vh,int qb,int tskip,const bf16*__restrict__ P,bf16*O,char*shm){
  const int tid=threadIdx.x,lane=tid&63,r32=lane&31,hi=lane>>5; const int wid=__builtin_amdgcn_readfirstlane(tid>>6);
  const long rowbase=(long)b*SEQ; const int q0=qb*QB;
  const bf16*Qw=P+(rowbase+q0+wid*QBLK)*DM+h*128+cm*64;
  const bf16*Kh=P+(rowbase+(long)tskip*KVBLK)*DM+512+h*128+cm*64,*Vh=P+(rowbase+(long)tskip*KVBLK)*DM+1024+h*128+vh*64;
  const unsigned lds0=(unsigned)(uintptr_t)shm;
  float*wsf=(float*)(shm+LDS_WS)+wid*64;
  const bf16*ksrc=Kh+(long)lane*DM+wid*8;
  const bf16*vsrc=Vh+(long)(16*(wid&3)+(lane>>2))*DM+(wid>>2)*32+(lane&3)*8;
  const unsigned kdst=lds0+LDS_K+wid*1024, vdst=lds0+LDS_V+wid*1024;
  #define DMA_K(t,slot) glds16(ksrc+(long)(t)*KVBLK*DM,(unsigned)__builtin_amdgcn_readfirstlane(kdst+(slot)))
  #define DMA_V(t,slot) glds16(vsrc+(long)(t)*KVBLK*DM,(unsigned)__builtin_amdgcn_readfirstlane(vdst+(slot)))
  const int vb0=(int)(lds0+LDS_V)+((lane>>4)&1)*32+(lane&3)*8+(4*hi+((lane&15)>>2))*64;
  const char*Kbase=shm+LDS_K; bf16x8 kf[8];
  const lds_cptr shm3=(lds_cptr)shm; const lds_cptr kp0=shm3+LDS_K+hi*1024+r32*16; const lds_cptr vp0=shm3+LDS_V+((lane>>4)&1)*32+(lane&3)*8+(4*hi+((lane&15)>>2))*64;
  const int NT=(q0+QB)/KVBLK-tskip;
  DMA_K(0,0);DMA_V(0,0);DMA_K(1,SLOTB);
  bf16x8 qr[4];
  #pragma unroll
  for(int d0=0;d0<4;++d0)qr[d0]=*reinterpret_cast<const bf16x8*>(&Qw[(long)r32*DM+d0*16+hi*8]);
  float mhat=0.f,l_reg=0.f;f32x16 o[2];o[0]=f32x16{};o[1]=f32x16{};
  s16x4 qx,kx0,kx1; unsigned jp0,jp1;
  { const float sl2=exp2f(-2.0f*(float)(h+1))*1.4426950408889634f; const unsigned s0=bfb(sl2); const float r1=sl2-bff(s0); const unsigned s1=bfb(r1); const float r2=r1-bff(s1); const unsigned s2=bfb(r2);
    const unsigned a0=s0|(s1<<16), a1=s2|(bfb(64.f*bff(s0))<<16), b0=bfb(64.f*bff(s1))|(bfb(64.f*bff(s2))<<16);
    u32x2_t qq; qq.x=hi?b0:a0; qq.y=hi?0u:a1; qx=__builtin_bit_cast(s16x4,qq);
    jp0=bfb((float)r32); jp1=bfb((float)(r32+32)); }
  #define KXSET(t) do{ const unsigned tb_=__float_as_uint((float)(t))>>16; u32x2_t k0_,k1_; \
    k0_.x=hi?(tb_|(tb_<<16)):(jp0|(jp0<<16)); k0_.y=hi?0x3f803f80u:(jp0|(tb_<<16)); k1_.x=hi?(tb_|(tb_<<16)):(jp1|(jp1<<16)); k1_.y=hi?0x3f803f80u:(jp1|(tb_<<16)); \
    kx0=__builtin_bit_cast(s16x4,k0_); kx1=__builtin_bit_cast(s16x4,k1_); }while(0)
  #define SETRHO(newr,eff) do{ const float nx_=-(newr); const unsigned nh_=bfb(nx_); const float nl_f=nx_-bff(nh_); const unsigned nl_=bfb(nl_f); eff=-(bff(nh_)+bff(nl_)); \
    if(hi){ u32x2_t q_=__builtin_bit_cast(u32x2_t,qx); q_.y=nh_|(nl_<<16); qx=__builtin_bit_cast(s16x4,q_); } }while(0)
  const int qrel=wid*QBLK+r32;
  #define CMASK(P0,P1,t) do{int jb_=(t)-(NT-4); if(jb_>=0)cmask(P0,P1,jb_,qrel,hi);}while(0)
  bool resc=false;
  #define START(P0,P1) do{ const float rm=rowmax(P0,P1); resc=false; \
    { float dl; SETRHO(rm,dl); mhat=dl; \
      _Pragma("unroll") for(int r=0;r<16;++r){P0[r]=fsub_s(P0[r],dl);P1[r]=fsub_s(P1[r],dl);} } \
    _Pragma("unroll") for(int r=0;r<16;++r)P0[r]=__builtin_amdgcn_exp2f(P0[r]); }while(0)
  #define RESC() do{ if(resc){ asm volatile("s_waitcnt lgkmcnt(0)":::"memory"); \
      _Pragma("unroll") for(int d_=0;d_<2;++d_) _Pragma("unroll") for(int r=0;r<16;++r)o[d_][r]*=wsf[crow(r,hi)]; } }while(0)
  f32x16 pA0,pA1,pB0,pB1;
  int sl_prev=0,sl_cur=0,sl_next=SLOTB;
  #define ROT() do{sl_prev=sl_cur;sl_cur=sl_next;sl_next=(sl_next==(NSLOT-1)*SLOTB)?0:sl_next+SLOTB;}while(0)
  DMA_K(2,2*SLOTB);
  WAIT_BAR(3);
  KXSET(0); qkt(pA0,pA1,Kbase,qr,kx0,kx1,qx,r32,hi);asm volatile("s_nop 15\n\ts_nop 7":"+v"(pA0),"+v"(pA1));CMASK(pA0,pA1,0);
  START(pA0,pA1);
  _Pragma("unroll") for(int r=0;r<16;++r)pA1[r]=__builtin_amdgcn_exp2f(pA1[r]);
  WAIT_BAR(0);
  DMA_K(3,0);DMA_V(1,SLOTB);
  ROT();
  kload8(kf,kp0+sl_cur);
  WAIT_BAR(2);
  s16x4 vlo[8],vhi[8]; u32x4 pw0,pw1,pw2,pw3;
  #define PKW(P,B) cvtpk_s(P[B],P[B+1])
  #define PAF(k) __builtin_bit_cast(bf16x8,pw##k)
  #define VFR(i) (bf16x8){vlo[i][0],vlo[i][1],vlo[i][2],vlo[i][3],vhi[i][0],vhi[i][1],vhi[i][2],vhi[i][3]}
  #define PIN(x) asm volatile("":"+v"(x))
  #define MX3(a,b,c) __builtin_fmaxf(__builtin_fmaxf((a),(b)),(c))
  #define GAPA(MF,A0,A1,A2,A3,W0,W1,PW) do{ MF; sacc+=A0; sacc+=A1; sacc+=A2; sacc+=A3; PIN(sacc); W0; W1; PIN(PW); SBAR(); }while(0)
  #define EX(v) __builtin_amdgcn_exp2f(v)
  #define GAPB(MF,X,B) do{ MF; X[B]=EX(X[B]); X[B+1]=EX(X[B+1]); X[B+2]=EX(X[B+2]); X[B+3]=EX(X[B+3]); PIN(X); SBAR(); }while(0)
  #define VRD(i) do{ vlo[i]=vtr(vp_+(((i)>>2)*4096+((i)&3)*1024)); vhi[i]=vtr(vp_+(((i)>>2)*4096+((i)&3)*1024+512)); }while(0)
  #define KRD(G,j) do{ if(G){ kload2(kf,kp0+sl_next,j); SBAR(); } }while(0)
  #define STEP(C0,C1,P0,P1,t,GK,GV,GL) do{ SBAR(); \
    const lds_cptr vp_=vp0+sl_prev; \
    KXSET(t); { const f32x16 Z_=f32x16{}; C0=MFMA8(kx0,qx,Z_); C1=MFMA8(kx1,qx,Z_); } SBAR(); \
    VRD(0); SBAR(); float sacc=(P0[0]+P0[1]); \
    GAPA(C0=__builtin_amdgcn_mfma_f32_32x32x16_bf16(kf[0],qr[0],C0,0,0,0), P0[2],P0[3],P0[4],P0[5],     pw0[0]=PKW(P0,0), pw0[1]=PKW(P0,2), pw0); \
    VRD(4); SBAR(); GAPA(C1=__builtin_amdgcn_mfma_f32_32x32x16_bf16(kf[1],qr[0],C1,0,0,0), P0[6],P0[7],P0[8],P0[9],     pw0[2]=PKW(P0,4), pw0[3]=PKW(P0,6), pw0); \
    VRD(1); SBAR(); GAPA(C0=__builtin_amdgcn_mfma_f32_32x32x16_bf16(kf[2],qr[1],C0,0,0,0),   P0[10],P0[11],P0[12],P0[13], pw1[0]=PKW(P0,8), pw1[1]=PKW(P0,10), pw1); \
    VRD(5); SBAR(); GAPA(C1=__builtin_amdgcn_mfma_f32_32x32x16_bf16(kf[3],qr[1],C1,0,0,0),   P0[14],P0[15],P1[0],P1[1],   pw1[2]=PKW(P0,12),pw1[3]=PKW(P0,14), pw1); \
    VRD(2); SBAR(); GAPA(C0=__builtin_amdgcn_mfma_f32_32x32x16_bf16(kf[4],qr[2],C0,0,0,0),   P1[2],P1[3],P1[4],P1[5],     pw2[0]=PKW(P1,0), pw2[1]=PKW(P1,2), pw2); \
    VRD(6); SBAR(); GAPA(C1=__builtin_amdgcn_mfma_f32_32x32x16_bf16(kf[5],qr[2],C1,0,0,0),   P1[6],P1[7],P1[8],P1[9],     pw2[2]=PKW(P1,4), pw2[3]=PKW(P1,6), pw2); \
    VRD(3); SBAR(); GAPA(C0=__builtin_amdgcn_mfma_f32_32x32x16_bf16(kf[6],qr[3],C0,0,0,0),   P1[10],P1[11],P1[12],P1[13], pw3[0]=PKW(P1,8), pw3[1]=PKW(P1,10), pw3); \
    VRD(7); SBAR(); GAPA(C1=__builtin_amdgcn_mfma_f32_32x32x16_bf16(kf[7],qr[3],C1,0,0,0),   P1[14],P1[15],0.f,0.f,       pw3[2]=PKW(P1,12),pw3[3]=PKW(P1,14), pw3); \
    l_reg+=sacc; \
    if(GK){DMA_K((t)+3,sl_cur);} if(GV){DMA_V((t)+1,sl_next);} \
    CMASK(C0,C1,t); \
    { float a=MX3(C0[0],C0[1],C1[0]),b=MX3(C0[2],C0[3],C1[1]); a=MX3(a,C1[2],C1[3]); \
      _Pragma("unroll") for(int r=4;r<16;r+=4){a=MX3(a,C0[r],C0[r+1]);b=MX3(b,C0[r+2],C0[r+3]);a=MX3(a,C1[r],C1[r+1]);b=MX3(b,C1[r+2],C1[r+3]);} \
      float rm=__builtin_fmaxf(a,b); { auto rr=__builtin_amdgcn_permlane32_swap(__float_as_uint(rm),__float_as_uint(rm),false,false); rm=__builtin_fmaxf(__uint_as_float(rr[0]),__uint_as_float(rr[1])); } \
      resc=false; \
      if(__builtin_expect(__any(rm>(float)THRL),0)){ const float nr_=mhat+__builtin_fmaxf(rm,0.f); float ne_; SETRHO(nr_,ne_); const float dl=ne_-mhat; mhat=ne_; \
        _Pragma("unroll") for(int r=0;r<16;++r){C0[r]-=dl;C1[r]-=dl;} \
        const float f=__builtin_amdgcn_exp2f(-dl); l_reg*=f; if(hi==0)wsf[r32]=f; resc=true; } } \
    SBAR(); \
    GAPB(o[0]=__builtin_amdgcn_mfma_f32_32x32x16_bf16(PAF(0),VFR(0),o[0],0,0,0), C0,0); \
    GAPB(o[1]=__builtin_amdgcn_mfma_f32_32x32x16_bf16(PAF(0),VFR(4),o[1],0,0,0), C0,4); \
    KRD(GL,0); GAPB(o[0]=__builtin_amdgcn_mfma_f32_32x32x16_bf16(PAF(1),VFR(1),o[0],0,0,0), C0,8); \
    KRD(GL,1); GAPB(o[1]=__builtin_amdgcn_mfma_f32_32x32x16_bf16(PAF(1),VFR(5),o[1],0,0,0), C0,12); \
    KRD(GL,2); GAPB(o[0]=__builtin_amdgcn_mfma_f32_32x32x16_bf16(PAF(2),VFR(2),o[0],0,0,0), C1,0); \
    KRD(GL,3); GAPB(o[1]=__builtin_amdgcn_mfma_f32_32x32x16_bf16(PAF(2),VFR(6),o[1],0,0,0), C1,4); \
    GAPB(o[0]=__builtin_amdgcn_mfma_f32_32x32x16_bf16(PAF(3),VFR(3),o[0],0,0,0), C1,8); \
    GAPB(o[1]=__builtin_amdgcn_mfma_f32_32x32x16_bf16(PAF(3),VFR(7),o[1],0,0,0), C1,12); \
    }while(0)
  int t=1;
  #undef CMASK
  #define CMASK(P0,P1,t) do{}while(0)
  for(;t+5<NT;t+=2){
    STEP(pB0,pB1,pA0,pA1,t,true,true,true);     WAIT_BAR(2); RESC(); ROT();
    STEP(pA0,pA1,pB0,pB1,t+1,true,true,true);   WAIT_BAR(2); RESC(); ROT();
  }
  #undef CMASK
  #define CMASK(P0,P1,t) do{int jb_=(t)-(NT-4); if(jb_>=0)cmask(P0,P1,jb_,qrel,hi);}while(0)
  #define ENDW(tt) do{ if((tt)+3<NT){WAIT_BAR(2);} else if((tt)+2<NT){WAIT_BAR(1);} else {WAIT_BAR(0);} }while(0)
  for(;t+1<NT;t+=2){
    STEP(pB0,pB1,pA0,pA1,t,(t+3<NT),(t+1<NT),(t+1<NT));       ENDW(t);   RESC(); ROT();
    STEP(pA0,pA1,pB0,pB1,t+1,(t+4<NT),(t+2<NT),(t+2<NT));     ENDW(t+1); RESC(); ROT();
  }
  STEP(pB0,pB1,pA0,pA1,NT-1,false,false,false); RESC();
  { float sacc=pB0[0]+pB0[1]; _Pragma("unroll") for(int r=2;r<16;++r)sacc+=pB0[r]; _Pragma("unroll") for(int r=0;r<16;++r)sacc+=pB1[r]; l_reg+=sacc;
    pw0=(u32x4){PKW(pB0,0),PKW(pB0,2),PKW(pB0,4),PKW(pB0,6)};pw1=(u32x4){PKW(pB0,8),PKW(pB0,10),PKW(pB0,12),PKW(pB0,14)};pw2=(u32x4){PKW(pB1,0),PKW(pB1,2),PKW(pB1,4),PKW(pB1,6)};pw3=(u32x4){PKW(pB1,8),PKW(pB1,10),PKW(pB1,12),PKW(pB1,14)};
    SBAR(); pv(o,vb0+sl_cur,PAF(0),PAF(1),PAF(2),PAF(3)); }
  #undef PKW
  #undef PAF
  #undef VFR
  #undef PIN
  #undef MX3
  #undef GAPA
  #undef GAPB
  #undef EX
  #undef VRD
  #undef KRD
  #undef STEP
  #undef ENDW
  {auto rr=__builtin_amdgcn_permlane32_swap(__float_as_uint(l_reg),__float_as_uint(l_reg),false,false);l_reg=__uint_as_float(rr[0])+__uint_as_float(rr[1]);}
  if(hi==0)wsf[32+r32]=l_reg;asm volatile("s_waitcnt lgkmcnt(0)":::"memory");
  float rli[16];
  #pragma unroll
  for(int r=0;r<16;++r)rli[r]=__builtin_amdgcn_rcpf(wsf[32+crow(r,hi)]);
  bf16*Ow=O+(rowbase+q0+wid*QBLK)*OPITCH+cm*512+h*128+vh*64;
  { bf16*stg=(bf16*)(shm+LDS_OST)+wid*2048;
    #pragma unroll
    for(int r=0;r<16;++r){const int orow=crow(r,hi);
      #pragma unroll
      for(int d0=0;d0<2;++d0)stg[orow*64+d0*32+r32]=__float2bfloat16(o[d0][r]*rli[r]);}
    asm volatile("s_waitcnt lgkmcnt(0)":::"memory");
    #pragma unroll
    for(int i=0;i<4;++i){const int row=i*8+(lane>>3),ch=lane&7; const u32x4 v=*(const u32x4*)(stg+row*64+ch*8); ATTN_STORE16(Ow+(long)row*OPITCH+ch*8,v);} }
  asm volatile("s_waitcnt lgkmcnt(0)\n\ts_barrier":::"memory");
  #undef DMA_K
  #undef DMA_V
  #undef KXSET
  #undef SETRHO
  #undef CMASK
  #undef START
  #undef RESC
  #undef ROT
}
constexpr int ATTN_LDS_BYTES=LDS_BYTES;
#undef SBAR
#undef WAIT_BAR
}
#define GAS __attribute__((address_space(1)))
#define LAS __attribute__((address_space(3)))
typedef unsigned short bf16;
typedef unsigned v4u __attribute__((ext_vector_type(4)));
typedef float f32x4 __attribute__((ext_vector_type(4)));
typedef short bf16x8 __attribute__((ext_vector_type(8)));
typedef GAS unsigned gu32;
typedef GAS unsigned long long gu64;
#define RLX_AGENT __ATOMIC_RELAXED, __HIP_MEMORY_SCOPE_AGENT
#define LDS_WAIT() asm volatile("s_waitcnt lgkmcnt(0)" ::: "memory")
#define VM_WAIT() asm volatile("s_waitcnt vmcnt(0)" ::: "memory")
__device__ __forceinline__ unsigned long long rt() { return __builtin_amdgcn_s_memrealtime(); }
__device__ __forceinline__ unsigned f2bf(float f) { unsigned u = __builtin_bit_cast(unsigned, f); return (u + 0x7fffu + ((u >> 16) & 1u)) >> 16; }
__device__ __forceinline__ unsigned pk2(float lo, float hi) { return f2bf(lo) | (f2bf(hi) << 16); }

#define XB_TMO      128
#define XB_XCNT(j)  (256  + 64 * (j))
#define XB_XSUB(j)  (1280 + 64 * (j))
#define XB_XGEN(j)  (2304 + 64 * (j))
#define XB_TOP      3328
#define XB_TOPGEN   3392
#define XCD_BAR_WORDS 3456
#define XB_SPIN_CAP (1u << 18)

__device__ __forceinline__ unsigned xb_ld(unsigned* p)              { return __hip_atomic_load(p, __ATOMIC_RELAXED, __HIP_MEMORY_SCOPE_AGENT); }
__device__ __forceinline__ unsigned xb_add(unsigned* p, unsigned v) { return __hip_atomic_fetch_add(p, v, __ATOMIC_RELAXED, __HIP_MEMORY_SCOPE_AGENT); }
__device__ __forceinline__ unsigned xb_xcc_id() { return (unsigned)__builtin_amdgcn_s_getreg((3 << 11) | 20) & 0xFu; }
#define XB_SPIN(cond, bar) do { unsigned _sp = 0; while (cond) { __builtin_amdgcn_s_sleep(1); \
    if ((++_sp & 255u) == 0u) { if (xb_ld(&(bar)[XB_TMO])) break; if (_sp > XB_SPIN_CAP) { atomicAdd(&(bar)[XB_TMO], 1u); break; } } } } while (0)

struct XcdBarrier {
    unsigned* bar; unsigned x;
    volatile LAS unsigned* st;
};

__device__ __forceinline__ XcdBarrier xcd_barrier_post(unsigned* bar, volatile LAS unsigned* st) {
    XcdBarrier b; b.bar = bar; b.x = xb_xcc_id(); b.st = st;
    if (threadIdx.x == 0) (void)xb_add(&bar[XB_XCNT(b.x)], 1u);
    return b;
}
__device__ __forceinline__ void xcd_barrier_complete(unsigned* bar, unsigned x, unsigned& nloc, unsigned& nx) {
    const unsigned G = gridDim.x * gridDim.y * gridDim.z;
    unsigned sum, cnt, mine, sp = 0u;
    for (;;) {
        sum = 0u; cnt = 0u; mine = 0u;
#pragma unroll
        for (unsigned j = 0; j < 16; ++j) { const unsigned c = xb_ld(&bar[XB_XCNT(j)]); sum += c; cnt += (c > 0u) ? 1u : 0u; mine = (j == x) ? c : mine; }
        if (sum == G) break;
        __builtin_amdgcn_s_sleep(1);
        if ((++sp & 255u) == 0u) { if (xb_ld(&bar[XB_TMO])) break; if (sp > XB_SPIN_CAP) { atomicAdd(&bar[XB_TMO], 1u); break; } }
    }
    nloc = mine > 0u ? mine : 1u; nx = cnt > 0u ? cnt : 1u;
}

__device__ __forceinline__ void xcd_barrier(const XcdBarrier& b) {
    asm volatile("s_waitcnt vmcnt(0)" ::: "memory");
    __syncthreads();
    if (threadIdx.x == 0) {
        unsigned* bar = b.bar;
        __builtin_amdgcn_s_waitcnt(0);
        unsigned nloc = b.st[0], nx = b.st[1];
        if (nloc == 0u) { xcd_barrier_complete(bar, b.x, nloc, nx); b.st[0] = nloc; b.st[1] = nx; }
        const unsigned old = xb_add(&bar[XB_XSUB(b.x)], 1u);
        const unsigned gen = old / nloc;
        if (old + 1u == (gen + 1u) * nloc) {
            __builtin_amdgcn_fence(__ATOMIC_RELEASE, "agent");
            asm volatile("s_waitcnt vmcnt(0)" ::: "memory");
            const unsigned og = xb_add(&bar[XB_TOP], 1u);
            const unsigned tg = og / nx;
            if (og + 1u == (tg + 1u) * nx) xb_add(&bar[XB_TOPGEN], 1u);
            else XB_SPIN(xb_ld(&bar[XB_TOPGEN]) == tg, bar);
            __builtin_amdgcn_fence(__ATOMIC_ACQUIRE, "agent");
            xb_add(&bar[XB_XGEN(b.x)], 1u);
            asm volatile("s_waitcnt vmcnt(0)" ::: "memory");
        } else {
            XB_SPIN(xb_ld(&bar[XB_XGEN(b.x)]) == gen, bar);
            __builtin_amdgcn_fence(__ATOMIC_ACQUIRE, "agent");
            asm volatile("s_waitcnt vmcnt(0)" ::: "memory");
        }
    }
    __syncthreads();
}

#include <hip/hip_cooperative_groups.h>
namespace cg = cooperative_groups;
constexpr int NWAVES = 8;
constexpr int SEQ = 8192, D = 1024, M = 16384, DFF = 2816, NUP = 5632, NINP = 3592, NPROJ = 3584;
constexpr float EPS = 1e-6f;
constexpr size_t MiB = 1u << 20;
constexpr size_t WS_CTL = 0, CTL_ZERO_BYTES = 1 * MiB;
constexpr size_t WS_WIN = 2 * MiB, WS_WO = 9 * MiB, WS_WUP = 11 * MiB, WS_WDN = 22 * MiB, WS_GAB = 28 * MiB, WS_HALO = 29 * MiB, WS_GL = 35 * MiB;
constexpr size_t WS_XN = 36 * MiB;
constexpr size_t WS_PREP = 36 * MiB;
constexpr size_t WS_G = 68 * MiB;
constexpr size_t WS_PA = 124 * MiB;
constexpr size_t WS_PG = 188 * MiB;
constexpr size_t WS_OATT = 188 * MiB;
constexpr size_t WS_OG = 220 * MiB;
constexpr size_t WS_X1 = 188 * MiB;
constexpr size_t WS_END = 252 * MiB;
constexpr int CW_NORM = 704;
constexpr int CW_QUEUE = 64;
constexpr int CW_BAR = 4096;
constexpr int PREP_STRIDE = 90112, PO_W = 0, PO_QD = 16384, PO_KDT = 32768, PO_QK = 49152, PO_U = 57344;
constexpr int RING_BYTES = 131072, XH_OFF = RING_BYTES, MISC_OFF = XH_OFF + 8192, LDS_BYTES = 147456;

struct Frame {
    LAS unsigned char* lds; volatile LAS unsigned* MISC;
    int vcu, G;
};
__device__ __forceinline__ float wave_sum(float v) {
#pragma unroll
    for (int o = 1; o < 64; o <<= 1) v += __shfl_xor(v, o);
    return v;
}
__device__ __forceinline__ float bf2f(unsigned short b) { return __uint_as_float(((unsigned)b) << 16); }
typedef float f32x2m_t __attribute__((ext_vector_type(2))); typedef __bf16 bf16x2m_t __attribute__((ext_vector_type(2)));
__device__ __forceinline__ unsigned cvtpk(float lo, float hi) { f32x2m_t v = {lo, hi}; bf16x2m_t b = __builtin_convertvector(v, bf16x2m_t); return __builtin_bit_cast(unsigned, b); }

__device__ __forceinline__ void p0_transpose_item(const float* W, int pitch, int col0, int k0, bf16* WT, int n0, int K, LAS float* scr, int lane) {
#pragma unroll 8
    for (int i = 0; i < 32; ++i) { const int kk = 2 * i + (lane >> 5); scr[kk * 33 + (lane & 31)] = W[(size_t)(k0 + kk) * pitch + col0 + (lane & 31)]; }
    LDS_WAIT(); asm volatile("" ::: "memory");
    const int c = lane & 7;
#pragma unroll
    for (int j = 0; j < 4; ++j) { const int n = (lane >> 3) + 8 * j; const LAS float* s = scr + (8 * c) * 33 + n;
        v4u o; o.x = pk2(s[0 * 33], s[1 * 33]); o.y = pk2(s[2 * 33], s[3 * 33]); o.z = pk2(s[4 * 33], s[5 * 33]); o.w = pk2(s[6 * 33], s[7 * 33]);
        *(GAS v4u*)(WT + (size_t)(n0 + n) * K + k0 + 8 * c) = o; }
    LDS_WAIT(); asm volatile("" ::: "memory");
}
__device__ __forceinline__ void rms_row(const float* xrow, const float* gain, int lane, f32x4 (&v)[4]) {
    const GAS f32x4* xr = (const GAS f32x4*)xrow + lane; const GAS f32x4* gr = (const GAS f32x4*)gain + lane;
    float s = 0.f;
#pragma unroll
    for (int j = 0; j < 4; ++j) { v[j] = xr[64 * j]; s += (v[j].x * v[j].x + v[j].y * v[j].y) + (v[j].z * v[j].z + v[j].w * v[j].w); }
    const float r = 1.0f / sqrtf(wave_sum(s) * (1.f / D) + EPS);
#pragma unroll
    for (int j = 0; j < 4; ++j) { const f32x4 g = gr[64 * j]; v[j] = v[j] * r * g; }
}
__device__ __forceinline__ void store_row_bf16(bf16* orow, int lane, const f32x4 (&v)[4]) {
    GAS unsigned long long* o8 = (GAS unsigned long long*)orow + lane;
#pragma unroll
    for (int j = 0; j < 4; ++j) o8[64 * j] = (unsigned long long)cvtpk(v[j].x, v[j].y) | ((unsigned long long)cvtpk(v[j].z, v[j].w) << 32);
}

namespace gdn {
typedef float f32x16 __attribute__((ext_vector_type(16)));
constexpr int KP = 136, L_KBF = 0, L_KBB = 17408, L_QBF = 34816, L_KDEC = 52224, L_R = 69632, RP = 132, L_LM = 103424, LP = 68, L_GC = 120832, L_BETA = 121088;
__device__ __forceinline__ int crow(int r, int hi) { return (r & 3) + 8 * (r >> 2) + 4 * hi; }
#define GDN_BAR() asm volatile("s_waitcnt lgkmcnt(0)\n\ts_barrier" ::: "memory")
__device__ __forceinline__ void prep_chunk(LAS unsigned char* lds, int tid, int chunk, const bf16* PG, const float* GAB, const float* convw, const float* a_log, const float* dt_bias,
                                           unsigned char* prep, float* GL) {
    const int lane = tid & 63, wid = __builtin_amdgcn_readfirstlane(tid >> 6);
    const int bh = chunk >> 7, n = chunk & 127, b = bh >> 2, h = bh & 3; const int row0 = b * SEQ + n * 64;
    LAS float* gcs = (LAS float*)(lds + L_GC); LAS float* betas = (LAS float*)(lds + L_BETA);
    unsigned char* cb = prep + (size_t)chunk * PREP_STRIDE;
    if (wid == 0) {
        const float ga = GAB[(size_t)(row0 + lane) * 8 + h], gb = GAB[(size_t)(row0 + lane) * 8 + 4 + h];
        const float xs = ga + dt_bias[h]; const float sp = xs > 20.f ? xs : log1pf(__expf(xs));
        float g = -__expf(a_log[h]) * sp;
#pragma unroll
        for (int o = 1; o < 64; o <<= 1) { const float t = __shfl_up(g, o); if (lane >= o) g += t; }
        gcs[lane] = g; betas[lane] = 1.0f / (1.0f + __expf(-gb));
        if (lane == 63) GL[chunk] = __expf(g);
    }
    GDN_BAR();
    const float gc_last = gcs[63];
    {
        const int sub = tid & 15, pl = tid >> 4;
#pragma unroll
        for (int tensor = 0; tensor < 3; ++tensor) {
            const int col = tensor * 512 + h * 128 + sub * 8;
            f32x4 wv[4][2];
#pragma unroll
            for (int j = 0; j < 4; ++j) { wv[j][0] = *(const f32x4*)(convw + j * 1536 + col); wv[j][1] = *(const f32x4*)(convw + j * 1536 + col + 4); }
#pragma unroll
            for (int ph = 0; ph < 2; ++ph) {
                const int p = ph * 32 + pl;
                float y[8];
#pragma unroll
                for (int e = 0; e < 8; ++e) y[e] = 0.f;
#pragma unroll
                for (int j = 0; j < 4; ++j) {
                    const int pr = p - 3 + j;
                    v4u raw = (v4u){0u, 0u, 0u, 0u};
                    if (n > 0 || pr >= 0) raw = *(const GAS v4u*)(PG + (size_t)(row0 + pr) * 1536 + col);
#pragma unroll
                    for (int q = 0; q < 4; ++q) { y[2 * q] += wv[j][q >> 1][(2 * q) & 3] * __uint_as_float(raw[q] << 16); y[2 * q + 1] += wv[j][q >> 1][(2 * q + 1) & 3] * __uint_as_float(raw[q] & 0xffff0000u); }
                }
                float ss = 0.f;
#pragma unroll
                for (int e = 0; e < 8; ++e) { y[e] = pg8::silu_f(y[e]); ss += y[e] * y[e]; }
                const float gcp = gcs[p], bp = betas[p];
                if (tensor < 2) {
                    ss += __shfl_xor(ss, 1); ss += __shfl_xor(ss, 2); ss += __shfl_xor(ss, 4); ss += __shfl_xor(ss, 8);
                    float rn = 1.0f / sqrtf(ss + EPS); if (tensor == 0) rn *= 0.08838834764831845f;
#pragma unroll
                    for (int e = 0; e < 8; ++e) y[e] *= rn;
                    v4u o; o.x = cvtpk(y[0], y[1]); o.y = cvtpk(y[2], y[3]); o.z = cvtpk(y[4], y[5]); o.w = cvtpk(y[6], y[7]);
                    if (tensor == 0) {
                        *(LAS v4u*)(lds + L_QBF + (p * KP + sub * 8) * 2) = o;
                        const float eg = __expf(gcp); v4u d; d.x = cvtpk(y[0] * eg, y[1] * eg); d.y = cvtpk(y[2] * eg, y[3] * eg); d.z = cvtpk(y[4] * eg, y[5] * eg); d.w = cvtpk(y[6] * eg, y[7] * eg);
                        *(GAS v4u*)(cb + PO_QD + (p * 128 + sub * 8) * 2) = d;
                    } else {
                        *(LAS v4u*)(lds + L_KBF + (p * KP + sub * 8) * 2) = o;
                        v4u kb; kb.x = cvtpk(y[0] * bp, y[1] * bp); kb.y = cvtpk(y[2] * bp, y[3] * bp); kb.z = cvtpk(y[4] * bp, y[5] * bp); kb.w = cvtpk(y[6] * bp, y[7] * bp);
                        *(LAS v4u*)(lds + L_KBB + (p * KP + sub * 8) * 2) = kb;
                        const float ed = __expf(gc_last - gcp); v4u kd; kd.x = cvtpk(y[0] * ed, y[1] * ed); kd.y = cvtpk(y[2] * ed, y[3] * ed); kd.z = cvtpk(y[4] * ed, y[5] * ed); kd.w = cvtpk(y[6] * ed, y[7] * ed);
                        *(LAS v4u*)(lds + L_KDEC + (p * KP + sub * 8) * 2) = kd;
                    }
                } else {
                    LAS float* R = (LAS float*)(lds + L_R) + p * RP + sub * 8;
                    *(LAS f32x4*)R = (f32x4){y[0] * bp, y[1] * bp, y[2] * bp, y[3] * bp}; *(LAS f32x4*)(R + 4) = (f32x4){y[4] * bp, y[5] * bp, y[6] * bp, y[7] * bp};
                }
            }
        }
    }
    GDN_BAR();
    {
        const int isqk = wid >> 2, tile = wid & 3, ti = tile >> 1, tj = tile & 1, r32 = lane & 31, hi = lane >> 5;
        bf16* qkg = (bf16*)(cb + PO_QK);
        if (!(ti == 0 && tj == 1)) {
            f32x16 acc = f32x16{};
            const LAS unsigned char* ap = lds + (isqk ? L_QBF : L_KBB) + ((32 * ti + r32) * KP + hi * 8) * 2;
            const LAS unsigned char* bp = lds + L_KBF + ((32 * tj + r32) * KP + hi * 8) * 2;
#pragma unroll
            for (int ks = 0; ks < 8; ++ks) acc = __builtin_amdgcn_mfma_f32_32x32x16_bf16(*(const LAS bf16x8*)(ap + ks * 32), *(const LAS bf16x8*)(bp + ks * 32), acc, 0, 0, 0);
            const int j = 32 * tj + r32; const float gcj = gcs[j];
#pragma unroll
            for (int r = 0; r < 16; ++r) {
                const int i = 32 * ti + crow(r, hi);
                const bool keep = isqk ? (j <= i) : (j < i);
                const float val = keep ? acc[r] * __expf(gcs[i] - gcj) : 0.f;
                if (isqk) qkg[i * 64 + j] = (bf16)f2bf(val); else ((LAS float*)(lds + L_LM))[i * LP + j] = val;
            }
        } else if (isqk) {
#pragma unroll
            for (int r = 0; r < 16; ++r) qkg[crow(r, hi) * 64 + 32 + r32] = 0;
        }
    }
    GDN_BAR();
    if (wid < 4) {
        const int c = tid; float x[64];
        int z_; asm volatile("v_mov_b32 %0, 0" : "=v"(z_));
        const LAS float* Lm = (const LAS float*)(lds + L_LM) + z_; const LAS float* gcv = gcs + z_;
        if (c < 128) {
#pragma unroll
            for (int p = 0; p < 64; ++p) x[p] = ((const LAS float*)(lds + L_R))[p * RP + c];
        } else {
#pragma unroll
            for (int p = 0; p < 64; ++p) x[p] = bf2f(((const LAS bf16*)(lds + L_KBB))[p * KP + (c - 128)]) * __expf(gcv[p]);
        }
#pragma unroll
        for (int i = 1; i < 64; ++i) {
            float a = x[i];
#pragma unroll
            for (int jj = 0; jj < (i + 3) / 4; ++jj) { const f32x4 l = *(const LAS f32x4*)(Lm + i * LP + 4 * jj);
#pragma unroll
                for (int e = 0; e < 4; ++e) if (4 * jj + e < i) a -= l[e] * x[4 * jj + e]; }
            x[i] = a;
        }
        if (c < 128) {
            float* ug = (float*)(cb + PO_U);
#pragma unroll
            for (int p = 0; p < 64; ++p) ug[p * 128 + c] = x[p];
        } else {
            bf16* wg = (bf16*)(cb + PO_W);
#pragma unroll
            for (int p = 0; p < 64; ++p) wg[p * 128 + (c - 128)] = (bf16)f2bf(x[p]);
        }
    } else {
        const int t2 = tid - 256;
#pragma unroll
        for (int it = 0; it < 2; ++it) {
            const int item = t2 + 256 * it, dk = item & 127, pgp = item >> 7;
            const LAS bf16* src = (const LAS bf16*)(lds + L_KDEC) + (16 * pgp) * KP + dk;
            unsigned w[8];
#pragma unroll
            for (int q = 0; q < 8; ++q) w[q] = (unsigned)src[(2 * q) * KP] | ((unsigned)src[(2 * q + 1) * KP] << 16);
            GAS v4u* dst = (GAS v4u*)(cb + PO_KDT + (dk * 64 + 16 * pgp) * 2);
            dst[0] = (v4u){w[0], w[1], w[2], w[3]}; dst[1] = (v4u){w[4], w[5], w[6], w[7]};
        }
    }
    GDN_BAR();
}

__device__ __forceinline__ void scan(LAS unsigned char* lds, int tid, int bh, int s, const unsigned char* prep, const float* GL, bf16* OG) {
    const int lane = tid & 63, wid = __builtin_amdgcn_readfirstlane(tid >> 6), r32 = lane & 31, hi = lane >> 5;
    const int b = bh >> 2, h = bh & 3;
    constexpr int SP = 136, VP = 72, L_ST = 0, L_VN = 32 * SP * 2;
    for (int i = tid; i < (32 * SP * 2 + 32 * VP * 2) / 4; i += 512) ((LAS unsigned*)lds)[i] = 0u;
    f32x16 Sacc = f32x16{};
    const int role = wid < 2 ? 0 : (wid < 4 ? 1 : 2);
    const int rb = wid & 1, db = wid & 3;
    const unsigned char* base = prep + (size_t)(bh * 128) * PREP_STRIDE;
    const unsigned char* pA = base + (role == 0 ? PO_W : PO_QD) + ((32 * rb + r32) * 128 + 8 * hi) * 2;
    const unsigned char* pB = base + (role == 1 ? PO_QK + ((32 * rb + r32) * 64 + 8 * hi) * 2 : PO_KDT + ((32 * db + r32) * 64 + 8 * hi) * 2);
    const unsigned char* pU = base + PO_U + (32 * rb * 128 + 32 * s + r32) * 4;
    bf16x8 fa[8], fb[4]; float uu[16]; float gl = 1.f;
#define SCAN_LOAD(ci) do { const size_t off_ = (size_t)(ci) * PREP_STRIDE; \
        if (role < 2) { _Pragma("unroll") for (int ks = 0; ks < 8; ++ks) fa[ks] = *(const GAS bf16x8*)(pA + off_ + ks * 32); } \
        if (role > 0) { _Pragma("unroll") for (int ks = 0; ks < 4; ++ks) fb[ks] = *(const GAS bf16x8*)(pB + off_ + ks * 32); } \
        if (role == 0) { _Pragma("unroll") for (int r = 0; r < 16; ++r) uu[r] = *(const GAS float*)(pU + off_ + crow(r, hi) * 512); } \
        if (role == 2) gl = GL[bh * 128 + (ci)]; } while (0)
    SCAN_LOAD(0);
    GDN_BAR();
    const LAS unsigned char* stp = lds + L_ST + (r32 * SP + 8 * hi) * 2;
    const LAS unsigned char* vnp = lds + L_VN + (r32 * VP + 8 * hi) * 2;
    for (int i = 0; i < 128; ++i) {
        bf16x8 ca[8], cbb[4]; float cu[16]; const float cgl = gl;
#pragma unroll
        for (int k = 0; k < 8; ++k) ca[k] = fa[k];
#pragma unroll
        for (int k = 0; k < 4; ++k) cbb[k] = fb[k];
#pragma unroll
        for (int r = 0; r < 16; ++r) cu[r] = uu[r];
        if (i + 1 < 128) SCAN_LOAD(i + 1);
        f32x16 acc = f32x16{};
        if (role < 2) {
#pragma unroll
            for (int ks = 0; ks < 8; ++ks) acc = __builtin_amdgcn_mfma_f32_32x32x16_bf16(ca[ks], *(const LAS bf16x8*)(stp + ks * 32), acc, 0, 0, 0);
            if (role == 0) {
                typedef unsigned u32x2v __attribute__((ext_vector_type(2)));
#pragma unroll
                for (int q = 0; q < 4; ++q) { u32x2v w; w.x = cvtpk(cu[4 * q] - acc[4 * q], cu[4 * q + 1] - acc[4 * q + 1]); w.y = cvtpk(cu[4 * q + 2] - acc[4 * q + 2], cu[4 * q + 3] - acc[4 * q + 3]);
                    *(LAS u32x2v*)(lds + L_VN + (r32 * VP + 32 * rb + 8 * q + 4 * hi) * 2) = w; }
            }
        }
        GDN_BAR();
        if (role == 1) {
#pragma unroll
            for (int ks = 0; ks < 4; ++ks) acc = __builtin_amdgcn_mfma_f32_32x32x16_bf16(cbb[ks], *(const LAS bf16x8*)(vnp + ks * 32), acc, 0, 0, 0);
            bf16* og = OG + (size_t)(b * SEQ + i * 64 + 32 * rb) * 512 + h * 128 + 32 * s + r32;
#pragma unroll
            for (int r = 0; r < 16; ++r) og[(size_t)crow(r, hi) * 512] = (bf16)f2bf(acc[r]);
        } else if (role == 2) {
            Sacc = Sacc * cgl;
#pragma unroll
            for (int ks = 0; ks < 4; ++ks) Sacc = __builtin_amdgcn_mfma_f32_32x32x16_bf16(cbb[ks], *(const LAS bf16x8*)(vnp + ks * 32), Sacc, 0, 0, 0);
            typedef unsigned u32x2v __attribute__((ext_vector_type(2)));
#pragma unroll
            for (int q = 0; q < 4; ++q) { u32x2v w; w.x = cvtpk(Sacc[4 * q], Sacc[4 * q + 1]); w.y = cvtpk(Sacc[4 * q + 2], Sacc[4 * q + 3]);
                *(LAS u32x2v*)(lds + L_ST + (r32 * SP + 32 * db + 8 * q + 4 * hi) * 2) = w; }
        }
        GDN_BAR();
    }
#undef SCAN_LOAD
}
}

struct Args { const float* in[19]; float* out; unsigned char* ws; };
__global__ void __launch_bounds__(NWAVES * 64, 2) mega_fwd(Args) {
    extern __shared__ __attribute__((aligned(16))) unsigned char lds[];
    cg::grid_group grid = cg::this_grid();
    Frame F;
    F.lds = (LAS unsigned char*)lds; F.MISC = (volatile LAS unsigned*)(F.lds + MISC_OFF);
    F.G = gridDim.x; { const int bx = blockIdx.x; F.vcu = (F.G % 8 == 0) ? (bx % 8) * (F.G / 8) + bx / 8 : bx; }
#define KARGP() const __attribute__((address_space(4))) unsigned long long* kp_ = (const __attribute__((address_space(4))) unsigned long long*)__builtin_amdgcn_kernarg_segment_ptr(); asm volatile("" : "+s"(kp_))
#define INP(k) ((const float*)(GAS const float*)(kp_[k]))
#define WSB ((unsigned char*)(GAS unsigned char*)(kp_[20]))
#define OUT ((float*)(GAS float*)(kp_[19]))
#define in_x INP(0)
#define attn_g INP(1)
#define w_in INP(2)
#define lq1 INP(3)
#define lk1 INP(4)
#define lq2 INP(5)
#define lk2 INP(6)
#define subln_g INP(7)
#define gconv_w INP(8)
#define a_log INP(9)
#define dt_bias INP(10)
#define gnorm_g INP(11)
#define w_out INP(12)
#define ffn_g INP(13)
#define w_up INP(14)
#define fconv_w INP(15)
#define fconv_b INP(16)
#define w_down INP(17)
#define final_g INP(18)
#define WinT ((bf16*)(WSB + WS_WIN))
#define WoT ((bf16*)(WSB + WS_WO))
#define WupT ((bf16*)(WSB + WS_WUP))
#define WdnT ((bf16*)(WSB + WS_WDN))
#define GAB ((float*)(WSB + WS_GAB))
#define HALO ((float*)(WSB + WS_HALO))
#define GL ((float*)(WSB + WS_GL))
#define XN ((bf16*)(WSB + WS_XN))
#define PREP (WSB + WS_PREP)
#define Gb ((bf16*)(WSB + WS_G))
#define PA ((bf16*)(WSB + WS_PA))
#define PGb ((bf16*)(WSB + WS_PG))
#define OATT ((bf16*)(WSB + WS_OATT))
#define OGb ((bf16*)(WSB + WS_OG))
#define X1 ((float*)(WSB + WS_X1))
#define CTLP ((gu32*)(GAS unsigned*)(kp_[20]))
    for (int u = threadIdx.x; u < (LDS_BYTES - MISC_OFF) / 4; u += NWAVES * 64) ((LAS unsigned*)(F.lds + MISC_OFF))[u] = 0u;
    __syncthreads();
    { KARGP(); (void)xcd_barrier_post((unsigned*)(CTLP + CW_BAR), F.MISC + 8); }
    grid.sync();
#ifdef TSTAMP
    if (blockIdx.x == 0 && threadIdx.x == 0) { KARGP(); ((unsigned long long*)(CTLP + 600))[0] = __builtin_amdgcn_s_memrealtime(); }
#endif
#define GRID_BAR() do { const __attribute__((address_space(4))) unsigned long long* kq_ = (const __attribute__((address_space(4))) unsigned long long*)__builtin_amdgcn_kernarg_segment_ptr(); asm volatile("" : "+s"(kq_)); \
        XcdBarrier b_; b_.bar = (unsigned*)(GAS unsigned*)(kq_[20]) + CW_BAR; b_.x = xb_xcc_id(); b_.st = F.MISC + 8; xcd_barrier(b_); } while (0)
#define PHASE_IDS() int tid = threadIdx.x; asm volatile("" : "+v"(tid)); const int lane = tid & 63, wave = __builtin_amdgcn_readfirstlane(tid >> 6); const int gw = F.vcu * NWAVES + wave, NGW = F.G * NWAVES; (void)lane; (void)gw; (void)NGW; KARGP()

    {
        PHASE_IDS();
        LAS float* scr = (LAS float*)(F.lds + wave * 16384);
        constexpr int I_IN = 112 * 16, I_O = 32 * 16, I_UP = 176 * 16, I_DN = 32 * 44, NITEMS = I_IN + I_O + I_UP + I_DN;
        for (int it = gw; it < NITEMS; it += NGW) {
            int r = it;
            if (r < I_IN) { const int nb = r % 112, kb = r / 112, n0 = 32 * nb; const int c0 = n0 < 1536 ? n0 : (n0 < 2048 ? 3080 + (n0 - 1536) : 1536 + (n0 - 2048));
                p0_transpose_item(w_in, NINP, c0, 64 * kb, WinT, n0, D, scr, lane); continue; } r -= I_IN;
            if (r < I_O) { const int nb = r % 32, kb = r / 32; p0_transpose_item(w_out, D, 32 * nb, 64 * kb, WoT, 32 * nb, D, scr, lane); continue; } r -= I_O;
            if (r < I_UP) { const int nb = r % 176, kb = r / 176; const int c0 = ((nb >> 2) & 1) * DFF + 128 * (nb >> 3) + 32 * (nb & 3);
                p0_transpose_item(w_up, NUP, c0, 64 * kb, WupT, 32 * nb, D, scr, lane); continue; } r -= I_UP;
            { const int nb = r % 32, kb = r / 32; p0_transpose_item(w_down, D, 32 * nb, 64 * kb, WdnT, 32 * nb, DFF, scr, lane); }
        }
        __syncthreads();
        LAS float* Wab = (LAS float*)F.lds;
        for (int i = tid; i < 2048; i += NWAVES * 64) { const int k = i >> 1, hf = i & 1; *(LAS f32x4*)(Wab + k * 8 + 4 * hf) = *(const f32x4*)(w_in + (size_t)k * NINP + 3072 + 4 * hf); }
        __syncthreads();
        for (int m = gw; m < M; m += NGW) {
            f32x4 v[4]; rms_row(in_x + (size_t)m * D, attn_g, lane, v);
            store_row_bf16(XN + (size_t)m * D, lane, v);
            float d8[8];
#pragma unroll
            for (int e = 0; e < 8; ++e) d8[e] = 0.f;
#pragma unroll
            for (int j = 0; j < 4; ++j)
#pragma unroll
                for (int q = 0; q < 4; ++q) { const int k = 4 * lane + 256 * j + q; const f32x4 wa = *(const LAS f32x4*)(Wab + k * 8), wb = *(const LAS f32x4*)(Wab + k * 8 + 4); const float hv = v[j][q];
                    d8[0] += hv * wa.x; d8[1] += hv * wa.y; d8[2] += hv * wa.z; d8[3] += hv * wa.w; d8[4] += hv * wb.x; d8[5] += hv * wb.y; d8[6] += hv * wb.z; d8[7] += hv * wb.w; }
#pragma unroll
            for (int e = 0; e < 8; ++e) d8[e] = wave_sum(d8[e]);
            if (lane == 0) { *(f32x4*)(GAB + (size_t)m * 8) = (f32x4){d8[0], d8[1], d8[2], d8[3]}; *(f32x4*)(GAB + (size_t)m * 8 + 4) = (f32x4){d8[4], d8[5], d8[6], d8[7]}; }
        }
    }
    GRID_BAR();
#ifdef TSTAMP
    if (blockIdx.x == 0 && threadIdx.x == 0) { KARGP(); ((unsigned long long*)(CTLP + 600))[1] = __builtin_amdgcn_s_memrealtime(); }
#endif
    {
        KARGP();
        pg8::Gemm g{XN, WinT, M, NPROJ, D}; pg8::StaticOrder S; S.init(M, NPROJ, F.G, (int)blockIdx.x);
        pg8::EpiProj E{PA, PGb, attn_body::C2};
        pg8::gemm_phase<pg8::EpiProj, pg8::StaticOrder, true, true>(F.lds, g, S, E);
    }
    GRID_BAR();
#ifdef TSTAMP
    if (blockIdx.x == 0 && threadIdx.x == 0) { KARGP(); ((unsigned long long*)(CTLP + 600))[2] = __builtin_amdgcn_s_memrealtime(); }
#endif
    { PHASE_IDS(); for (int ch = F.vcu; ch < 1024; ch += F.G) gdn::prep_chunk(F.lds, tid, ch, PGb, GAB, gconv_w, a_log, dt_bias, PREP, GL);
      float mx0 = 0.f, mx1 = 0.f;
      for (int m = gw; m < M; m += NGW) {
          const v4u r0 = *(const GAS v4u*)(PA + (size_t)m * 2048 + 16 * lane), r1 = *(const GAS v4u*)(PA + (size_t)m * 2048 + 16 * lane + 8); float ss = 0.f;
#pragma unroll
          for (int q = 0; q < 4; ++q) { const float a0 = __uint_as_float(r0[q] << 16), a1 = __uint_as_float(r0[q] & 0xffff0000u), b0 = __uint_as_float(r1[q] << 16), b1 = __uint_as_float(r1[q] & 0xffff0000u); ss += a0 * a0 + a1 * a1 + b0 * b0 + b1 * b1; }
          ss += __shfl_xor(ss, 1); ss += __shfl_xor(ss, 2);
          if ((m >> 13) == 0) mx0 = fmaxf(mx0, ss); else mx1 = fmaxf(mx1, ss); }
      if ((lane & 3) == 0) { atomicMax((unsigned*)(CTLP + CW_NORM + (lane >> 2)), __float_as_uint(mx0)); atomicMax((unsigned*)(CTLP + CW_NORM + 16 + (lane >> 2)), __float_as_uint(mx1)); }
    }
    GRID_BAR();
#ifdef TSTAMP
    if (blockIdx.x == 0 && threadIdx.x == 0) { KARGP(); ((unsigned long long*)(CTLP + 600))[3] = __builtin_amdgcn_s_memrealtime(); }
#endif
    {
        PHASE_IDS();
        if ((int)blockIdx.x >= F.G - 32) { const int si = (int)blockIdx.x - (F.G - 32); gdn::scan(F.lds, tid, si >> 2, si & 3, PREP, GL, OGb); }
        for (;;) {
            if (tid == 0) F.MISC[4] = __hip_atomic_fetch_add(CTLP + CW_QUEUE, 1u, __ATOMIC_RELAXED, __HIP_MEMORY_SCOPE_AGENT);
            __syncthreads();
            const int u = (int)F.MISC[4];
            __syncthreads();
            if (u >= 1024) break;
            const int qb = 31 - (u >> 5), vhd = u & 31; const int ab = vhd >> 4, ah = (vhd >> 2) & 3, ac = (vhd >> 1) & 1;
            int tsk = 0;
            { const float q2 = __uint_as_float(__hip_atomic_load((const unsigned*)(CTLP + CW_NORM + ab * 16 + ah * 2 + ac), __ATOMIC_RELAXED, __HIP_MEMORY_SCOPE_AGENT));
              const float k2 = __uint_as_float(__hip_atomic_load((const unsigned*)(CTLP + CW_NORM + ab * 16 + 8 + ah * 2 + ac), __ATOMIC_RELAXED, __HIP_MEMORY_SCOPE_AGENT));
              const float smax = sqrtf(q2 * k2) * 1.001f, sl2 = exp2f(-2.0f * (float)(ah + 1)) * 1.4426950408889634f;
              const float xk = (float)(256 * qb - 63) - (2.0f * smax + 40.0f) / sl2;
              if (xk >= 0.f) { tsk = ((int)(xk * (1.0f / 64.0f)) + 1) & ~1; if (tsk > 4 * qb) tsk = 4 * qb; }
              tsk = __builtin_amdgcn_readfirstlane(tsk); }
            attn_body::attn_unit<16>(ab, ah, ac, vhd & 1, qb, tsk, (const attn_body::bf16*)PA, (attn_body::bf16*)OATT, (char*)lds);
        }
    }
    GRID_BAR();
#ifdef TSTAMP
    if (blockIdx.x == 0 && threadIdx.x == 0) { KARGP(); ((unsigned long long*)(CTLP + 600))[4] = __builtin_amdgcn_s_memrealtime(); }
#endif
    {
        PHASE_IDS();
        float s1 = lq1[lane] * lk1[lane], s2 = lq2[lane] * lk2[lane];
        const float lam = __expf(wave_sum(s1)) - __expf(wave_sum(s2)) + 0.2f;
        const int a0 = 8 * lane, dd = 8 * (lane & 15);
        float sg[8], gg[8];
#pragma unroll
        for (int e = 0; e < 8; ++e) { sg[e] = subln_g[dd + e] * 0.8f; gg[e] = gnorm_g[dd + e]; }
        for (int m = gw; m < M; m += NGW) {
            const v4u o0 = *(const GAS v4u*)(OATT + (size_t)m * 1024 + a0), o1 = *(const GAS v4u*)(OATT + (size_t)m * 1024 + 512 + a0);
            const v4u og = *(const GAS v4u*)(OGb + (size_t)m * 512 + a0), zz = *(const GAS v4u*)(PA + (size_t)m * 2048 + 1536 + a0);
            float oa[8], ob[8], zf[8]; float ssa = 0.f, ssb = 0.f;
#pragma unroll
            for (int q = 0; q < 4; ++q) {
                oa[2 * q] = __uint_as_float(o0[q] << 16) - lam * __uint_as_float(o1[q] << 16); oa[2 * q + 1] = __uint_as_float(o0[q] & 0xffff0000u) - lam * __uint_as_float(o1[q] & 0xffff0000u);
                ob[2 * q] = __uint_as_float(og[q] << 16); ob[2 * q + 1] = __uint_as_float(og[q] & 0xffff0000u);
                zf[2 * q] = __uint_as_float(zz[q] << 16); zf[2 * q + 1] = __uint_as_float(zz[q] & 0xffff0000u);
            }
#pragma unroll
            for (int e = 0; e < 8; ++e) { ssa += oa[e] * oa[e]; ssb += ob[e] * ob[e]; }
#pragma unroll
            for (int o = 1; o < 16; o <<= 1) { ssa += __shfl_xor(ssa, o); ssb += __shfl_xor(ssb, o); }
            const float ra = 1.0f / sqrtf(ssa * (1.f / 128.f) + EPS), rb = 1.0f / sqrtf(ssb * (1.f / 128.f) + EPS);
            float ya[8], yb[8];
#pragma unroll
            for (int e = 0; e < 8; ++e) { ya[e] = oa[e] * ra * sg[e]; yb[e] = ob[e] * rb * gg[e] * pg8::silu_f(zf[e]); }
            *(GAS v4u*)(XN + (size_t)m * 1024 + a0) = (v4u){cvtpk(ya[0], ya[1]), cvtpk(ya[2], ya[3]), cvtpk(ya[4], ya[5]), cvtpk(ya[6], ya[7])};
            *(GAS v4u*)(XN + (size_t)m * 1024 + 512 + a0) = (v4u){cvtpk(yb[0], yb[1]), cvtpk(yb[2], yb[3]), cvtpk(yb[4], yb[5]), cvtpk(yb[6], yb[7])};
        }
    }
    GRID_BAR();
#ifdef TSTAMP
    if (blockIdx.x == 0 && threadIdx.x == 0) { KARGP(); ((unsigned long long*)(CTLP + 600))[5] = __builtin_amdgcn_s_memrealtime(); }
#endif
    {
        KARGP();
        pg8::Gemm g{XN, WoT, M, D, D}; pg8::StaticOrder S; S.init(M, D, F.G, (int)blockIdx.x);
        pg8::EpiResF32 E{in_x, X1, D};
        pg8::gemm_phase<pg8::EpiResF32, pg8::StaticOrder, true, true>(F.lds, g, S, E);
    }
    GRID_BAR();
#ifdef TSTAMP
    if (blockIdx.x == 0 && threadIdx.x == 0) { KARGP(); ((unsigned long long*)(CTLP + 600))[6] = __builtin_amdgcn_s_memrealtime(); }
#endif
    { PHASE_IDS(); for (int m = gw; m < M; m += NGW) { f32x4 v[4]; rms_row(X1 + (size_t)m * D, ffn_g, lane, v); store_row_bf16(XN + (size_t)m * D, lane, v); } }
    GRID_BAR();
#ifdef TSTAMP
    if (blockIdx.x == 0 && threadIdx.x == 0) { KARGP(); ((unsigned long long*)(CTLP + 600))[7] = __builtin_amdgcn_s_memrealtime(); }
#endif
    {
        KARGP();
        pg8::Gemm g{XN, WupT, M, NUP, D}; pg8::StaticOrder S; S.init(M, NUP, F.G, (int)blockIdx.x);
        pg8::EpiConvGLU E{Gb, fconv_w, fconv_b, HALO, (PG8_LAS float*)(F.lds + XH_OFF)};
        pg8::gemm_phase<pg8::EpiConvGLU, pg8::StaticOrder, true, true>(F.lds, g, S, E);
    }
    GRID_BAR();
#ifdef TSTAMP
    if (blockIdx.x == 0 && threadIdx.x == 0) { KARGP(); ((unsigned long long*)(CTLP + 600))[8] = __builtin_amdgcn_s_memrealtime(); }
#endif
    {
        PHASE_IDS();
        const int gt = blockIdx.x * (NWAVES * 64) + tid, NT = F.G * NWAVES * 64;
        for (int it = gt; it < 64 * DFF; it += NT) {
            const int pm = it / DFF, c = it % DFF; if ((pm & 31) == 0) continue;
            const int j = c >> 7, i = c & 127, cg_ = 256 * j + i, cv_ = cg_ + 128;
            const float* hp = HALO + (size_t)(pm - 1) * 4 * NUP; const float* hc = HALO + (size_t)pm * 4 * NUP;
            const float gm2 = hp[2 * NUP + cg_], gm1 = hp[3 * NUP + cg_], g0 = hc[cg_], g1 = hc[NUP + cg_];
            const float vm2 = hp[2 * NUP + cv_], vm1 = hp[3 * NUP + cv_], v0 = hc[cv_], v1 = hc[NUP + cv_];
            const float wg0 = fconv_w[c], wg1 = fconv_w[NUP + c], wg2 = fconv_w[2 * NUP + c], bg = fconv_b[c];
            const float wv0 = fconv_w[DFF + c], wv1 = fconv_w[NUP + DFF + c], wv2 = fconv_w[2 * NUP + DFF + c], bv = fconv_b[DFF + c];
            const float ug0 = wg0 * gm2 + wg1 * gm1 + wg2 * g0 + bg, ug1 = wg0 * gm1 + wg1 * g0 + wg2 * g1 + bg;
            const float uv0 = wv0 * vm2 + wv1 * vm1 + wv2 * v0 + bv, uv1 = wv0 * vm1 + wv1 * v0 + wv2 * v1 + bv;
            Gb[(size_t)(pm * 256) * DFF + c] = (bf16)f2bf(pg8::silu_f(ug0) * uv0);
            Gb[(size_t)(pm * 256 + 1) * DFF + c] = (bf16)f2bf(pg8::silu_f(ug1) * uv1);
        }
    }
    GRID_BAR();
#ifdef TSTAMP
    if (blockIdx.x == 0 && threadIdx.x == 0) { KARGP(); ((unsigned long long*)(CTLP + 600))[9] = __builtin_amdgcn_s_memrealtime(); }
#endif
    {
        KARGP();
        pg8::Gemm g{Gb, WdnT, M, D, DFF}; pg8::StaticOrder S; S.init(M, D, F.G, (int)blockIdx.x);
        pg8::EpiResF32 E{X1, OUT, D};
        pg8::gemm_phase<pg8::EpiResF32, pg8::StaticOrder, true, true>(F.lds, g, S, E);
    }
    GRID_BAR();
#ifdef TSTAMP
    if (blockIdx.x == 0 && threadIdx.x == 0) { KARGP(); ((unsigned long long*)(CTLP + 600))[10] = __builtin_amdgcn_s_memrealtime(); }
#endif
    { PHASE_IDS();
    for (int m = gw; m < M; m += NGW) {
        f32x4 v[4]; rms_row(OUT + (size_t)m * D, final_g, lane, v);
        GAS f32x4* o = (GAS f32x4*)(OUT + (size_t)m * D) + lane;
#pragma unroll
        for (int j = 0; j < 4; ++j) o[64 * j] = v[j];
    } }

#ifdef TSTAMP
    GRID_BAR();
    if (blockIdx.x == 0 && threadIdx.x == 0) { KARGP(); const unsigned long long* ts = (const unsigned long long*)(CTLP + 600); const unsigned long long tend = __builtin_amdgcn_s_memrealtime();
        const unsigned long long t1 = (TSTAMP + 1 > 10) ? tend : ts[TSTAMP + 1]; float us = (float)(t1 - ts[TSTAMP]) * 0.01f;
        float q = 1.f; while (us >= 100.f) { us *= 0.1f; q *= 10.f; } us = floorf(us + 0.5f) * q;
        OUT[0] = us; }
#endif
}

extern "C" void kernel_launch(void* const* d_in, const int* in_sizes, int n_in, void* d_out, int out_size, void* d_ws, size_t ws_size, hipStream_t stream) {
    static int grid = 0;
    if (grid == 0) {
        if (n_in != 19 || ws_size < WS_END) { fprintf(stderr, "kernel_launch: unexpected inputs (n_in %d, ws %zu)\n", n_in, ws_size); grid = -1; return; }
        int dev = 0, cus = 0, per_cu = 0;
        hipGetDevice(&dev); hipDeviceGetAttribute(&cus, hipDeviceAttributeMultiprocessorCount, dev);
        hipFuncSetAttribute((const void*)mega_fwd, hipFuncAttributeMaxDynamicSharedMemorySize, LDS_BYTES);
        hipOccupancyMaxActiveBlocksPerMultiprocessor(&per_cu, (const void*)mega_fwd, NWAVES * 64, LDS_BYTES);
        (void)hipGetLastError();
        if (per_cu < 1) per_cu = 1;
        grid = cus;
        if (grid > 256) grid = 256;
    }
    if (grid < 0) return;
    hipMemsetAsync((char*)d_ws + WS_CTL, 0, CTL_ZERO_BYTES, stream);
    Args a{};
    for (int i = 0; i < 19; ++i) a.in[i] = (const float*)d_in[i];
    a.out = (float*)d_out; a.ws = (unsigned char*)d_ws;
    void* kargs[] = {&a};
    hipError_t e = hipLaunchCooperativeKernel((const void*)mega_fwd, dim3(grid), dim3(NWAVES * 64), kargs, LDS_BYTES, stream);
    if (e != hipSuccess) fprintf(stderr, "cooperative launch failed: %s (grid %d)\n", hipGetErrorString(e), grid);
}
```

```cpp
#include <hip/hip_runtime.h>
#include <cstdio>
#include <cstdint>
namespace pg8 {
#define PG8_LAS __attribute__((address_space(3)))
typedef unsigned short bf16_t;
typedef short bf16x8 __attribute__((ext_vector_type(8)));
typedef float f32x4 __attribute__((ext_vector_type(4)));
typedef unsigned u32x4 __attribute__((ext_vector_type(4)));
constexpr int BM = 256, BK = 64, HALF = 128, HTB = HALF * BK * 2  , STAGE_BYTES = 8 * HTB, NXCD = 8, WGM = 8;

__host__ __device__ __forceinline__ int lds_byte(int r, int c) { const int st = (r >> 4) * 2 + (c >> 5), rr = r & 15, cc = c & 31, ob = rr * 64 + cc * 2; return st * 1024 + (ob ^ (((ob >> 9) & 1) << 5)); }
__host__ __device__ __forceinline__ void stage_rc(int b, int& R, int& C) { const int st = b / 1024, sb = b % 1024, swz = sb ^ (((sb >> 9) & 1) << 5); R = (st >> 1) * 16 + swz / 64; C = (st & 1) * 32 + (swz % 64) / 2; }
__host__ __device__ __forceinline__ int perm32(int rho) { const int n = rho >> 4, i = rho & 15; return 8 * (i >> 2) + 4 * n + (i & 3); }

struct Unit { int pm, pn; };
struct Gemm { const bf16_t* A; const bf16_t* Bt; int M, N, K; };

struct StaticOrder {
    int nM, nN, nwg, G, c;
    __host__ __device__ void init(int M, int N, int G_, int c_) { nM = M / BM; nN = N / BM; nwg = nM * nN; G = G_; c = c_; }
    __host__ __device__ bool next(int i, Unit& u) const {
        const long L = (long)i * G + c; if (L >= nwg) return false;
        int wgid = (int)L; { const int q = nwg / NXCD, r = nwg % NXCD, xcd = wgid % NXCD, off = wgid / NXCD; wgid = (xcd < r ? xcd * (q + 1) : r * (q + 1) + (xcd - r) * q) + off; }
        const int nig = WGM * nN, gid = wgid / nig, fm = gid * WGM, gsz = (nM - fm) < WGM ? (nM - fm) : WGM;
        u.pm = fm + ((wgid % nig) % gsz); u.pn = (wgid % nig) / gsz; return true;
    }
    __device__ __forceinline__ void a_ready(const Unit&) const {}
    __device__ __forceinline__ void done(const Unit&) const {}
};

__device__ __forceinline__ unsigned cvt_pk_bf16(float lo, float hi) { unsigned r; asm volatile("v_cvt_pk_bf16_f32 %0, %1, %2" : "=v"(r) : "v"(lo), "v"(hi)); return r; }
typedef float f32x2 __attribute__((ext_vector_type(2)));
__device__ __forceinline__ f32x2 gelu_pk(f32x2 v) {
    const f32x2 av = __builtin_elementwise_abs(v), d = av * 0.2316418882f + 1.0f;
    f32x2 t; t.x = __builtin_amdgcn_rcpf(d.x); t.y = __builtin_amdgcn_rcpf(d.y);
    f32x2 q = t * 0.5307027145f + (-0.7265760135f); q = q * t + 0.7107068705f; q = q * t + (-0.142248368f); q = q * t + 0.127414796f; q = q * t;
    const f32x2 s = (v * v) * (-0.72134752044f);
    f32x2 e; e.x = __builtin_amdgcn_exp2f(s.x); e.y = __builtin_amdgcn_exp2f(s.y);
    const f32x2 m = v * (q * e), r = v - m;
    f32x2 o; o.x = v.x < 0.f ? m.x : r.x; o.y = v.y < 0.f ? m.y : r.y; return o;
}

template <int ACT  > struct EpiBf16 {
    static constexpr bool PERM = true, AFTER_DRAIN = false; static_assert(ACT == 0 || ACT == 1, "EpiBf16: ACT is 0 (none) or 1 (gelu_pk)");
    bf16_t* O; int ldc; const float* bias; int split_cols; size_t split_stride; float scale0;
    __device__ __forceinline__ void operator()(const f32x4 (&acc)[2][2][4][2], const Unit& u, int wr, int wc, int fr, int fq) const {
        const int row0 = u.pm * BM + wr * 64 + fr; int colt = u.pn * BM; bf16_t* base = O;
        float sc = 1.f; if (split_cols) { const int t = colt / split_cols; base += (size_t)t * split_stride; colt -= t * split_cols; if (t == 0) sc = scale0; }
        const int col0 = colt + wc * 32 + 8 * fq, bcol0 = u.pn * BM + wc * 32 + 8 * fq;
        f32x4 bv[2][2];
#pragma unroll
        for (int bj = 0; bj < 2; ++bj)
#pragma unroll
            for (int n = 0; n < 2; ++n) bv[bj][n] = bias ? *(const f32x4*)(bias + bcol0 + bj * HALF + 4 * n) : (f32x4){0.f, 0.f, 0.f, 0.f};
#pragma unroll
        for (int ai = 0; ai < 2; ++ai)
#pragma unroll
            for (int m = 0; m < 4; ++m) { bf16_t* rowp = base + (size_t)(row0 + ai * HALF + m * 16) * ldc + col0;
#pragma unroll
                for (int bj = 0; bj < 2; ++bj) { f32x4 v0 = acc[ai][bj][m][0] + bv[bj][0], v1 = acc[ai][bj][m][1] + bv[bj][1];
                    if (ACT == 1) { f32x2 a = gelu_pk((f32x2){v0[0], v0[1]}), b = gelu_pk((f32x2){v0[2], v0[3]}), c = gelu_pk((f32x2){v1[0], v1[1]}), d = gelu_pk((f32x2){v1[2], v1[3]});
                        v0 = (f32x4){a.x, a.y, b.x, b.y}; v1 = (f32x4){c.x, c.y, d.x, d.y}; }
                    v0 = v0 * sc; v1 = v1 * sc; u32x4 w; w.x = cvt_pk_bf16(v0[0], v0[1]); w.y = cvt_pk_bf16(v0[2], v0[3]); w.z = cvt_pk_bf16(v1[0], v1[1]); w.w = cvt_pk_bf16(v1[2], v1[3]);
                    *(u32x4*)(rowp + bj * HALF) = w; } }
    }
};

struct EpiProj {
    static constexpr bool PERM = true, AFTER_DRAIN = false;
    bf16_t* PA; bf16_t* PG; float scale0;
    __device__ __forceinline__ void operator()(const f32x4 (&acc)[2][2][4][2], const Unit& u, int wr, int wc, int fr, int fq) const {
        const int row0 = u.pm * BM + wr * 64 + fr;
        bf16_t* base; int ldc, colt;
        if (u.pn < 8) { base = PA; ldc = 2048; colt = u.pn * BM; } else { base = PG; ldc = 1536; colt = (u.pn - 8) * BM; }
        const float sc = (u.pn < 2) ? scale0 : 1.f;
        const int col0 = colt + wc * 32 + 8 * fq;
#pragma unroll
        for (int ai = 0; ai < 2; ++ai)
#pragma unroll
            for (int m = 0; m < 4; ++m) { bf16_t* rowp = base + (size_t)(row0 + ai * HALF + m * 16) * ldc + col0;
#pragma unroll
                for (int bj = 0; bj < 2; ++bj) { f32x4 v0 = acc[ai][bj][m][0] * sc, v1 = acc[ai][bj][m][1] * sc;
                    u32x4 w; w.x = cvt_pk_bf16(v0[0], v0[1]); w.y = cvt_pk_bf16(v0[2], v0[3]); w.z = cvt_pk_bf16(v1[0], v1[1]); w.w = cvt_pk_bf16(v1[2], v1[3]);
                    *(u32x4*)(rowp + bj * HALF) = w; } }
    }
};
struct EpiResF32 {
    static constexpr bool PERM = false, AFTER_DRAIN = false;
    const float* base; float* out; int ldc;
    __device__ __forceinline__ void operator()(const f32x4 (&acc)[2][2][4][2], const Unit& u, int wr, int wc, int fr, int fq) const {
        const int col0 = u.pn * BM + wc * 32 + 4 * fq;
#pragma unroll
        for (int ai = 0; ai < 2; ++ai)
#pragma unroll
            for (int m = 0; m < 4; ++m) { const size_t off = (size_t)(u.pm * BM + ai * HALF + wr * 64 + m * 16 + fr) * ldc + col0;
#pragma unroll
                for (int bj = 0; bj < 2; ++bj)
#pragma unroll
                    for (int n = 0; n < 2; ++n) { const f32x4 bs = *(const f32x4*)(base + off + bj * HALF + n * 16); *(f32x4*)(out + off + bj * HALF + n * 16) = bs + acc[ai][bj][m][n]; } }
    }
};
__device__ __forceinline__ float dpp_ror1(float v) { return __builtin_bit_cast(float, __builtin_amdgcn_update_dpp(0, __builtin_bit_cast(int, v), 0x121, 0xf, 0xf, false)); }
__device__ __forceinline__ float dpp_ror2(float v) { return __builtin_bit_cast(float, __builtin_amdgcn_update_dpp(0, __builtin_bit_cast(int, v), 0x122, 0xf, 0xf, false)); }
__device__ __forceinline__ float silu_f(float x) { return x * __builtin_amdgcn_rcpf(1.0f + __expf(-x)); }
struct EpiConvGLU {
    static constexpr bool PERM = true, AFTER_DRAIN = false;
    bf16_t* G; const float* cw; const float* cb; float* halo; PG8_LAS float* xh;
    __device__ __forceinline__ void operator()(const f32x4 (&acc)[2][2][4][2], const Unit& u, int wr, int wc, int fr, int fq) const {
        const int csb = wc * 32 + 8 * fq;
        if (fr >= 14) {
#pragma unroll
            for (int ai = 0; ai < 2; ++ai)
#pragma unroll
                for (int bj = 0; bj < 2; ++bj)
#pragma unroll
                    for (int n = 0; n < 2; ++n) *(PG8_LAS f32x4*)(xh + (((2 * ai + wr) * 2 + (fr - 14)) * 256 + bj * 128 + csb + 4 * n)) = acc[ai][bj][3][n];
        }
        if (wr == 0 && fr < 2) {
#pragma unroll
            for (int bj = 0; bj < 2; ++bj)
#pragma unroll
                for (int n = 0; n < 2; ++n) *(f32x4*)(halo + ((size_t)(u.pm * 4 + fr) * 5632 + u.pn * 256 + bj * 128 + csb + 4 * n)) = acc[0][bj][0][n];
        }
        if (wr == 1 && fr >= 14) {
#pragma unroll
            for (int bj = 0; bj < 2; ++bj)
#pragma unroll
                for (int n = 0; n < 2; ++n) *(f32x4*)(halo + ((size_t)(u.pm * 4 + 2 + (fr - 14)) * 5632 + u.pn * 256 + bj * 128 + csb + 4 * n)) = acc[1][bj][3][n];
        }
        asm volatile("s_waitcnt lgkmcnt(0)" ::: "memory"); __builtin_amdgcn_s_barrier(); asm volatile("" ::: "memory");
        const bool seqstart = (u.pm & 31) == 0;
#pragma unroll
        for (int n = 0; n < 2; ++n) {
            const int chg = u.pn * 128 + csb + 4 * n, chv = 2816 + chg;
            const f32x4 g0 = *(const f32x4*)(cw + chg), g1 = *(const f32x4*)(cw + 5632 + chg), g2 = *(const f32x4*)(cw + 2 * 5632 + chg), gb = *(const f32x4*)(cb + chg);
            const f32x4 v0 = *(const f32x4*)(cw + chv), v1 = *(const f32x4*)(cw + 5632 + chv), v2 = *(const f32x4*)(cw + 2 * 5632 + chv), vb = *(const f32x4*)(cb + chv);
#pragma unroll
            for (int ai = 0; ai < 2; ++ai) {
                const int g = 2 * ai + wr;
                f32x4 hg = (f32x4){0.f, 0.f, 0.f, 0.f}, hv = hg;
                if (g > 0) { hg = *(const PG8_LAS f32x4*)(xh + (((g - 1) * 2 + (fr & 1)) * 256 + csb + 4 * n)); hv = *(const PG8_LAS f32x4*)(xh + (((g - 1) * 2 + (fr & 1)) * 256 + 128 + csb + 4 * n)); }
#pragma unroll
                for (int m = 0; m < 4; ++m) {
                    const f32x4 pg = (m == 0) ? hg : acc[ai][0][m == 0 ? 0 : m - 1][n], pv = (m == 0) ? hv : acc[ai][1][m == 0 ? 0 : m - 1][n];
                    const f32x4 cg = acc[ai][0][m][n], cv = acc[ai][1][m][n];
                    float og[4];
#pragma unroll
                    for (int e = 0; e < 4; ++e) {
                        const float g_p1 = dpp_ror1(fr == 15 ? pg[e] : cg[e]), g_p2 = dpp_ror2(fr >= 14 ? pg[e] : cg[e]);
                        const float v_p1 = dpp_ror1(fr == 15 ? pv[e] : cv[e]), v_p2 = dpp_ror2(fr >= 14 ? pv[e] : cv[e]);
                        const float ug = g2[e] * cg[e] + g1[e] * g_p1 + g0[e] * g_p2 + gb[e];
                        const float uv = v2[e] * cv[e] + v1[e] * v_p1 + v0[e] * v_p2 + vb[e];
                        og[e] = silu_f(ug) * uv;
                    }
                    typedef unsigned u32x2v __attribute__((ext_vector_type(2)));
                    u32x2v w; w.x = cvt_pk_bf16(og[0], og[1]); w.y = cvt_pk_bf16(og[2], og[3]);
                    const bool skip = (g == 0) && (m == 0) && (fr < 2) && !seqstart;
                    if (!skip) *(u32x2v*)(G + (size_t)(u.pm * BM + ai * HALF + wr * 64 + m * 16 + fr) * 2816 + chg) = w;
                }
            }
        }
    }
};
template <class Epi, class Sched, bool ALIGN_EPI = false, bool SP2 = false>
__device__ __forceinline__ void gemm_phase(PG8_LAS unsigned char* lds, const Gemm g, const Sched& S, const Epi& E) {
    int tid_l = threadIdx.x; asm volatile("" : "+v"(tid_l));
    const int tid = tid_l, wid = __builtin_amdgcn_readfirstlane(tid >> 6), lane = tid & 63, wr = wid >> 2, wc = wid & 3, fr = lane & 15, fq = lane >> 4;
    const int K = g.K, nt = K / BK;
    unsigned voffA[2], voffB[2];
#pragma unroll
    for (int i = 0; i < 2; ++i) { int R, C; stage_rc(tid * 16 + i * 8192, R, C); const int Rb = Epi::PERM ? ((R & ~31) + perm32(R & 31)) : R;
        voffA[i] = (unsigned)(R * K + C) * 2u; voffB[i] = (unsigned)(Rb * K + C) * 2u; }
    const size_t kstep = (size_t)(BK * 2);
    const size_t hstep = (size_t)HALF * K * 2;
    const size_t tstep = 2 * hstep;
    const unsigned ldsw = (unsigned)wid * 1024u;
    const int aoff = lds_byte(wr * 64 + fr, fq * 8), boff = lds_byte(wc * 32 + fr, fq * 8);
#define PG8_SA(b, h) (((b) * 2 + (h)) * HTB)
#define PG8_SB(b, h) ((4 + (b) * 2 + (h)) * HTB)
#define PG8_STAGE(bufoff, gbase, voff) do { _Pragma("unroll") for (int _i = 0; _i < 2; ++_i) \
        __builtin_amdgcn_global_load_lds((const unsigned*)((const char*)(gbase) + (voff)[_i]), (PG8_LAS unsigned*)(lds + (bufoff) + ldsw + _i * 8192), 16, 0, 0); } while (0)
#define PG8_LDA(dst, b, h) do { _Pragma("unroll") for (int m = 0; m < 4; ++m) _Pragma("unroll") for (int k = 0; k < 2; ++k) dst[m][k] = *(const PG8_LAS bf16x8*)(lds + PG8_SA(b, h) + aoff + m * 2048 + k * 1024); } while (0)
#define PG8_LDB(dst, b, h) do { _Pragma("unroll") for (int n = 0; n < 2; ++n) _Pragma("unroll") for (int k = 0; k < 2; ++k) dst[n][k] = *(const PG8_LAS bf16x8*)(lds + PG8_SB(b, h) + boff + n * 2048 + k * 1024); } while (0)
#define PG8_MMA(ai, bj, At, Bt) do { __builtin_amdgcn_s_setprio(1); _Pragma("unroll") for (int m = 0; m < 4; ++m) _Pragma("unroll") for (int n = 0; n < 2; ++n) _Pragma("unroll") for (int k = 0; k < 2; ++k) \
        acc[ai][bj][m][n] = __builtin_amdgcn_mfma_f32_16x16x32_bf16(Bt[n][k], At[m][k], acc[ai][bj][m][n], 0, 0, 0); __builtin_amdgcn_s_setprio(0); } while (0)
#define PG8_WAIT_V(n) asm volatile("s_waitcnt vmcnt(" #n ")" ::: "memory")
#define PG8_WAIT_L(n) asm volatile("s_waitcnt lgkmcnt(" #n ")" ::: "memory")
#define PG8_BAR __builtin_amdgcn_s_barrier()
#define PG8_SCHED __builtin_amdgcn_sched_barrier(0)
    Unit cur, nxt; int ui = 0;
    if (!S.next(0, cur)) return;
    f32x4 acc[2][2][4][2];
#pragma unroll
    for (int a = 0; a < 2; ++a)
#pragma unroll
        for (int b = 0; b < 2; ++b)
#pragma unroll
            for (int m = 0; m < 4; ++m)
#pragma unroll
                for (int n = 0; n < 2; ++n) acc[a][b][m][n] = (f32x4){0.f, 0.f, 0.f, 0.f};
    bf16x8 At[4][2], B0[2][2], B1[2][2];
    const char* cA = (const char*)g.A + (size_t)cur.pm * tstep; const char* cB = (const char*)g.Bt + (size_t)cur.pn * tstep;
    S.a_ready(cur);
    if constexpr (SP2) {
        PG8_STAGE(PG8_SB(0, 0), cB, voffB); PG8_STAGE(PG8_SB(0, 1), cB + hstep, voffB); PG8_STAGE(PG8_SA(0, 0), cA, voffA); PG8_STAGE(PG8_SA(0, 1), cA + hstep, voffA);
        if (wr == 1) PG8_BAR;
        PG8_WAIT_V(2); PG8_BAR;
        PG8_STAGE(PG8_SB(1, 0), cB + kstep, voffB); PG8_STAGE(PG8_SA(1, 0), cA + kstep, voffA); PG8_STAGE(PG8_SB(1, 1), cB + hstep + kstep, voffB);
        PG8_WAIT_V(6); PG8_BAR;
    } else {
        PG8_STAGE(PG8_SB(0, 0), cB, voffB); PG8_STAGE(PG8_SA(0, 0), cA, voffA); PG8_STAGE(PG8_SB(0, 1), cB + hstep, voffB); PG8_STAGE(PG8_SA(0, 1), cA + hstep, voffA);
        if (wr == 1) PG8_BAR;
        PG8_WAIT_V(4); PG8_BAR;
        PG8_STAGE(PG8_SB(1, 0), cB + kstep, voffB); PG8_STAGE(PG8_SA(1, 0), cA + kstep, voffA); PG8_STAGE(PG8_SB(1, 1), cB + hstep + kstep, voffB);
        PG8_WAIT_V(6); PG8_BAR;
    }
    for (;;) {
        const bool has_next = S.next(ui + 1, nxt);
        const char* nA = has_next ? (const char*)g.A + (size_t)nxt.pm * tstep : cA; const char* nB = has_next ? (const char*)g.Bt + (size_t)nxt.pn * tstep : cB;
        for (int t = 0; t < nt; t += 2) {
            const bool last = (t == nt - 2);
            const char* a1 = cA + (size_t)(t + 1) * kstep;
            const char* a2 = last ? nA : cA + (size_t)(t + 2) * kstep; const char* b2 = last ? nB : cB + (size_t)(t + 2) * kstep;
            const char* a3 = a2 + kstep; const char* b3 = b2 + kstep;
            if (last && has_next) S.a_ready(nxt);
            if constexpr (SP2) {
            PG8_LDB(B0, 0, 0); PG8_LDB(B1, 0, 1); PG8_SCHED; PG8_LDA(At, 0, 0); PG8_STAGE(PG8_SA(1, 1), a1 + hstep, voffA);
            PG8_WAIT_V(8); PG8_WAIT_L(0); PG8_BAR; PG8_MMA(0, 0, At, B0); PG8_MMA(0, 1, At, B1); PG8_BAR; PG8_SCHED;
            PG8_LDA(At, 0, 1); PG8_STAGE(PG8_SB(0, 0), b2, voffB); PG8_STAGE(PG8_SB(0, 1), b2 + hstep, voffB); PG8_STAGE(PG8_SA(0, 0), a2, voffA);
            PG8_WAIT_V(8); PG8_WAIT_L(0); PG8_BAR; PG8_MMA(1, 0, At, B0); PG8_MMA(1, 1, At, B1); PG8_BAR; PG8_SCHED;
            PG8_LDB(B0, 1, 0); PG8_LDB(B1, 1, 1); PG8_SCHED; PG8_LDA(At, 1, 0); PG8_STAGE(PG8_SA(0, 1), a2 + hstep, voffA);
            PG8_WAIT_V(8); PG8_WAIT_L(0); PG8_BAR; PG8_MMA(0, 0, At, B0); PG8_MMA(0, 1, At, B1); PG8_BAR; PG8_SCHED;
            PG8_LDA(At, 1, 1); PG8_STAGE(PG8_SB(1, 0), b3, voffB); PG8_STAGE(PG8_SB(1, 1), b3 + hstep, voffB); PG8_STAGE(PG8_SA(1, 0), a3, voffA);
            PG8_WAIT_V(8); PG8_WAIT_L(0); PG8_BAR; PG8_MMA(1, 0, At, B0); PG8_MMA(1, 1, At, B1); PG8_BAR; PG8_SCHED;
            } else {
            PG8_LDB(B0, 0, 0); PG8_SCHED; PG8_LDA(At, 0, 0); PG8_STAGE(PG8_SA(1, 1), a1 + hstep, voffA);
            PG8_WAIT_L(8); PG8_BAR; PG8_WAIT_L(0); PG8_MMA(0, 0, At, B0); PG8_BAR; PG8_SCHED;
            PG8_LDB(B1, 0, 1); PG8_STAGE(PG8_SB(0, 0), b2, voffB);
            PG8_BAR; PG8_WAIT_L(0); PG8_MMA(0, 1, At, B1); PG8_BAR;
            PG8_LDA(At, 0, 1); PG8_STAGE(PG8_SA(0, 0), a2, voffA);
            PG8_BAR; PG8_WAIT_L(0); PG8_MMA(1, 0, At, B0); PG8_BAR; PG8_SCHED;
            PG8_STAGE(PG8_SB(0, 1), b2 + hstep, voffB);
            PG8_WAIT_V(6); PG8_BAR; PG8_MMA(1, 1, At, B1); PG8_BAR;
            PG8_LDB(B0, 1, 0); PG8_SCHED; PG8_LDA(At, 1, 0); PG8_STAGE(PG8_SA(0, 1), a2 + hstep, voffA);
            PG8_WAIT_L(8); PG8_BAR; PG8_WAIT_L(0); PG8_MMA(0, 0, At, B0); PG8_BAR; PG8_SCHED;
            PG8_LDB(B1, 1, 1); PG8_STAGE(PG8_SB(1, 0), b3, voffB);
            PG8_BAR; PG8_WAIT_L(0); PG8_MMA(0, 1, At, B1); PG8_BAR;
            PG8_LDA(At, 1, 1); PG8_STAGE(PG8_SA(1, 0), a3, voffA);
            PG8_BAR; PG8_WAIT_L(0); PG8_MMA(1, 0, At, B0); PG8_BAR; PG8_SCHED;
            PG8_STAGE(PG8_SB(1, 1), b3 + hstep, voffB);
            PG8_WAIT_V(6); PG8_BAR; PG8_MMA(1, 1, At, B1); PG8_BAR;
            }
        }
        if constexpr (ALIGN_EPI) { if (wr == 0) PG8_BAR; }
        if constexpr (!Epi::AFTER_DRAIN) { E(acc, cur, wr, wc, fr, fq); S.done(cur); }
        if (!has_next) break;
#pragma unroll
        for (int a = 0; a < 2; ++a)
#pragma unroll
            for (int b = 0; b < 2; ++b)
#pragma unroll
                for (int m = 0; m < 4; ++m)
#pragma unroll
                    for (int n = 0; n < 2; ++n) acc[a][b][m][n] = (f32x4){0.f, 0.f, 0.f, 0.f};
        cur = nxt; cA = nA; cB = nB; ++ui;
        if constexpr (ALIGN_EPI) { if (wr == 1) PG8_BAR; }
    }
    PG8_WAIT_V(0);
    if constexpr (!ALIGN_EPI) { if (wr == 0) PG8_BAR; }
    PG8_BAR;
    if constexpr (Epi::AFTER_DRAIN) { E.fused(acc, cur, wr, wc, fr, fq, lds, wid, lane); S.done(cur); }
#undef PG8_SA
#undef PG8_SB
#undef PG8_STAGE
#undef PG8_LDA
#undef PG8_LDB
#undef PG8_MMA
#undef PG8_WAIT_V
#undef PG8_WAIT_L
#undef PG8_BAR
#undef PG8_SCHED
}
}

#ifndef PG8_SP2
#define PG8_SP2 true
#endif
#ifndef PG8_ALIGN
#define PG8_ALIGN true
#endif
#include <hip/hip_bf16.h>
#include <cmath>
namespace attn_body {
using bf16=__hip_bfloat16;
using bf16x8=__attribute__((ext_vector_type(8)))short;
using s16x4=__attribute__((ext_vector_type(4)))short;
using f32x16=__attribute__((ext_vector_type(16)))float;
using u32x4=__attribute__((ext_vector_type(4)))unsigned;
constexpr int BATCH=2,NHEAD=16,SEQ=8192,D=64,DM=2048,OPITCH=1024;
constexpr int NW=8,QBLK=32,QB=QBLK*NW,KVBLK=64,NQB=SEQ/QB;
constexpr int ATTN_PITCH=DM, ATTN_UNIT_ROWS=QB;
__device__ __forceinline__ int crow(int r,int hi){return (r&3)+8*(r>>2)+4*hi;}
#define SBAR() __builtin_amdgcn_sched_barrier(0)
__device__ __forceinline__ void cmask(f32x16&p0,f32x16&p1,int jb,int qrel,int hi){
  const float NEG=-INFINITY; int kb=64*jb+4*hi;
  #pragma unroll
  for(int r=0;r<16;++r){int kv=kb+(r&3)+8*(r>>2); if(kv>qrel)p0[r]=NEG; if(kv+32>qrel)p1[r]=NEG;}
}

constexpr int NSLOT=3, SLOTB=8192;
constexpr int LDS_K=0, LDS_V=NSLOT*SLOTB, LDS_WS=2*NSLOT*SLOTB, LDS_OST=LDS_WS+NW*64*4, LDS_BYTES=LDS_OST+NW*4096;
constexpr float C2=0.125f*1.4426950408889634f;
__device__ __forceinline__ void glds16(const void*gsrc,unsigned lds_dst){unsigned keep;
  asm volatile("s_mov_b32 %0, m0\n\ts_mov_b32 m0, %2\n\ts_nop 0\n\tglobal_load_lds_dwordx4 %1, off\n\ts_mov_b32 m0, %0":"=&s"(keep):"v"(gsrc),"s"(lds_dst):"memory");}
__device__ __forceinline__ float max3f(float a,float b,float c){float r;asm("v_max3_f32 %0, %1, %2, %3":"=v"(r):"v"(a),"v"(b),"v"(c));return r;}
__device__ __forceinline__ float max2f(float a,float b){float r;asm("v_max_f32_e32 %0, %1, %2":"=v"(r):"v"(a),"v"(b));return r;}
__device__ __forceinline__ float fadd_s(float a,float b){float r;asm("v_add_f32_e32 %0, %1, %2":"=v"(r):"v"(a),"v"(b));return r;}
__device__ __forceinline__ float fsub_s(float a,float b){float r;asm("v_sub_f32_e32 %0, %1, %2":"=v"(r):"v"(a),"v"(b));return r;}
typedef float f32x2_t __attribute__((ext_vector_type(2))); typedef __bf16 bf16x2_t __attribute__((ext_vector_type(2)));
__device__ __forceinline__ unsigned cvtpk_s(float lo,float hi){f32x2_t v={lo,hi};bf16x2_t b=__builtin_convertvector(v,bf16x2_t);return __builtin_bit_cast(unsigned,b);}
typedef unsigned u32x2_t __attribute__((ext_vector_type(2)));
__device__ __forceinline__ unsigned bfb(float x){return cvtpk_s(x,0.f)&0xffffu;}
__device__ __forceinline__ float bff(unsigned b){return __uint_as_float(b<<16);}
#define MFMA8(a,b,c) __builtin_amdgcn_mfma_f32_32x32x8bf16_1k((a),(b),(c),0,0,0)
#define WAIT_BAR(N) asm volatile("s_waitcnt vmcnt(" #N ") lgkmcnt(0)\n\ts_barrier":::"memory")

__device__ __forceinline__ void qkt(f32x16&p0,f32x16&p1,const char*Kslot,const bf16x8*qr,const s16x4 kx0,const s16x4 kx1,const s16x4 qx,int r32,int hi){
  const f32x16 Z=f32x16{}; p0=MFMA8(kx0,qx,Z); p1=MFMA8(kx1,qx,Z);
  const char*kb=Kslot+hi*1024+r32*16;
  #pragma unroll
  for(int d0=0;d0<4;++d0){
    const bf16x8 b0=*reinterpret_cast<const bf16x8*>(kb+d0*2048);
    const bf16x8 b1=*reinterpret_cast<const bf16x8*>(kb+d0*2048+512);
    {p0=__builtin_amdgcn_mfma_f32_32x32x16_bf16(b0,qr[d0],p0,0,0,0);p1=__builtin_amdgcn_mfma_f32_32x32x16_bf16(b1,qr[d0],p1,0,0,0);}}
}
typedef __attribute__((address_space(3))) const char* lds_cptr;
typedef short v4i16_t __attribute__((ext_vector_type(4)));
__device__ __forceinline__ void kload8(bf16x8*kf,lds_cptr kp){
  kf[0]=*(const __attribute__((address_space(3))) bf16x8*)(kp);      kf[1]=*(const __attribute__((address_space(3))) bf16x8*)(kp+512);
  kf[2]=*(const __attribute__((address_space(3))) bf16x8*)(kp+2048); kf[3]=*(const __attribute__((address_space(3))) bf16x8*)(kp+2560);
  kf[4]=*(const __attribute__((address_space(3))) bf16x8*)(kp+4096); kf[5]=*(const __attribute__((address_space(3))) bf16x8*)(kp+4608);
  kf[6]=*(const __attribute__((address_space(3))) bf16x8*)(kp+6144); kf[7]=*(const __attribute__((address_space(3))) bf16x8*)(kp+6656);
}
__device__ __forceinline__ void kload2(bf16x8*kf,lds_cptr kp,int j){ kf[2*j]=*(const __attribute__((address_space(3))) bf16x8*)(kp+j*2048); kf[2*j+1]=*(const __attribute__((address_space(3))) bf16x8*)(kp+j*2048+512); }
__device__ __forceinline__ s16x4 vtr(lds_cptr p){ return __builtin_bit_cast(s16x4,__builtin_amdgcn_ds_read_tr16_b64_v4i16((__attribute__((address_space(3))) v4i16_t*)p)); }
__device__ __forceinline__ float rowmax(const f32x16&p0,const f32x16&p1){
  float a=max3f(p0[0],p0[1],p1[0]),b=max3f(p0[2],p0[3],p1[1]);a=max3f(a,p1[2],p1[3]);
  #pragma unroll
  for(int r=4;r<16;r+=4){a=max3f(a,p0[r],p0[r+1]);b=max3f(b,p0[r+2],p0[r+3]);a=max3f(a,p1[r],p1[r+1]);b=max3f(b,p1[r+2],p1[r+3]);}
  const float m=max2f(a,b);
  auto rr=__builtin_amdgcn_permlane32_swap(__float_as_uint(m),__float_as_uint(m),false,false);
  return max2f(__uint_as_float(rr[0]),__uint_as_float(rr[1]));
}
__device__ __forceinline__ void pv(f32x16*o,int vb,bf16x8 pa0,bf16x8 pa1,bf16x8 pa2,bf16x8 pa3){
  #pragma unroll
  for(int d0=0;d0<2;++d0){s16x4 lo[4],hi[4];
    #pragma unroll
    for(int ks=0;ks<4;++ks){
      asm volatile("ds_read_b64_tr_b16 %0,%1 offset:%c2":"=&v"(lo[ks]):"v"(vb),"i"(d0*4096+ks*1024):"memory");
      asm volatile("ds_read_b64_tr_b16 %0,%1 offset:%c2":"=&v"(hi[ks]):"v"(vb),"i"(d0*4096+ks*1024+512):"memory");}
    asm volatile("s_waitcnt lgkmcnt(0)":::"memory");SBAR();
    #define PK(k) (bf16x8){lo[k][0],lo[k][1],lo[k][2],lo[k][3],hi[k][0],hi[k][1],hi[k][2],hi[k][3]}
    o[d0]=__builtin_amdgcn_mfma_f32_32x32x16_bf16(pa0,PK(0),o[d0],0,0,0);
    o[d0]=__builtin_amdgcn_mfma_f32_32x32x16_bf16(pa1,PK(1),o[d0],0,0,0);
    o[d0]=__builtin_amdgcn_mfma_f32_32x32x16_bf16(pa2,PK(2),o[d0],0,0,0);
    o[d0]=__builtin_amdgcn_mfma_f32_32x32x16_bf16(pa3,PK(3),o[d0],0,0,0);
    #undef PK
  }
}

#ifndef ATTN_STORE16
#define ATTN_STORE16(p,v) (*(u32x4*)(p)=(v))
#endif
template<int THRL> __device__ __forceinline__ void attn_unit(int b,int h,int cm,int vh,int qb,int tskip,const bf16*__restrict__ P,bf16*O,char*shm){
  const int tid=threadIdx.x,lane=tid&63,r32=lane&31,hi=lane>>5; const int wid=__builtin_amdgcn_readfirstlane(tid>>6);
  const long rowbase=(long)b*SEQ; const int q0=qb*QB;
  const bf16*Qw=P+(rowbase+q0+wid*QBLK)*DM+h*128+cm*64;
  const bf16*Kh=P+(rowbase+(long)tskip*KVBLK)*DM+512+h*128+cm*64,*Vh=P+(rowbase+(long)tskip*KVBLK)*DM+1024+h*128+vh*64;
  const unsigned lds0=(unsigned)(uintptr_t)shm;
  float*wsf=(float*)(shm+LDS_WS)+wid*64;
  const bf16*ksrc=Kh+(long)lane*DM+wid*8;
  const bf16*vsrc=Vh+(long)(16*(wid&3)+(lane>>2))*DM+(wid>>2)*32+(lane&3)*8;
  const unsigned kdst=lds0+LDS_K+wid*1024, vdst=lds0+LDS_V+wid*1024;
  #define DMA_K(t,slot) glds16(ksrc+(long)(t)*KVBLK*DM,(unsigned)__builtin_amdgcn_readfirstlane(kdst+(slot)))
  #define DMA_V(t,slot) glds16(vsrc+(long)(t)*KVBLK*DM,(unsigned)__builtin_amdgcn_readfirstlane(vdst+(slot)))
  const int vb0=(int)(lds0+LDS_V)+((lane>>4)&1)*32+(lane&3)*8+(4*hi+((lane&15)>>2))*64;
  const char*Kbase=shm+LDS_K; bf16x8 kf[8];
  const lds_cptr shm3=(lds_cptr)shm; const lds_cptr kp0=shm3+LDS_K+hi*1024+r32*16; const lds_cptr vp0=shm3+LDS_V+((lane>>4)&1)*32+(lane&3)*8+(4*hi+((lane&15)>>2))*64;
  const int NT=(q0+QB)/KVBLK-tskip;
  DMA_K(0,0);DMA_V(0,0);DMA_K(1,SLOTB);
  bf16x8 qr[4];
  #pragma unroll
  for(int d0=0;d0<4;++d0)qr[d0]=*reinterpret_cast<const bf16x8*>(&Qw[(long)r32*DM+d0*16+hi*8]);
  float mhat=0.f,l_reg=0.f;f32x16 o[2];o[0]=f32x16{};o[1]=f32x16{};
  s16x4 qx,kx0,kx1; unsigned jp0,jp1;
  { const float sl2=exp2f(-2.0f*(float)(h+1))*1.4426950408889634f; const unsigned s0=bfb(sl2); const float r1=sl2-bff(s0); const unsigned s1=bfb(r1); const float r2=r1-bff(s1); const unsigned s2=bfb(r2);
    const unsigned a0=s0|(s1<<16), a1=s2|(bfb(64.f*bff(s0))<<16), b0=bfb(64.f*bff(s1))|(bfb(64.f*bff(s2))<<16);
    u32x2_t qq; qq.x=hi?b0:a0; qq.y=hi?0u:a1; qx=__builtin_bit_cast(s16x4,qq);
    jp0=bfb((float)r32); jp1=bfb((float)(r32+32)); }
  #define KXSET(t) do{ const unsigned tb_=__float_as_uint((float)(t))>>16; u32x2_t k0_,k1_; \
    k0_.x=hi?(tb_|(tb_<<16)):(jp0|(jp0<<16)); k0_.y=hi?0x3f803f80u:(jp0|(tb_<<16)); k1_.x=hi?(tb_|(tb_<<16)):(jp1|(jp1<<16)); k1_.y=hi?0x3f803f80u:(jp1|(tb_<<16)); \
    kx0=__builtin_bit_cast(s16x4,k0_); kx1=__builtin_bit_cast(s16x4,k1_); }while(0)
  #define SETRHO(newr,eff) do{ const float nx_=-(newr); const unsigned nh_=bfb(nx_); const float nl_f=nx_-bff(nh_); const unsigned nl_=bfb(nl_f); eff=-(bff(nh_)+bff(nl_)); \
    if(hi){ u32x2_t q_=__builtin_bit_cast(u32x2_t,qx); q_.y=nh_|(nl_<<16); qx=__builtin_bit_cast(s16x4,q_); } }while(0)
  const int qrel=wid*QBLK+r32;
  #define CMASK(P0,P1,t) do{int jb_=(t)-(NT-4); if(jb_>=0)cmask(P0,P1,jb_,qrel,hi);}while(0)
  bool resc=false;
  #define START(P0,P1) do{ const float rm=rowmax(P0,P1); resc=false; \
    { float dl; SETRHO(rm,dl); mhat=dl; \
      _Pragma("unroll") for(int r=0;r<16;++r){P0[r]=fsub_s(P0[r],dl);P1[r]=fsub_s(P1[r],dl);} } \
    _Pragma("unroll") for(int r=0;r<16;++r)P0[r]=__builtin_amdgcn_exp2f(P0[r]); }while(0)
  #define RESC() do{ if(resc){ asm volatile("s_waitcnt lgkmcnt(0)":::"memory"); \
      _Pragma("unroll") for(int d_=0;d_<2;++d_) _Pragma("unroll") for(int r=0;r<16;++r)o[d_][r]*=wsf[crow(r,hi)]; } }while(0)
  f32x16 pA0,pA1,pB0,pB1;
  int sl_prev=0,sl_cur=0,sl_next=SLOTB;
  #define ROT() do{sl_prev=sl_cur;sl_cur=sl_next;sl_next=(sl_next==(NSLOT-1)*SLOTB)?0:sl_next+SLOTB;}while(0)
  DMA_K(2,2*SLOTB);
  WAIT_BAR(3);
  KXSET(0); qkt(pA0,pA1,Kbase,qr,kx0,kx1,qx,r32,hi);asm volatile("s_nop 15\n\ts_nop 7":"+v"(pA0),"+v"(pA1));CMASK(pA0,pA1,0);
  START(pA0,pA1);
  _Pragma("unroll") for(int r=0;r<16;++r)pA1[r]=__builtin_amdgcn_exp2f(pA1[r]);
  WAIT_BAR(0);
  DMA_K(3,0);DMA_V(1,SLOTB);
  ROT();
  kload8(kf,kp0+sl_cur);
  WAIT_BAR(2);
  s16x4 vlo[8],vhi[8]; u32x4 pw0,pw1,pw2,pw3;
  #define PKW(P,B) cvtpk_s(P[B],P[B+1])
  #define PAF(k) __builtin_bit_cast(bf16x8,pw##k)
  #define VFR(i) (bf16x8){vlo[i][0],vlo[i][1],vlo[i][2],vlo[i][3],vhi[i][0],vhi[i][1],vhi[i][2],vhi[i][3]}
  #define PIN(x) asm volatile("":"+v"(x))
  #define MX3(a,b,c) __builtin_fmaxf(__builtin_fmaxf((a),(b)),(c))
  #define GAPA(MF,A0,A1,A2,A3,W0,W1,PW) do{ MF; sacc+=A0; sacc+=A1; sacc+=A2; sacc+=A3; PIN(sacc); W0; W1; PIN(PW); SBAR(); }while(0)
  #define EX(v) __builtin_amdgcn_exp2f(v)
  #define GAPB(MF,X,B) do{ MF; X[B]=EX(X[B]); X[B+1]=EX(X[B+1]); X[B+2]=EX(X[B+2]); X[B+3]=EX(X[B+3]); PIN(X); SBAR(); }while(0)
  #define VRD(i) do{ vlo[i]=vtr(vp_+(((i)>>2)*4096+((i)&3)*1024)); vhi[i]=vtr(vp_+(((i)>>2)*4096+((i)&3)*1024+512)); }while(0)
  #define KRD(G,j) do{ if(G){ kload2(kf,kp0+sl_next,j); SBAR(); } }while(0)
  #define STEP(C0,C1,P0,P1,t,GK,GV,GL) do{ SBAR(); \
    const lds_cptr vp_=vp0+sl_prev; \
    KXSET(t); { const f32x16 Z_=f32x16{}; C0=MFMA8(kx0,qx,Z_); C1=MFMA8(kx1,qx,Z_); } SBAR(); \
    VRD(0); SBAR(); float sacc=(P0[0]+P0[1]); \
    GAPA(C0=__builtin_amdgcn_mfma_f32_32x32x16_bf16(kf[0],qr[0],C0,0,0,0), P0[2],P0[3],P0[4],P0[5],     pw0[0]=PKW(P0,0), pw0[1]=PKW(P0,2), pw0); \
    VRD(4); SBAR(); GAPA(C1=__builtin_amdgcn_mfma_f32_32x32x16_bf16(kf[1],qr[0],C1,0,0,0), P0[6],P0[7],P0[8],P0[9],     pw0[2]=PKW(P0,4), pw0[3]=PKW(P0,6), pw0); \
    VRD(1); SBAR(); GAPA(C0=__builtin_amdgcn_mfma_f32_32x32x16_bf16(kf[2],qr[1],C0,0,0,0),   P0[10],P0[11],P0[12],P0[13], pw1[0]=PKW(P0,8), pw1[1]=PKW(P0,10), pw1); \
    VRD(5); SBAR(); GAPA(C1=__builtin_amdgcn_mfma_f32_32x32x16_bf16(kf[3],qr[1],C1,0,0,0),   P0[14],P0[15],P1[0],P1[1],   pw1[2]=PKW(P0,12),pw1[3]=PKW(P0,14), pw1); \
    VRD(2); SBAR(); GAPA(C0=__builtin_amdgcn_mfma_f32_32x32x16_bf16(kf[4],qr[2],C0,0,0,0),   P1[2],P1[3],P1[4],P1[5],     pw2[0]=PKW(P1,0), pw2[1]=PKW(P1,2), pw2); \
    VRD(6); SBAR(); GAPA(C1=__builtin_amdgcn_mfma_f32_32x32x16_bf16(kf[5],qr[2],C1,0,0,0),   P1[6],P1[7],P1[8],P1[9],     pw2[2]=PKW(P1,4), pw2[3]=PKW(P1,6), pw2); \
    VRD(3); SBAR(); GAPA(C0=__builtin_amdgcn_mfma_f32_32x32x16_bf16(kf[6],qr[3],C0,0,0,0),   P1[10],P1[11],P1[12],P1[13], pw3[0]=PKW(P1,8), pw3[1]=PKW(P1,10), pw3); \
    VRD(7); SBAR(); GAPA(C1=__builtin_amdgcn_mfma_f32_32x32x16_bf16(kf[7],qr[3],C1,0,0,0),   P1[14],P1[15],0.f,0.f,       pw3[2]=PKW(P1,12),pw3[3]=PKW(P1,14), pw3); \
    l_reg+=sacc; \
    if(GK){DMA_K((t)+3,sl_cur);} if(GV){DMA_V((t)+1,sl_next);} \
    CMASK(C0,C1,t); \
    { float a=MX3(C0[0],C0[1],C1[0]),b=MX3(C0[2],C0[3],C1[1]); a=MX3(a,C1[2],C1[3]); \
      _Pragma("unroll") for(int r=4;r<16;r+=4){a=MX3(a,C0[r],C0[r+1]);b=MX3(b,C0[r+2],C0[r+3]);a=MX3(a,C1[r],C1[r+1]);b=MX3(b,C1[r+2],C1[r+3]);} \
      float rm=__builtin_fmaxf(a,b); { auto rr=__builtin_amdgcn_permlane32_swap(__float_as_uint(rm),__float_as_uint(rm),false,false); rm=__builtin_fmaxf(__uint_as_float(rr[0]),__uint_as_float(rr[1])); } \
      resc=false; \
      if(__builtin_expect(__any(rm>(float)THRL),0)){ const float nr_=mhat+__builtin_fmaxf(rm,0.f); float ne_; SETRHO(nr_,ne_); const float dl=ne_-mhat; mhat=ne_; \
        _Pragma("unroll") for(int r=0;r<16;++r){C0[r]-=dl;C1[r]-=dl;} \
        const float f=__builtin_amdgcn_exp2f(-dl); l_reg*=f; if(hi==0)wsf[r32]=f; resc=true; } } \
    SBAR(); \
    GAPB(o[0]=__builtin_amdgcn_mfma_f32_32x32x16_bf16(PAF(0),VFR(0),o[0],0,0,0), C0,0); \
    GAPB(o[1]=__builtin_amdgcn_mfma_f32_32x32x16_bf16(PAF(0),VFR(4),o[1],0,0,0), C0,4); \
    KRD(GL,0); GAPB(o[0]=__builtin_amdgcn_mfma_f32_32x32x16_bf16(PAF(1),VFR(1),o[0],0,0,0), C0,8); \
    KRD(GL,1); GAPB(o[1]=__builtin_amdgcn_mfma_f32_32x32x16_bf16(PAF(1),VFR(5),o[1],0,0,0), C0,12); \
    KRD(GL,2); GAPB(o[0]=__builtin_amdgcn_mfma_f32_32x32x16_bf16(PAF(2),VFR(2),o[0],0,0,0), C1,0); \
    KRD(GL,3); GAPB(o[1]=__builtin_amdgcn_mfma_f32_32x32x16_bf16(PAF(2),VFR(6),o[1],0,0,0), C1,4); \
    GAPB(o[0]=__builtin_amdgcn_mfma_f32_32x32x16_bf16(PAF(3),VFR(3),o[0],0,0,0), C1,8); \
    GAPB(o[1]=__builtin_amdgcn_mfma_f32_32x32x16_bf16(PAF(3),VFR(7),o[1],0,0,0), C1,12); \
    }while(0)
  int t=1;
  #undef CMASK
  #define CMASK(P0,P1,t) do{}while(0)
  for(;t+5<NT;t+=2){
    STEP(pB0,pB1,pA0,pA1,t,true,true,true);     WAIT_BAR(2); RESC(); ROT();
    STEP(pA0,pA1,pB0,pB1,t+1,true,true,true);   WAIT_BAR(2); RESC(); ROT();
  }
  #undef CMASK
  #define CMASK(P0,P1,t) do{int jb_=(t)-(NT-4); if(jb_>=0)cmask(P0,P1,jb_,qrel,hi);}while(0)
  #define ENDW(tt) do{ if((tt)+3<NT){WAIT_BAR(2);} else if((tt)+2<NT){WAIT_BAR(1);} else {WAIT_BAR(0);} }while(0)
  for(;t+1<NT;t+=2){
    STEP(pB0,pB1,pA0,pA1,t,(t+3<NT),(t+1<NT),(t+1<NT));       ENDW(t);   RESC(); ROT();
    STEP(pA0,pA1,pB0,pB1,t+1,(t+4<NT),(t+2<NT),(t+2<NT));     ENDW(t+1); RESC(); ROT();
  }
  STEP(pB0,pB1,pA0,pA1,NT-1,false,false,false); RESC();
  { float sacc=pB0[0]+pB0[1]; _Pragma("unroll") for(int r=2;r<16;++r)sacc+=pB0[r]; _Pragma("unroll") for(int r=0;r<16;++r)sacc+=pB1[r]; l_reg+=sacc;
    pw0=(u32x4){PKW(pB0,0),PKW(pB0,2),PKW(pB0,4),PKW(pB0,6)};pw1=(u32x4){PKW(pB0,8),PKW(pB0,10),PKW(pB0,12),PKW(pB0,14)};pw2=(u32x4){PKW(pB1,0),PKW(pB1,2),PKW(pB1,4),PKW(pB1,6)};pw3=(u32x4){PKW(pB1,8),PKW(pB1,10),PKW(pB1,12),PKW(pB1,14)};
    SBAR(); pv(o,vb0+sl_cur,PAF(0),PAF(1),PAF(2),PAF(3)); }
  #undef PKW
  #undef PAF
  #undef VFR
  #undef PIN
  #undef MX3
  #undef GAPA
  #undef GAPB
  #undef EX
  #undef VRD
  #undef KRD
  #undef STEP
  #undef ENDW
  {auto rr=__builtin_amdgcn_permlane32_swap(__float_as_uint(l_reg),__float_as_uint(l_reg),false,false);l_reg=__uint_as_float(rr[0])+__uint_as_float(rr[1]);}
  if(hi==0)wsf[32+r32]=l_reg;asm volatile("s_waitcnt lgkmcnt(0)":::"memory");
  float rli[16];
  #pragma unroll
  for(int r=0;r<16;++r)rli[r]=__builtin_amdgcn_rcpf(wsf[32+crow(r,hi)]);
  bf16*Ow=O+(rowbase+q0+wid*QBLK)*OPITCH+cm*512+h*128+vh*64;
  { bf16*stg=(bf16*)(shm+LDS_OST)+wid*2048;
    #pragma unroll
    for(int r=0;r<16;++r){const int orow=crow(r,hi);
      #pragma unroll
      for(int d0=0;d0<2;++d0)stg[orow*64+d0*32+r32]=__float2bfloat16(o[d0][r]*rli[r]);}
    asm volatile("s_waitcnt lgkmcnt(0)":::"memory");
    #pragma unroll
    for(int i=0;i<4;++i){const int row=i*8+(lane>>3),ch=lane&7; const u32x4 v=*(const u32x4*)(stg+row*64+ch*8); ATTN_STORE16(Ow+(long)row*OPITCH+ch*8,v);} }
  asm volatile("s_waitcnt lgkmcnt(0)\n\ts_barrier":::"memory");
  #undef DMA_K
  #undef DMA_V
  #undef KXSET
  #undef SETRHO
  #undef CMASK
  #undef START
  #undef RESC
  #undef ROT
}
constexpr int ATTN_LDS_BYTES=LDS_BYTES;
#undef SBAR
#undef WAIT_BAR
}
#define GAS __attribute__((address_space(1)))
#define LAS __attribute__((address_space(3)))
typedef unsigned short bf16;
typedef unsigned v4u __attribute__((ext_vector_type(4)));
typedef float f32x4 __attribute__((ext_vector_type(4)));
typedef short bf16x8 __attribute__((ext_vector_type(8)));
typedef GAS unsigned gu32;
typedef GAS unsigned long long gu64;
#define RLX_AGENT __ATOMIC_RELAXED, __HIP_MEMORY_SCOPE_AGENT
#define LDS_WAIT() asm volatile("s_waitcnt lgkmcnt(0)" ::: "memory")
#define VM_WAIT() asm volatile("s_waitcnt vmcnt(0)" ::: "memory")
__device__ __forceinline__ unsigned long long rt() { return __builtin_amdgcn_s_memrealtime(); }
__device__ __forceinline__ unsigned f2bf(float f) { unsigned u = __builtin_bit_cast(unsigned, f); return (u + 0x7fffu + ((u >> 16) & 1u)) >> 16; }
__device__ __forceinline__ unsigned pk2(float lo, float hi) { return f2bf(lo) | (f2bf(hi) << 16); }

#define XB_TMO      128
#define XB_XCNT(j)  (256  + 64 * (j))
#define XB_XSUB(j)  (1280 + 64 * (j))
#define XB_XGEN(j)  (2304 + 64 * (j))
#define XB_TOP      3328
#define XB_TOPGEN   3392
#define XCD_BAR_WORDS 3456
#define XB_SPIN_CAP (1u << 18)

__device__ __forceinline__ unsigned xb_ld(unsigned* p)              { return __hip_atomic_load(p, __ATOMIC_RELAXED, __HIP_MEMORY_SCOPE_AGENT); }
__device__ __forceinline__ unsigned xb_add(unsigned* p, unsigned v) { return __hip_atomic_fetch_add(p, v, __ATOMIC_RELAXED, __HIP_MEMORY_SCOPE_AGENT); }
__device__ __forceinline__ unsigned xb_xcc_id() { return (unsigned)__builtin_amdgcn_s_getreg((3 << 11) | 20) & 0xFu; }
#define XB_SPIN(cond, bar) do { unsigned _sp = 0; while (cond) { __builtin_amdgcn_s_sleep(1); \
    if ((++_sp & 255u) == 0u) { if (xb_ld(&(bar)[XB_TMO])) break; if (_sp > XB_SPIN_CAP) { atomicAdd(&(bar)[XB_TMO], 1u); break; } } } } while (0)

struct XcdBarrier {
    unsigned* bar; unsigned x;
    volatile LAS unsigned* st;
};

__device__ __forceinline__ XcdBarrier xcd_barrier_post(unsigned* bar, volatile LAS unsigned* st) {
    XcdBarrier b; b.bar = bar; b.x = xb_xcc_id(); b.st = st;
    if (threadIdx.x == 0) (void)xb_add(&bar[XB_XCNT(b.x)], 1u);
    return b;
}
__device__ __forceinline__ void xcd_barrier_complete(unsigned* bar, unsigned x, unsigned& nloc, unsigned& nx) {
    const unsigned G = gridDim.x * gridDim.y * gridDim.z;
    unsigned sum, cnt, mine, sp = 0u;
    for (;;) {
        sum = 0u; cnt = 0u; mine = 0u;
#pragma unroll
        for (unsigned j = 0; j < 16; ++j) { const unsigned c = xb_ld(&bar[XB_XCNT(j)]); sum += c; cnt += (c > 0u) ? 1u : 0u; mine = (j == x) ? c : mine; }
        if (sum == G) break;
        __builtin_amdgcn_s_sleep(1);
        if ((++sp & 255u) == 0u) { if (xb_ld(&bar[XB_TMO])) break; if (sp > XB_SPIN_CAP) { atomicAdd(&bar[XB_TMO], 1u); break; } }
    }
    nloc = mine > 0u ? mine : 1u; nx = cnt > 0u ? cnt : 1u;
}

__device__ __forceinline__ void xcd_barrier(const XcdBarrier& b) {
    asm volatile("s_waitcnt vmcnt(0)" ::: "memory");
    __syncthreads();
    if (threadIdx.x == 0) {
        unsigned* bar = b.bar;
        __builtin_amdgcn_s_waitcnt(0);
        unsigned nloc = b.st[0], nx = b.st[1];
        if (nloc == 0u) { xcd_barrier_complete(bar, b.x, nloc, nx); b.st[0] = nloc; b.st[1] = nx; }
        const unsigned old = xb_add(&bar[XB_XSUB(b.x)], 1u);
        const unsigned gen = old / nloc;
        if (old + 1u == (gen + 1u) * nloc) {
            __builtin_amdgcn_fence(__ATOMIC_RELEASE, "agent");
            asm volatile("s_waitcnt vmcnt(0)" ::: "memory");
            const unsigned og = xb_add(&bar[XB_TOP], 1u);
            const unsigned tg = og / nx;
            if (og + 1u == (tg + 1u) * nx) xb_add(&bar[XB_TOPGEN], 1u);
            else XB_SPIN(xb_ld(&bar[XB_TOPGEN]) == tg, bar);
            __builtin_amdgcn_fence(__ATOMIC_ACQUIRE, "agent");
            xb_add(&bar[XB_XGEN(b.x)], 1u);
            asm volatile("s_waitcnt vmcnt(0)" ::: "memory");
        } else {
            XB_SPIN(xb_ld(&bar[XB_XGEN(b.x)]) == gen, bar);
            __builtin_amdgcn_fence(__ATOMIC_ACQUIRE, "agent");
            asm volatile("s_waitcnt vmcnt(0)" ::: "memory");
        }
    }
    __syncthreads();
}

#include <hip/hip_cooperative_groups.h>
namespace cg = cooperative_groups;
constexpr int NWAVES = 8;
constexpr int SEQ = 8192, D = 1024, M = 16384, DFF = 2816, NUP = 5632, NINP = 3592, NPROJ = 3584;
constexpr float EPS = 1e-6f;
constexpr size_t MiB = 1u << 20;
constexpr size_t WS_CTL = 0, CTL_ZERO_BYTES = 1 * MiB;
constexpr size_t WS_WIN = 2 * MiB, WS_WO = 9 * MiB, WS_WUP = 11 * MiB, WS_WDN = 22 * MiB, WS_GAB = 28 * MiB, WS_HALO = 29 * MiB, WS_GL = 35 * MiB;
constexpr size_t WS_XN = 36 * MiB;
constexpr size_t WS_PREP = 36 * MiB;
constexpr size_t WS_G = 68 * MiB;
constexpr size_t WS_PA = 124 * MiB;
constexpr size_t WS_PG = 188 * MiB;
constexpr size_t WS_OATT = 188 * MiB;
constexpr size_t WS_OG = 220 * MiB;
constexpr size_t WS_X1 = 188 * MiB;
constexpr size_t WS_END = 252 * MiB;
constexpr int CW_NORM = 704;
constexpr int CW_QUEUE = 64;
constexpr int CW_BAR = 4096;
constexpr int PREP_STRIDE = 90112, PO_W = 0, PO_QD = 16384, PO_KDT = 32768, PO_QK = 49152, PO_U = 57344;
constexpr int RING_BYTES = 131072, XH_OFF = RING_BYTES, MISC_OFF = XH_OFF + 8192, LDS_BYTES = 147456;

struct Frame {
    LAS unsigned char* lds; volatile LAS unsigned* MISC;
    int vcu, G;
};
__device__ __forceinline__ float wave_sum(float v) {
#pragma unroll
    for (int o = 1; o < 64; o <<= 1) v += __shfl_xor(v, o);
    return v;
}
__device__ __forceinline__ float bf2f(unsigned short b) { return __uint_as_float(((unsigned)b) << 16); }
typedef float f32x2m_t __attribute__((ext_vector_type(2))); typedef __bf16 bf16x2m_t __attribute__((ext_vector_type(2)));
__device__ __forceinline__ unsigned cvtpk(float lo, float hi) { f32x2m_t v = {lo, hi}; bf16x2m_t b = __builtin_convertvector(v, bf16x2m_t); return __builtin_bit_cast(unsigned, b); }

__device__ __forceinline__ void p0_transpose_item(const float* W, int pitch, int col0, int k0, bf16* WT, int n0, int K, LAS float* scr, int lane) {
#pragma unroll 8
    for (int i = 0; i < 32; ++i) { const int kk = 2 * i + (lane >> 5); scr[kk * 33 + (lane & 31)] = W[(size_t)(k0 + kk) * pitch + col0 + (lane & 31)]; }
    LDS_WAIT(); asm volatile("" ::: "memory");
    const int c = lane & 7;
#pragma unroll
    for (int j = 0; j < 4; ++j) { const int n = (lane >> 3) + 8 * j; const LAS float* s = scr + (8 * c) * 33 + n;
        v4u o; o.x = pk2(s[0 * 33], s[1 * 33]); o.y = pk2(s[2 * 33], s[3 * 33]); o.z = pk2(s[4 * 33], s[5 * 33]); o.w = pk2(s[6 * 33], s[7 * 33]);
        *(GAS v4u*)(WT + (size_t)(n0 + n) * K + k0 + 8 * c) = o; }
    LDS_WAIT(); asm volatile("" ::: "memory");
}
__device__ __forceinline__ void rms_row(const float* xrow, const float* gain, int lane, f32x4 (&v)[4]) {
    const GAS f32x4* xr = (const GAS f32x4*)xrow + lane; const GAS f32x4* gr = (const GAS f32x4*)gain + lane;
    float s = 0.f;
#pragma unroll
    for (int j = 0; j < 4; ++j) { v[j] = xr[64 * j]; s += (v[j].x * v[j].x + v[j].y * v[j].y) + (v[j].z * v[j].z + v[j].w * v[j].w); }
    const float r = 1.0f / sqrtf(wave_sum(s) * (1.f / D) + EPS);
#pragma unroll
    for (int j = 0; j < 4; ++j) { const f32x4 g = gr[64 * j]; v[j] = v[j] * r * g; }
}
__device__ __forceinline__ void store_row_bf16(bf16* orow, int lane, const f32x4 (&v)[4]) {
    GAS unsigned long long* o8 = (GAS unsigned long long*)orow + lane;
#pragma unroll
    for (int j = 0; j < 4; ++j) o8[64 * j] = (unsigned long long)cvtpk(v[j].x, v[j].y) | ((unsigned long long)cvtpk(v[j].z, v[j].w) << 32);
}

namespace gdn {
typedef float f32x16 __attribute__((ext_vector_type(16)));
constexpr int KP = 136, L_KBF = 0, L_KBB = 17408, L_QBF = 34816, L_KDEC = 52224, L_R = 69632, RP = 132, L_LM = 103424, LP = 68, L_GC = 120832, L_BETA = 121088;
__device__ __forceinline__ int crow(int r, int hi) { return (r & 3) + 8 * (r >> 2) + 4 * hi; }
#define GDN_BAR() asm volatile("s_waitcnt lgkmcnt(0)\n\ts_barrier" ::: "memory")
__device__ __forceinline__ void prep_chunk(LAS unsigned char* lds, int tid, int chunk, const bf16* PG, const float* GAB, const float* convw, const float* a_log, const float* dt_bias,
                                           unsigned char* prep, float* GL) {
    const int lane = tid & 63, wid = __builtin_amdgcn_readfirstlane(tid >> 6);
    const int bh = chunk >> 7, n = chunk & 127, b = bh >> 2, h = bh & 3; const int row0 = b * SEQ + n * 64;
    LAS float* gcs = (LAS float*)(lds + L_GC); LAS float* betas = (LAS float*)(lds + L_BETA);
    unsigned char* cb = prep + (size_t)chunk * PREP_STRIDE;
    if (wid == 0) {
        const float ga = GAB[(size_t)(row0 + lane) * 8 + h], gb = GAB[(size_t)(row0 + lane) * 8 + 4 + h];
        const float xs = ga + dt_bias[h]; const float sp = xs > 20.f ? xs : log1pf(__expf(xs));
        float g = -__expf(a_log[h]) * sp;
#pragma unroll
        for (int o = 1; o < 64; o <<= 1) { const float t = __shfl_up(g, o); if (lane >= o) g += t; }
        gcs[lane] = g; betas[lane] = 1.0f / (1.0f + __expf(-gb));
        if (lane == 63) GL[chunk] = __expf(g);
    }
    GDN_BAR();
    const float gc_last = gcs[63];
    {
        const int sub = tid & 15, pl = tid >> 4;
#pragma unroll
        for (int tensor = 0; tensor < 3; ++tensor) {
            const int col = tensor * 512 + h * 128 + sub * 8;
            f32x4 wv[4][2];
#pragma unroll
            for (int j = 0; j < 4; ++j) { wv[j][0] = *(const f32x4*)(convw + j * 1536 + col); wv[j][1] = *(const f32x4*)(convw + j * 1536 + col + 4); }
#pragma unroll
            for (int ph = 0; ph < 2; ++ph) {
                const int p = ph * 32 + pl;
                float y[8];
#pragma unroll
                for (int e = 0; e < 8; ++e) y[e] = 0.f;
#pragma unroll
                for (int j = 0; j < 4; ++j) {
                    const int pr = p - 3 + j;
                    v4u raw = (v4u){0u, 0u, 0u, 0u};
                    if (n > 0 || pr >= 0) raw = *(const GAS v4u*)(PG + (size_t)(row0 + pr) * 1536 + col);
#pragma unroll
                    for (int q = 0; q < 4; ++q) { y[2 * q] += wv[j][q >> 1][(2 * q) & 3] * __uint_as_float(raw[q] << 16); y[2 * q + 1] += wv[j][q >> 1][(2 * q + 1) & 3] * __uint_as_float(raw[q] & 0xffff0000u); }
                }
                float ss = 0.f;
#pragma unroll
                for (int e = 0; e < 8; ++e) { y[e] = pg8::silu_f(y[e]); ss += y[e] * y[e]; }
                const float gcp = gcs[p], bp = betas[p];
                if (tensor < 2) {
                    ss += __shfl_xor(ss, 1); ss += __shfl_xor(ss, 2); ss += __shfl_xor(ss, 4); ss += __shfl_xor(ss, 8);
                    float rn = 1.0f / sqrtf(ss + EPS); if (tensor == 0) rn *= 0.08838834764831845f;
#pragma unroll
                    for (int e = 0; e < 8; ++e) y[e] *= rn;
                    v4u o; o.x = cvtpk(y[0], y[1]); o.y = cvtpk(y[2], y[3]); o.z = cvtpk(y[4], y[5]); o.w = cvtpk(y[6], y[7]);
                    if (tensor == 0) {
                        *(LAS v4u*)(lds + L_QBF + (p * KP + sub * 8) * 2) = o;
                        const float eg = __expf(gcp); v4u d; d.x = cvtpk(y[0] * eg, y[1] * eg); d.y = cvtpk(y[2] * eg, y[3] * eg); d.z = cvtpk(y[4] * eg, y[5] * eg); d.w = cvtpk(y[6] * eg, y[7] * eg);
                        *(GAS v4u*)(cb + PO_QD + ((((p >> 5) * 8 + (sub >> 1)) * 64 + (sub & 1) * 32 + (p & 31)) * 16)) = d;
                    } else {
                        *(LAS v4u*)(lds + L_KBF + (p * KP + sub * 8) * 2) = o;
                        v4u kb; kb.x = cvtpk(y[0] * bp, y[1] * bp); kb.y = cvtpk(y[2] * bp, y[3] * bp); kb.z = cvtpk(y[4] * bp, y[5] * bp); kb.w = cvtpk(y[6] * bp, y[7] * bp);
                        *(LAS v4u*)(lds + L_KBB + (p * KP + sub * 8) * 2) = kb;
                        const float ed = __expf(gc_last - gcp); v4u kd; kd.x = cvtpk(y[0] * ed, y[1] * ed); kd.y = cvtpk(y[2] * ed, y[3] * ed); kd.z = cvtpk(y[4] * ed, y[5] * ed); kd.w = cvtpk(y[6] * ed, y[7] * ed);
                        *(LAS v4u*)(lds + L_KDEC + (p * KP + sub * 8) * 2) = kd;
                    }
                } else {
                    LAS float* R = (LAS float*)(lds + L_R) + p * RP + sub * 8;
                    *(LAS f32x4*)R = (f32x4){y[0] * bp, y[1] * bp, y[2] * bp, y[3] * bp}; *(LAS f32x4*)(R + 4) = (f32x4){y[4] * bp, y[5] * bp, y[6] * bp, y[7] * bp};
                }
            }
        }
    }
    GDN_BAR();
    {
        const int isqk = wid >> 2, tile = wid & 3, ti = tile >> 1, tj = tile & 1, r32 = lane & 31, hi = lane >> 5;
        bf16* qkg = (bf16*)(cb + PO_QK);
        if (!(ti == 0 && tj == 1)) {
            f32x16 acc = f32x16{};
            const LAS unsigned char* ap = lds + (isqk ? L_QBF : L_KBB) + ((32 * ti + r32) * KP + hi * 8) * 2;
            const LAS unsigned char* bp = lds + L_KBF + ((32 * tj + r32) * KP + hi * 8) * 2;
#pragma unroll
            for (int ks = 0; ks < 8; ++ks) acc = __builtin_amdgcn_mfma_f32_32x32x16_bf16(*(const LAS bf16x8*)(ap + ks * 32), *(const LAS bf16x8*)(bp + ks * 32), acc, 0, 0, 0);
            const int j = 32 * tj + r32; const float gcj = gcs[j];
#pragma unroll
            for (int r = 0; r < 16; ++r) {
                const int i = 32 * ti + crow(r, hi);
                const bool keep = isqk ? (j <= i) : (j < i);
                const float val = keep ? acc[r] * __expf(gcs[i] - gcj) : 0.f;
                if (isqk) qkg[(((i >> 5) * 4 + (j >> 4)) * 64 + ((j >> 3) & 1) * 32 + (i & 31)) * 8 + (j & 7)] = (bf16)f2bf(val); else ((LAS float*)(lds + L_LM))[i * LP + j] = val;
            }
        } else if (isqk) {
#pragma unroll
            for (int r = 0; r < 16; ++r) { const int i = crow(r, hi), j = 32 + r32; qkg[(((i >> 5) * 4 + (j >> 4)) * 64 + ((j >> 3) & 1) * 32 + (i & 31)) * 8 + (j & 7)] = 0; }
        }
    }
    GDN_BAR();
    if (wid < 4) {
        const int c = tid; float x[64];
        int z_; asm volatile("v_mov_b32 %0, 0" : "=v"(z_));
        const LAS float* Lm = (const LAS float*)(lds + L_LM) + z_; const LAS float* gcv = gcs + z_;
        if (c < 128) {
#pragma unroll
            for (int p = 0; p < 64; ++p) x[p] = ((const LAS float*)(lds + L_R))[p * RP + c];
        } else {
#pragma unroll
            for (int p = 0; p < 64; ++p) x[p] = bf2f(((const LAS bf16*)(lds + L_KBB))[p * KP + (c - 128)]) * __expf(gcv[p]);
        }
#pragma unroll
        for (int i = 1; i < 64; ++i) {
            float a = x[i];
#pragma unroll
            for (int jj = 0; jj < (i + 3) / 4; ++jj) { const f32x4 l = *(const LAS f32x4*)(Lm + i * LP + 4 * jj);
#pragma unroll
                for (int e = 0; e < 4; ++e) if (4 * jj + e < i) a -= l[e] * x[4 * jj + e]; }
            x[i] = a;
        }
        if (c < 128) {
            float* ug = (float*)(cb + PO_U);
#pragma unroll
            for (int g = 0; g < 16; ++g) *(f32x4*)(ug + (g * 128 + c) * 4) = (f32x4){x[4 * g], x[4 * g + 1], x[4 * g + 2], x[4 * g + 3]};
        } else {
            bf16* wg = (bf16*)(cb + PO_W);
#pragma unroll
            for (int p = 0; p < 64; ++p) { const int dk = c - 128; wg[((((p >> 5) * 8 + (dk >> 4)) * 64 + ((dk >> 3) & 1) * 32 + (p & 31)) * 8) + (dk & 7)] = (bf16)f2bf(x[p]); }
        }
    } else {
        const int t2 = tid - 256;
#pragma unroll
        for (int it = 0; it < 2; ++it) {
            const int item = t2 + 256 * it, dk = item & 127, pgp = item >> 7;
            const LAS bf16* src = (const LAS bf16*)(lds + L_KDEC) + (16 * pgp) * KP + dk;
            unsigned w[8];
#pragma unroll
            for (int q = 0; q < 8; ++q) w[q] = (unsigned)src[(2 * q) * KP] | ((unsigned)src[(2 * q + 1) * KP] << 16);
            GAS v4u* dst = (GAS v4u*)(cb + PO_KDT) + (((dk >> 5) * 4 + pgp) * 64 + (dk & 31));
            dst[0] = (v4u){w[0], w[1], w[2], w[3]}; dst[32] = (v4u){w[4], w[5], w[6], w[7]};
        }
    }
    GDN_BAR();
}

__device__ __forceinline__ void scan(LAS unsigned char* lds, int tid, int bh, int s, const unsigned char* prep, const float* GL, bf16* OG) {
    const int lane = tid & 63, wid = __builtin_amdgcn_readfirstlane(tid >> 6), r32 = lane & 31, hi = lane >> 5;
    const int b = bh >> 2, h = bh & 3;
    constexpr int SP = 136, VP = 72, L_ST = 0, L_VN = 32 * SP * 2;
    for (int i = tid; i < (32 * SP * 2 + 32 * VP * 2) / 4; i += 512) ((LAS unsigned*)lds)[i] = 0u;
    f32x16 Sacc = f32x16{};
    const int role = wid < 2 ? 0 : (wid < 4 ? 1 : 2);
    const int rb = wid & 1, db = wid & 3;
    const unsigned char* base = prep + (size_t)(bh * 128) * PREP_STRIDE;
    const unsigned char* pB = base + (role == 0 ? PO_U + (((rb * 8 + hi) * 128 + 32 * s + r32) * 4) * 4 : (role == 1 ? PO_QK + ((rb * 4) * 64 + lane) * 16 : PO_KDT + ((db * 4) * 64 + lane) * 16));
    const int strideB = role == 0 ? 4096 : 1024;
    const unsigned char* pA = role == 2 ? pB : base + (role == 0 ? PO_W : PO_QD) + ((rb * 8) * 64 + lane) * 16;
    const int strideA = role == 2 ? 0 : 1024;
    v4u RA[3][8], RB[3][4]; float RG[3];
#pragma unroll
    for (int q = 0; q < 3; ++q) { RG[q] = 1.f;
#pragma unroll
        for (int k = 0; k < 8; ++k) RA[q][k] = (v4u){0u, 0u, 0u, 0u};
#pragma unroll
        for (int k = 0; k < 4; ++k) RB[q][k] = (v4u){0u, 0u, 0u, 0u}; }
#define SCAN_LOAD(S, ci) do { const int ci_ = (ci) < 128 ? (ci) : 127; const size_t off_ = (size_t)ci_ * PREP_STRIDE; \
        _Pragma("unroll") for (int ks = 0; ks < 8; ++ks) RA[S][ks] = *(const GAS v4u*)(pA + off_ + ks * strideA); \
        _Pragma("unroll") for (int ks = 0; ks < 4; ++ks) RB[S][ks] = *(const GAS v4u*)(pB + off_ + ks * strideB); \
        RG[S] = GL[bh * 128 + ci_]; } while (0)
    const LAS unsigned char* stp = lds + L_ST + (r32 * SP + 8 * hi) * 2;
    const LAS unsigned char* vnp = lds + L_VN + (r32 * VP + 8 * hi) * 2;
    typedef unsigned u32x2v __attribute__((ext_vector_type(2)));
#define SCAN_STEP(S, SL, ii) do { const int i_ = (ii); SCAN_LOAD(SL, i_ + 2); \
        f32x16 acc = f32x16{}; \
        if (role < 2) { f32x16 acc1 = f32x16{}; \
            _Pragma("unroll") for (int ks = 0; ks < 8; ks += 2) { \
                acc = __builtin_amdgcn_mfma_f32_32x32x16_bf16(__builtin_bit_cast(bf16x8, RA[S][ks]), *(const LAS bf16x8*)(stp + ks * 32), acc, 0, 0, 0); \
                acc1 = __builtin_amdgcn_mfma_f32_32x32x16_bf16(__builtin_bit_cast(bf16x8, RA[S][ks + 1]), *(const LAS bf16x8*)(stp + (ks + 1) * 32), acc1, 0, 0, 0); } \
            acc = acc + acc1; \
            if (role == 0) { \
                _Pragma("unroll") for (int q = 0; q < 4; ++q) { u32x2v w; \
                    w.x = cvtpk(__uint_as_float(RB[S][q][0]) - acc[4 * q], __uint_as_float(RB[S][q][1]) - acc[4 * q + 1]); w.y = cvtpk(__uint_as_float(RB[S][q][2]) - acc[4 * q + 2], __uint_as_float(RB[S][q][3]) - acc[4 * q + 3]); \
                    *(LAS u32x2v*)(lds + L_VN + (r32 * VP + 32 * rb + 8 * q + 4 * hi) * 2) = w; } } } \
        GDN_BAR(); \
        if (role == 1) { \
            _Pragma("unroll") for (int ks = 0; ks < 4; ++ks) acc = __builtin_amdgcn_mfma_f32_32x32x16_bf16(__builtin_bit_cast(bf16x8, RB[S][ks]), *(const LAS bf16x8*)(vnp + ks * 32), acc, 0, 0, 0); \
            bf16* og = OG + (size_t)(b * SEQ + i_ * 64 + 32 * rb) * 512 + h * 128 + 32 * s + r32; \
            _Pragma("unroll") for (int r = 0; r < 16; r += 2) { const unsigned pk = cvtpk(acc[r], acc[r + 1]); og[(size_t)crow(r, hi) * 512] = (bf16)(pk & 0xffffu); og[(size_t)crow(r + 1, hi) * 512] = (bf16)(pk >> 16); } \
        } else if (role == 2) { \
            Sacc = Sacc * RG[S]; \
            _Pragma("unroll") for (int ks = 0; ks < 4; ++ks) Sacc = __builtin_amdgcn_mfma_f32_32x32x16_bf16(__builtin_bit_cast(bf16x8, RB[S][ks]), *(const LAS bf16x8*)(vnp + ks * 32), Sacc, 0, 0, 0); \
            _Pragma("unroll") for (int q = 0; q < 4; ++q) { u32x2v w; w.x = cvtpk(Sacc[4 * q], Sacc[4 * q + 1]); w.y = cvtpk(Sacc[4 * q + 2], Sacc[4 * q + 3]); \
                *(LAS u32x2v*)(lds + L_ST + (r32 * SP + 32 * db + 8 * q + 4 * hi) * 2) = w; } } \
        GDN_BAR(); } while (0)
    SCAN_LOAD(0, 0); SCAN_LOAD(1, 1);
    GDN_BAR();
    for (int i = 0; i < 126; i += 3) { SCAN_STEP(0, 2, i); SCAN_STEP(1, 0, i + 1); SCAN_STEP(2, 1, i + 2); }
    SCAN_STEP(0, 2, 126); SCAN_STEP(1, 0, 127);
#undef SCAN_LOAD
#undef SCAN_STEP
}
}

struct Args { const float* in[19]; float* out; unsigned char* ws; };
__global__ void __launch_bounds__(NWAVES * 64, 2) mega_fwd(Args) {
    extern __shared__ __attribute__((aligned(16))) unsigned char lds[];
    cg::grid_group grid = cg::this_grid();
    Frame F;
    F.lds = (LAS unsigned char*)lds; F.MISC = (volatile LAS unsigned*)(F.lds + MISC_OFF);
    F.G = gridDim.x; { const int bx = blockIdx.x; F.vcu = (F.G % 8 == 0) ? (bx % 8) * (F.G / 8) + bx / 8 : bx; }
#define KARGP() const __attribute__((address_space(4))) unsigned long long* kp_ = (const __attribute__((address_space(4))) unsigned long long*)__builtin_amdgcn_kernarg_segment_ptr(); asm volatile("" : "+s"(kp_))
#define INP(k) ((const float*)(GAS const float*)(kp_[k]))
#define WSB ((unsigned char*)(GAS unsigned char*)(kp_[20]))
#define OUT ((float*)(GAS float*)(kp_[19]))
#define in_x INP(0)
#define attn_g INP(1)
#define w_in INP(2)
#define lq1 INP(3)
#define lk1 INP(4)
#define lq2 INP(5)
#define lk2 INP(6)
#define subln_g INP(7)
#define gconv_w INP(8)
#define a_log INP(9)
#define dt_bias INP(10)
#define gnorm_g INP(11)
#define w_out INP(12)
#define ffn_g INP(13)
#define w_up INP(14)
#define fconv_w INP(15)
#define fconv_b INP(16)
#define w_down INP(17)
#define final_g INP(18)
#define WinT ((bf16*)(WSB + WS_WIN))
#define WoT ((bf16*)(WSB + WS_WO))
#define WupT ((bf16*)(WSB + WS_WUP))
#define WdnT ((bf16*)(WSB + WS_WDN))
#define GAB ((float*)(WSB + WS_GAB))
#define HALO ((float*)(WSB + WS_HALO))
#define GL ((float*)(WSB + WS_GL))
#define XN ((bf16*)(WSB + WS_XN))
#define PREP (WSB + WS_PREP)
#define Gb ((bf16*)(WSB + WS_G))
#define PA ((bf16*)(WSB + WS_PA))
#define PGb ((bf16*)(WSB + WS_PG))
#define OATT ((bf16*)(WSB + WS_OATT))
#define OGb ((bf16*)(WSB + WS_OG))
#define X1 ((float*)(WSB + WS_X1))
#define CTLP ((gu32*)(GAS unsigned*)(kp_[20]))
    for (int u = threadIdx.x; u < (LDS_BYTES - MISC_OFF) / 4; u += NWAVES * 64) ((LAS unsigned*)(F.lds + MISC_OFF))[u] = 0u;
    __syncthreads();
    { KARGP(); (void)xcd_barrier_post((unsigned*)(CTLP + CW_BAR), F.MISC + 8); }
    grid.sync();
#ifdef TSTAMP
    if (blockIdx.x == 0 && threadIdx.x == 0) { KARGP(); ((unsigned long long*)(CTLP + 600))[0] = __builtin_amdgcn_s_memrealtime(); }
#endif
#define GRID_BAR() do { const __attribute__((address_space(4))) unsigned long long* kq_ = (const __attribute__((address_space(4))) unsigned long long*)__builtin_amdgcn_kernarg_segment_ptr(); asm volatile("" : "+s"(kq_)); \
        XcdBarrier b_; b_.bar = (unsigned*)(GAS unsigned*)(kq_[20]) + CW_BAR; b_.x = xb_xcc_id(); b_.st = F.MISC + 8; xcd_barrier(b_); } while (0)
#define PHASE_IDS() int tid = threadIdx.x; asm volatile("" : "+v"(tid)); const int lane = tid & 63, wave = __builtin_amdgcn_readfirstlane(tid >> 6); const int gw = F.vcu * NWAVES + wave, NGW = F.G * NWAVES; (void)lane; (void)gw; (void)NGW; KARGP()

    {
        PHASE_IDS();
        LAS float* scr = (LAS float*)(F.lds + wave * 16384);
        constexpr int I_IN = 112 * 16, I_O = 32 * 16, I_UP = 176 * 16, I_DN = 32 * 44, NITEMS = I_IN + I_O + I_UP + I_DN;
        for (int it = gw; it < NITEMS; it += NGW) {
            int r = it;
            if (r < I_IN) { const int nb = r % 112, kb = r / 112, n0 = 32 * nb; const int c0 = n0 < 1536 ? n0 : (n0 < 2048 ? 3080 + (n0 - 1536) : 1536 + (n0 - 2048));
                p0_transpose_item(w_in, NINP, c0, 64 * kb, WinT, n0, D, scr, lane); continue; } r -= I_IN;
            if (r < I_O) { const int nb = r % 32, kb = r / 32; p0_transpose_item(w_out, D, 32 * nb, 64 * kb, WoT, 32 * nb, D, scr, lane); continue; } r -= I_O;
            if (r < I_UP) { const int nb = r % 176, kb = r / 176; const int c0 = ((nb >> 2) & 1) * DFF + 128 * (nb >> 3) + 32 * (nb & 3);
                p0_transpose_item(w_up, NUP, c0, 64 * kb, WupT, 32 * nb, D, scr, lane); continue; } r -= I_UP;
            { const int nb = r % 32, kb = r / 32; p0_transpose_item(w_down, D, 32 * nb, 64 * kb, WdnT, 32 * nb, DFF, scr, lane); }
        }
        __syncthreads();
        LAS float* Wab = (LAS float*)F.lds;
        for (int i = tid; i < 2048; i += NWAVES * 64) { const int k = i >> 1, hf = i & 1; *(LAS f32x4*)(Wab + k * 8 + 4 * hf) = *(const f32x4*)(w_in + (size_t)k * NINP + 3072 + 4 * hf); }
        __syncthreads();
        for (int m = gw; m < M; m += NGW) {
            f32x4 v[4]; rms_row(in_x + (size_t)m * D, attn_g, lane, v);
            store_row_bf16(XN + (size_t)m * D, lane, v);
            float d8[8];
#pragma unroll
            for (int e = 0; e < 8; ++e) d8[e] = 0.f;
#pragma unroll
            for (int j = 0; j < 4; ++j)
#pragma unroll
                for (int q = 0; q < 4; ++q) { const int k = 4 * lane + 256 * j + q; const f32x4 wa = *(const LAS f32x4*)(Wab + k * 8), wb = *(const LAS f32x4*)(Wab + k * 8 + 4); const float hv = v[j][q];
                    d8[0] += hv * wa.x; d8[1] += hv * wa.y; d8[2] += hv * wa.z; d8[3] += hv * wa.w; d8[4] += hv * wb.x; d8[5] += hv * wb.y; d8[6] += hv * wb.z; d8[7] += hv * wb.w; }
#pragma unroll
            for (int e = 0; e < 8; ++e) d8[e] = wave_sum(d8[e]);
            if (lane == 0) { *(f32x4*)(GAB + (size_t)m * 8) = (f32x4){d8[0], d8[1], d8[2], d8[3]}; *(f32x4*)(GAB + (size_t)m * 8 + 4) = (f32x4){d8[4], d8[5], d8[6], d8[7]}; }
        }
    }
    GRID_BAR();
#ifdef TSTAMP
    if (blockIdx.x == 0 && threadIdx.x == 0) { KARGP(); ((unsigned long long*)(CTLP + 600))[1] = __builtin_amdgcn_s_memrealtime(); }
#endif
    {
        KARGP();
        pg8::Gemm g{XN, WinT, M, NPROJ, D}; pg8::StaticOrder S; S.init(M, NPROJ, F.G, (int)blockIdx.x);
        pg8::EpiProj E{PA, PGb, attn_body::C2};
        pg8::gemm_phase<pg8::EpiProj, pg8::StaticOrder, true, true>(F.lds, g, S, E);
    }
    GRID_BAR();
#ifdef TSTAMP
    if (blockIdx.x == 0 && threadIdx.x == 0) { KARGP(); ((unsigned long long*)(CTLP + 600))[2] = __builtin_amdgcn_s_memrealtime(); }
#endif
    { PHASE_IDS(); for (int ch = F.vcu; ch < 1024; ch += F.G) gdn::prep_chunk(F.lds, tid, ch, PGb, GAB, gconv_w, a_log, dt_bias, PREP, GL);
      float mx0 = 0.f, mx1 = 0.f;
      for (int m = gw; m < M; m += NGW) {
          const v4u r0 = *(const GAS v4u*)(PA + (size_t)m * 2048 + 16 * lane), r1 = *(const GAS v4u*)(PA + (size_t)m * 2048 + 16 * lane + 8); float ss = 0.f;
#pragma unroll
          for (int q = 0; q < 4; ++q) { const float a0 = __uint_as_float(r0[q] << 16), a1 = __uint_as_float(r0[q] & 0xffff0000u), b0 = __uint_as_float(r1[q] << 16), b1 = __uint_as_float(r1[q] & 0xffff0000u); ss += a0 * a0 + a1 * a1 + b0 * b0 + b1 * b1; }
          ss += __shfl_xor(ss, 1); ss += __shfl_xor(ss, 2);
          if ((m >> 13) == 0) mx0 = fmaxf(mx0, ss); else mx1 = fmaxf(mx1, ss); }
      if ((lane & 3) == 0) { atomicMax((unsigned*)(CTLP + CW_NORM + (lane >> 2)), __float_as_uint(mx0)); atomicMax((unsigned*)(CTLP + CW_NORM + 16 + (lane >> 2)), __float_as_uint(mx1)); }
    }
    GRID_BAR();
#ifdef TSTAMP
    if (blockIdx.x == 0 && threadIdx.x == 0) { KARGP(); ((unsigned long long*)(CTLP + 600))[3] = __builtin_amdgcn_s_memrealtime(); }
#endif
    {
        PHASE_IDS();
        if ((int)blockIdx.x >= F.G - 32) { const int si = (int)blockIdx.x - (F.G - 32); gdn::scan(F.lds, tid, si >> 2, si & 3, PREP, GL, OGb); }
        for (;;) {
            if (tid == 0) F.MISC[4] = __hip_atomic_fetch_add(CTLP + CW_QUEUE, 1u, __ATOMIC_RELAXED, __HIP_MEMORY_SCOPE_AGENT);
            __syncthreads();
            const int u = (int)F.MISC[4];
            __syncthreads();
            if (u >= 1024) break;
            const int qb = 31 - (u >> 5), vhd = u & 31; const int ab = vhd >> 4, ah = (vhd >> 2) & 3, ac = (vhd >> 1) & 1;
            int tsk = 0;
            { const float q2 = __uint_as_float(__hip_atomic_load((const unsigned*)(CTLP + CW_NORM + ab * 16 + ah * 2 + ac), __ATOMIC_RELAXED, __HIP_MEMORY_SCOPE_AGENT));
              const float k2 = __uint_as_float(__hip_atomic_load((const unsigned*)(CTLP + CW_NORM + ab * 16 + 8 + ah * 2 + ac), __ATOMIC_RELAXED, __HIP_MEMORY_SCOPE_AGENT));
              const float smax = sqrtf(q2 * k2) * 1.001f, sl2 = exp2f(-2.0f * (float)(ah + 1)) * 1.4426950408889634f;
              const float xk = (float)(256 * qb - 63) - (2.0f * smax + 40.0f) / sl2;
              if (xk >= 0.f) { tsk = ((int)(xk * (1.0f / 64.0f)) + 1) & ~1; if (tsk > 4 * qb) tsk = 4 * qb; }
              tsk = __builtin_amdgcn_readfirstlane(tsk); }
            attn_body::attn_unit<16>(ab, ah, ac, vhd & 1, qb, tsk, (const attn_body::bf16*)PA, (attn_body::bf16*)OATT, (char*)lds);
        }
    }
    GRID_BAR();
#ifdef TSTAMP
    if (blockIdx.x == 0 && threadIdx.x == 0) { KARGP(); ((unsigned long long*)(CTLP + 600))[4] = __builtin_amdgcn_s_memrealtime(); }
#endif
    {
        PHASE_IDS();
        float s1 = lq1[lane] * lk1[lane], s2 = lq2[lane] * lk2[lane];
        const float lam = __expf(wave_sum(s1)) - __expf(wave_sum(s2)) + 0.2f;
        const int a0 = 8 * lane, dd = 8 * (lane & 15);
        float sg[8], gg[8];
#pragma unroll
        for (int e = 0; e < 8; ++e) { sg[e] = subln_g[dd + e] * 0.8f; gg[e] = gnorm_g[dd + e]; }
        for (int m = gw; m < M; m += NGW) {
            const v4u o0 = *(const GAS v4u*)(OATT + (size_t)m * 1024 + a0), o1 = *(const GAS v4u*)(OATT + (size_t)m * 1024 + 512 + a0);
            const v4u og = *(const GAS v4u*)(OGb + (size_t)m * 512 + a0), zz = *(const GAS v4u*)(PA + (size_t)m * 2048 + 1536 + a0);
            float oa[8], ob[8], zf[8]; float ssa = 0.f, ssb = 0.f;
#pragma unroll
            for (int q = 0; q < 4; ++q) {
                oa[2 * q] = __uint_as_float(o0[q] << 16) - lam * __uint_as_float(o1[q] << 16); oa[2 * q + 1] = __uint_as_float(o0[q] & 0xffff0000u) - lam * __uint_as_float(o1[q] & 0xffff0000u);
                ob[2 * q] = __uint_as_float(og[q] << 16); ob[2 * q + 1] = __uint_as_float(og[q] & 0xffff0000u);
                zf[2 * q] = __uint_as_float(zz[q] << 16); zf[2 * q + 1] = __uint_as_float(zz[q] & 0xffff0000u);
            }
#pragma unroll
            for (int e = 0; e < 8; ++e) { ssa += oa[e] * oa[e]; ssb += ob[e] * ob[e]; }
#pragma unroll
            for (int o = 1; o < 16; o <<= 1) { ssa += __shfl_xor(ssa, o); ssb += __shfl_xor(ssb, o); }
            const float ra = 1.0f / sqrtf(ssa * (1.f / 128.f) + EPS), rb = 1.0f / sqrtf(ssb * (1.f / 128.f) + EPS);
            float ya[8], yb[8];
#pragma unroll
            for (int e = 0; e < 8; ++e) { ya[e] = oa[e] * ra * sg[e]; yb[e] = ob[e] * rb * gg[e] * pg8::silu_f(zf[e]); }
            *(GAS v4u*)(XN + (size_t)m * 1024 + a0) = (v4u){cvtpk(ya[0], ya[1]), cvtpk(ya[2], ya[3]), cvtpk(ya[4], ya[5]), cvtpk(ya[6], ya[7])};
            *(GAS v4u*)(XN + (size_t)m * 1024 + 512 + a0) = (v4u){cvtpk(yb[0], yb[1]), cvtpk(yb[2], yb[3]), cvtpk(yb[4], yb[5]), cvtpk(yb[6], yb[7])};
        }
    }
    GRID_BAR();
#ifdef TSTAMP
    if (blockIdx.x == 0 && threadIdx.x == 0) { KARGP(); ((unsigned long long*)(CTLP + 600))[5] = __builtin_amdgcn_s_memrealtime(); }
#endif
    {
        KARGP();
        pg8::Gemm g{XN, WoT, M, D, D}; pg8::StaticOrder S; S.init(M, D, F.G, (int)blockIdx.x);
        pg8::EpiResF32 E{in_x, X1, D};
        pg8::gemm_phase<pg8::EpiResF32, pg8::StaticOrder, true, true>(F.lds, g, S, E);
    }
    GRID_BAR();
#ifdef TSTAMP
    if (blockIdx.x == 0 && threadIdx.x == 0) { KARGP(); ((unsigned long long*)(CTLP + 600))[6] = __builtin_amdgcn_s_memrealtime(); }
#endif
    { PHASE_IDS(); for (int m = gw; m < M; m += NGW) { f32x4 v[4]; rms_row(X1 + (size_t)m * D, ffn_g, lane, v); store_row_bf16(XN + (size_t)m * D, lane, v); } }
    GRID_BAR();
#ifdef TSTAMP
    if (blockIdx.x == 0 && threadIdx.x == 0) { KARGP(); ((unsigned long long*)(CTLP + 600))[7] = __builtin_amdgcn_s_memrealtime(); }
#endif
    {
        KARGP();
        pg8::Gemm g{XN, WupT, M, NUP, D}; pg8::StaticOrder S; S.init(M, NUP, F.G, (int)blockIdx.x);
        pg8::EpiConvGLU E{Gb, fconv_w, fconv_b, HALO, (PG8_LAS float*)(F.lds + XH_OFF)};
        pg8::gemm_phase<pg8::EpiConvGLU, pg8::StaticOrder, true, true>(F.lds, g, S, E);
    }
    GRID_BAR();
#ifdef TSTAMP
    if (blockIdx.x == 0 && threadIdx.x == 0) { KARGP(); ((unsigned long long*)(CTLP + 600))[8] = __builtin_amdgcn_s_memrealtime(); }
#endif
    {
        PHASE_IDS();
        const int gt = blockIdx.x * (NWAVES * 64) + tid, NT = F.G * NWAVES * 64;
        for (int it = gt; it < 64 * DFF; it += NT) {
            const int pm = it / DFF, c = it % DFF; if ((pm & 31) == 0) continue;
            const int j = c >> 7, i = c & 127, cg_ = 256 * j + i, cv_ = cg_ + 128;
            const float* hp = HALO + (size_t)(pm - 1) * 4 * NUP; const float* hc = HALO + (size_t)pm * 4 * NUP;
            const float gm2 = hp[2 * NUP + cg_], gm1 = hp[3 * NUP + cg_], g0 = hc[cg_], g1 = hc[NUP + cg_];
            const float vm2 = hp[2 * NUP + cv_], vm1 = hp[3 * NUP + cv_], v0 = hc[cv_], v1 = hc[NUP + cv_];
            const float wg0 = fconv_w[c], wg1 = fconv_w[NUP + c], wg2 = fconv_w[2 * NUP + c], bg = fconv_b[c];
            const float wv0 = fconv_w[DFF + c], wv1 = fconv_w[NUP + DFF + c], wv2 = fconv_w[2 * NUP + DFF + c], bv = fconv_b[DFF + c];
            const float ug0 = wg0 * gm2 + wg1 * gm1 + wg2 * g0 + bg, ug1 = wg0 * gm1 + wg1 * g0 + wg2 * g1 + bg;
            const float uv0 = wv0 * vm2 + wv1 * vm1 + wv2 * v0 + bv, uv1 = wv0 * vm1 + wv1 * v0 + wv2 * v1 + bv;
            Gb[(size_t)(pm * 256) * DFF + c] = (bf16)f2bf(pg8::silu_f(ug0) * uv0);
            Gb[(size_t)(pm * 256 + 1) * DFF + c] = (bf16)f2bf(pg8::silu_f(ug1) * uv1);
        }
    }
    GRID_BAR();
#ifdef TSTAMP
    if (blockIdx.x == 0 && threadIdx.x == 0) { KARGP(); ((unsigned long long*)(CTLP + 600))[9] = __builtin_amdgcn_s_memrealtime(); }
#endif
    {
        KARGP();
        pg8::Gemm g{Gb, WdnT, M, D, DFF}; pg8::StaticOrder S; S.init(M, D, F.G, (int)blockIdx.x);
        pg8::EpiResF32 E{X1, OUT, D};
        pg8::gemm_phase<pg8::EpiResF32, pg8::StaticOrder, true, true>(F.lds, g, S, E);
    }
    GRID_BAR();
#ifdef TSTAMP
    if (blockIdx.x == 0 && threadIdx.x == 0) { KARGP(); ((unsigned long long*)(CTLP + 600))[10] = __builtin_amdgcn_s_memrealtime(); }
#endif
    { PHASE_IDS();
    for (int m = gw; m < M; m += NGW) {
        f32x4 v[4]; rms_row(OUT + (size_t)m * D, final_g, lane, v);
        GAS f32x4* o = (GAS f32x4*)(OUT + (size_t)m * D) + lane;
#pragma unroll
        for (int j = 0; j < 4; ++j) o[64 * j] = v[j];
    } }

#ifdef TSTAMP
    GRID_BAR();
    if (blockIdx.x == 0 && threadIdx.x == 0) { KARGP(); const unsigned long long* ts = (const unsigned long long*)(CTLP + 600); const unsigned long long tend = __builtin_amdgcn_s_memrealtime();
        const unsigned long long t1 = (TSTAMP + 1 > 10) ? tend : ts[TSTAMP + 1]; float us = (float)(t1 - ts[TSTAMP]) * 0.01f;
        float q = 1.f; while (us >= 100.f) { us *= 0.1f; q *= 10.f; } us = floorf(us + 0.5f) * q;
        OUT[0] = us; }
#endif
}

extern "C" void kernel_launch(void* const* d_in, const int* in_sizes, int n_in, void* d_out, int out_size, void* d_ws, size_t ws_size, hipStream_t stream) {
    static int grid = 0;
    if (grid == 0) {
        if (n_in != 19 || ws_size < WS_END) { fprintf(stderr, "kernel_launch: unexpected inputs (n_in %d, ws %zu)\n", n_in, ws_size); grid = -1; return; }
        int dev = 0, cus = 0, per_cu = 0;
        hipGetDevice(&dev); hipDeviceGetAttribute(&cus, hipDeviceAttributeMultiprocessorCount, dev);
        hipFuncSetAttribute((const void*)mega_fwd, hipFuncAttributeMaxDynamicSharedMemorySize, LDS_BYTES);
        hipOccupancyMaxActiveBlocksPerMultiprocessor(&per_cu, (const void*)mega_fwd, NWAVES * 64, LDS_BYTES);
        (void)hipGetLastError();
        if (per_cu < 1) per_cu = 1;
        grid = cus;
        if (grid > 256) grid = 256;
    }
    if (grid < 0) return;
    hipMemsetAsync((char*)d_ws + WS_CTL, 0, CTL_ZERO_BYTES, stream);
    Args a{};
    for (int i = 0; i < 19; ++i) a.in[i] = (const float*)d_in[i];
    a.out = (float*)d_out; a.ws = (unsigned char*)d_ws;
    void* kargs[] = {&a};
    hipError_t e = hipLaunchCooperativeKernel((const void*)mega_fwd, dim3(grid), dim3(NWAVES * 64), kargs, LDS_BYTES, stream);
    if (e != hipSuccess) fprintf(stderr, "cooperative launch failed: %s (grid %d)\n", hipGetErrorString(e), grid);
}
```

```cpp
#include <hip/hip_runtime.h>
#include <cstdio>
#include <cstdint>
namespace pg8 {
#define PG8_LAS __attribute__((address_space(3)))
typedef unsigned short bf16_t;
typedef short bf16x8 __attribute__((ext_vector_type(8)));
typedef float f32x4 __attribute__((ext_vector_type(4)));
typedef unsigned u32x4 __attribute__((ext_vector_type(4)));
constexpr int BM = 256, BK = 64, HALF = 128, HTB = HALF * BK * 2  , STAGE_BYTES = 8 * HTB, NXCD = 8, WGM = 8;

__host__ __device__ __forceinline__ int lds_byte(int r, int c) { const int st = (r >> 4) * 2 + (c >> 5), rr = r & 15, cc = c & 31, ob = rr * 64 + cc * 2; return st * 1024 + (ob ^ (((ob >> 9) & 1) << 5)); }
__host__ __device__ __forceinline__ void stage_rc(int b, int& R, int& C) { const int st = b / 1024, sb = b % 1024, swz = sb ^ (((sb >> 9) & 1) << 5); R = (st >> 1) * 16 + swz / 64; C = (st & 1) * 32 + (swz % 64) / 2; }
__host__ __device__ __forceinline__ int perm32(int rho) { const int n = rho >> 4, i = rho & 15; return 8 * (i >> 2) + 4 * n + (i & 3); }

struct Unit { int pm, pn; };
struct Gemm { const bf16_t* A; const bf16_t* Bt; int M, N, K; };

struct StaticOrder {
    int nM, nN, nwg, G, c;
    __host__ __device__ void init(int M, int N, int G_, int c_) { nM = M / BM; nN = N / BM; nwg = nM * nN; G = G_; c = c_; }
    __host__ __device__ bool next(int i, Unit& u) const {
        const long L = (long)i * G + c; if (L >= nwg) return false;
        int wgid = (int)L; { const int q = nwg / NXCD, r = nwg % NXCD, xcd = wgid % NXCD, off = wgid / NXCD; wgid = (xcd < r ? xcd * (q + 1) : r * (q + 1) + (xcd - r) * q) + off; }
        const int nig = WGM * nN, gid = wgid / nig, fm = gid * WGM, gsz = (nM - fm) < WGM ? (nM - fm) : WGM;
        u.pm = fm + ((wgid % nig) % gsz); u.pn = (wgid % nig) / gsz; return true;
    }
    __device__ __forceinline__ void a_ready(const Unit&) const {}
    __device__ __forceinline__ void done(const Unit&) const {}
};

__device__ __forceinline__ unsigned cvt_pk_bf16(float lo, float hi) { unsigned r; asm volatile("v_cvt_pk_bf16_f32 %0, %1, %2" : "=v"(r) : "v"(lo), "v"(hi)); return r; }
typedef float f32x2 __attribute__((ext_vector_type(2)));
__device__ __forceinline__ f32x2 gelu_pk(f32x2 v) {
    const f32x2 av = __builtin_elementwise_abs(v), d = av * 0.2316418882f + 1.0f;
    f32x2 t; t.x = __builtin_amdgcn_rcpf(d.x); t.y = __builtin_amdgcn_rcpf(d.y);
    f32x2 q = t * 0.5307027145f + (-0.7265760135f); q = q * t + 0.7107068705f; q = q * t + (-0.142248368f); q = q * t + 0.127414796f; q = q * t;
    const f32x2 s = (v * v) * (-0.72134752044f);
    f32x2 e; e.x = __builtin_amdgcn_exp2f(s.x); e.y = __builtin_amdgcn_exp2f(s.y);
    const f32x2 m = v * (q * e), r = v - m;
    f32x2 o; o.x = v.x < 0.f ? m.x : r.x; o.y = v.y < 0.f ? m.y : r.y; return o;
}

template <int ACT  > struct EpiBf16 {
    static constexpr bool PERM = true, AFTER_DRAIN = false; static_assert(ACT == 0 || ACT == 1, "EpiBf16: ACT is 0 (none) or 1 (gelu_pk)");
    bf16_t* O; int ldc; const float* bias; int split_cols; size_t split_stride; float scale0;
    __device__ __forceinline__ void operator()(const f32x4 (&acc)[2][2][4][2], const Unit& u, int wr, int wc, int fr, int fq) const {
        const int row0 = u.pm * BM + wr * 64 + fr; int colt = u.pn * BM; bf16_t* base = O;
        float sc = 1.f; if (split_cols) { const int t = colt / split_cols; base += (size_t)t * split_stride; colt -= t * split_cols; if (t == 0) sc = scale0; }
        const int col0 = colt + wc * 32 + 8 * fq, bcol0 = u.pn * BM + wc * 32 + 8 * fq;
        f32x4 bv[2][2];
#pragma unroll
        for (int bj = 0; bj < 2; ++bj)
#pragma unroll
            for (int n = 0; n < 2; ++n) bv[bj][n] = bias ? *(const f32x4*)(bias + bcol0 + bj * HALF + 4 * n) : (f32x4){0.f, 0.f, 0.f, 0.f};
#pragma unroll
        for (int ai = 0; ai < 2; ++ai)
#pragma unroll
            for (int m = 0; m < 4; ++m) { bf16_t* rowp = base + (size_t)(row0 + ai * HALF + m * 16) * ldc + col0;
#pragma unroll
                for (int bj = 0; bj < 2; ++bj) { f32x4 v0 = acc[ai][bj][m][0] + bv[bj][0], v1 = acc[ai][bj][m][1] + bv[bj][1];
                    if (ACT == 1) { f32x2 a = gelu_pk((f32x2){v0[0], v0[1]}), b = gelu_pk((f32x2){v0[2], v0[3]}), c = gelu_pk((f32x2){v1[0], v1[1]}), d = gelu_pk((f32x2){v1[2], v1[3]});
                        v0 = (f32x4){a.x, a.y, b.x, b.y}; v1 = (f32x4){c.x, c.y, d.x, d.y}; }
                    v0 = v0 * sc; v1 = v1 * sc; u32x4 w; w.x = cvt_pk_bf16(v0[0], v0[1]); w.y = cvt_pk_bf16(v0[2], v0[3]); w.z = cvt_pk_bf16(v1[0], v1[1]); w.w = cvt_pk_bf16(v1[2], v1[3]);
                    *(u32x4*)(rowp + bj * HALF) = w; } }
    }
};

struct EpiProj {
    static constexpr bool PERM = true, AFTER_DRAIN = false;
    bf16_t* PA; bf16_t* PG; float scale0;
    __device__ __forceinline__ void operator()(const f32x4 (&acc)[2][2][4][2], const Unit& u, int wr, int wc, int fr, int fq) const {
        const int row0 = u.pm * BM + wr * 64 + fr;
        bf16_t* base; int ldc, colt;
        if (u.pn < 8) { base = PA; ldc = 2048; colt = u.pn * BM; } else { base = PG; ldc = 1536; colt = (u.pn - 8) * BM; }
        const float sc = (u.pn < 2) ? scale0 : 1.f;
        const int col0 = colt + wc * 32 + 8 * fq;
#pragma unroll
        for (int ai = 0; ai < 2; ++ai)
#pragma unroll
            for (int m = 0; m < 4; ++m) { bf16_t* rowp = base + (size_t)(row0 + ai * HALF + m * 16) * ldc + col0;
#pragma unroll
                for (int bj = 0; bj < 2; ++bj) { f32x4 v0 = acc[ai][bj][m][0] * sc, v1 = acc[ai][bj][m][1] * sc;
                    u32x4 w; w.x = cvt_pk_bf16(v0[0], v0[1]); w.y = cvt_pk_bf16(v0[2], v0[3]); w.z = cvt_pk_bf16(v1[0], v1[1]); w.w = cvt_pk_bf16(v1[2], v1[3]);
                    *(u32x4*)(rowp + bj * HALF) = w; } }
    }
};
struct EpiResF32 {
    static constexpr bool PERM = false, AFTER_DRAIN = false;
    const float* base; float* out; int ldc;
    __device__ __forceinline__ void operator()(const f32x4 (&acc)[2][2][4][2], const Unit& u, int wr, int wc, int fr, int fq) const {
        const int col0 = u.pn * BM + wc * 32 + 4 * fq;
#pragma unroll
        for (int ai = 0; ai < 2; ++ai)
#pragma unroll
            for (int m = 0; m < 4; ++m) { const size_t off = (size_t)(u.pm * BM + ai * HALF + wr * 64 + m * 16 + fr) * ldc + col0;
#pragma unroll
                for (int bj = 0; bj < 2; ++bj)
#pragma unroll
                    for (int n = 0; n < 2; ++n) { const f32x4 bs = *(const f32x4*)(base + off + bj * HALF + n * 16); *(f32x4*)(out + off + bj * HALF + n * 16) = bs + acc[ai][bj][m][n]; } }
    }
};
__device__ __forceinline__ float dpp_ror1(float v) { return __builtin_bit_cast(float, __builtin_amdgcn_update_dpp(0, __builtin_bit_cast(int, v), 0x121, 0xf, 0xf, false)); }
__device__ __forceinline__ float dpp_ror2(float v) { return __builtin_bit_cast(float, __builtin_amdgcn_update_dpp(0, __builtin_bit_cast(int, v), 0x122, 0xf, 0xf, false)); }
__device__ __forceinline__ float silu_f(float x) { return x * __builtin_amdgcn_rcpf(1.0f + __expf(-x)); }
struct EpiConvGLU {
    static constexpr bool PERM = true, AFTER_DRAIN = false;
    bf16_t* G; const float* cw; const float* cb; float* halo; PG8_LAS float* xh;
    __device__ __forceinline__ void operator()(const f32x4 (&acc)[2][2][4][2], const Unit& u, int wr, int wc, int fr, int fq) const {
        const int csb = wc * 32 + 8 * fq;
        if (fr >= 14) {
#pragma unroll
            for (int ai = 0; ai < 2; ++ai)
#pragma unroll
                for (int bj = 0; bj < 2; ++bj)
#pragma unroll
                    for (int n = 0; n < 2; ++n) *(PG8_LAS f32x4*)(xh + (((2 * ai + wr) * 2 + (fr - 14)) * 256 + bj * 128 + csb + 4 * n)) = acc[ai][bj][3][n];
        }
        if (wr == 0 && fr < 2) {
#pragma unroll
            for (int bj = 0; bj < 2; ++bj)
#pragma unroll
                for (int n = 0; n < 2; ++n) *(f32x4*)(halo + ((size_t)(u.pm * 4 + fr) * 5632 + u.pn * 256 + bj * 128 + csb + 4 * n)) = acc[0][bj][0][n];
        }
        if (wr == 1 && fr >= 14) {
#pragma unroll
            for (int bj = 0; bj < 2; ++bj)
#pragma unroll
                for (int n = 0; n < 2; ++n) *(f32x4*)(halo + ((size_t)(u.pm * 4 + 2 + (fr - 14)) * 5632 + u.pn * 256 + bj * 128 + csb + 4 * n)) = acc[1][bj][3][n];
        }
        asm volatile("s_waitcnt lgkmcnt(0)" ::: "memory"); __builtin_amdgcn_s_barrier(); asm volatile("" ::: "memory");
        const bool seqstart = (u.pm & 31) == 0;
#pragma unroll
        for (int n = 0; n < 2; ++n) {
            const int chg = u.pn * 128 + csb + 4 * n, chv = 2816 + chg;
            const f32x4 g0 = *(const f32x4*)(cw + chg), g1 = *(const f32x4*)(cw + 5632 + chg), g2 = *(const f32x4*)(cw + 2 * 5632 + chg), gb = *(const f32x4*)(cb + chg);
            const f32x4 v0 = *(const f32x4*)(cw + chv), v1 = *(const f32x4*)(cw + 5632 + chv), v2 = *(const f32x4*)(cw + 2 * 5632 + chv), vb = *(const f32x4*)(cb + chv);
#pragma unroll
            for (int ai = 0; ai < 2; ++ai) {
                const int g = 2 * ai + wr;
                f32x4 hg = (f32x4){0.f, 0.f, 0.f, 0.f}, hv = hg;
                if (g > 0) { hg = *(const PG8_LAS f32x4*)(xh + (((g - 1) * 2 + (fr & 1)) * 256 + csb + 4 * n)); hv = *(const PG8_LAS f32x4*)(xh + (((g - 1) * 2 + (fr & 1)) * 256 + 128 + csb + 4 * n)); }
#pragma unroll
                for (int m = 0; m < 4; ++m) {
                    const f32x4 pg = (m == 0) ? hg : acc[ai][0][m == 0 ? 0 : m - 1][n], pv = (m == 0) ? hv : acc[ai][1][m == 0 ? 0 : m - 1][n];
                    const f32x4 cg = acc[ai][0][m][n], cv = acc[ai][1][m][n];
                    float og[4];
#pragma unroll
                    for (int e = 0; e < 4; ++e) {
                        const float g_p1 = dpp_ror1(fr == 15 ? pg[e] : cg[e]), g_p2 = dpp_ror2(fr >= 14 ? pg[e] : cg[e]);
                        const float v_p1 = dpp_ror1(fr == 15 ? pv[e] : cv[e]), v_p2 = dpp_ror2(fr >= 14 ? pv[e] : cv[e]);
                        const float ug = g2[e] * cg[e] + g1[e] * g_p1 + g0[e] * g_p2 + gb[e];
                        const float uv = v2[e] * cv[e] + v1[e] * v_p1 + v0[e] * v_p2 + vb[e];
                        og[e] = silu_f(ug) * uv;
                    }
                    typedef unsigned u32x2v __attribute__((ext_vector_type(2)));
                    u32x2v w; w.x = cvt_pk_bf16(og[0], og[1]); w.y = cvt_pk_bf16(og[2], og[3]);
                    const bool skip = (g == 0) && (m == 0) && (fr < 2) && !seqstart;
                    if (!skip) *(u32x2v*)(G + (size_t)(u.pm * BM + ai * HALF + wr * 64 + m * 16 + fr) * 2816 + chg) = w;
                }
            }
        }
    }
};
template <class Epi, class Sched, bool ALIGN_EPI = false, bool SP2 = false>
__device__ __forceinline__ void gemm_phase(PG8_LAS unsigned char* lds, const Gemm g, const Sched& S, const Epi& E) {
    int tid_l = threadIdx.x; asm volatile("" : "+v"(tid_l));
    const int tid = tid_l, wid = __builtin_amdgcn_readfirstlane(tid >> 6), lane = tid & 63, wr = wid >> 2, wc = wid & 3, fr = lane & 15, fq = lane >> 4;
    const int K = g.K, nt = K / BK;
    unsigned voffA[2], voffB[2];
#pragma unroll
    for (int i = 0; i < 2; ++i) { int R, C; stage_rc(tid * 16 + i * 8192, R, C); const int Rb = Epi::PERM ? ((R & ~31) + perm32(R & 31)) : R;
        voffA[i] = (unsigned)(R * K + C) * 2u; voffB[i] = (unsigned)(Rb * K + C) * 2u; }
    const size_t kstep = (size_t)(BK * 2);
    const size_t hstep = (size_t)HALF * K * 2;
    const size_t tstep = 2 * hstep;
    const unsigned ldsw = (unsigned)wid * 1024u;
    const int aoff = lds_byte(wr * 64 + fr, fq * 8), boff = lds_byte(wc * 32 + fr, fq * 8);
#define PG8_SA(b, h) (((b) * 2 + (h)) * HTB)
#define PG8_SB(b, h) ((4 + (b) * 2 + (h)) * HTB)
#define PG8_STAGE(bufoff, gbase, voff) do { _Pragma("unroll") for (int _i = 0; _i < 2; ++_i) \
        __builtin_amdgcn_global_load_lds((const unsigned*)((const char*)(gbase) + (voff)[_i]), (PG8_LAS unsigned*)(lds + (bufoff) + ldsw + _i * 8192), 16, 0, 0); } while (0)
#define PG8_LDA(dst, b, h) do { _Pragma("unroll") for (int m = 0; m < 4; ++m) _Pragma("unroll") for (int k = 0; k < 2; ++k) dst[m][k] = *(const PG8_LAS bf16x8*)(lds + PG8_SA(b, h) + aoff + m * 2048 + k * 1024); } while (0)
#define PG8_LDB(dst, b, h) do { _Pragma("unroll") for (int n = 0; n < 2; ++n) _Pragma("unroll") for (int k = 0; k < 2; ++k) dst[n][k] = *(const PG8_LAS bf16x8*)(lds + PG8_SB(b, h) + boff + n * 2048 + k * 1024); } while (0)
#define PG8_MMA(ai, bj, At, Bt) do { __builtin_amdgcn_s_setprio(1); _Pragma("unroll") for (int m = 0; m < 4; ++m) _Pragma("unroll") for (int n = 0; n < 2; ++n) _Pragma("unroll") for (int k = 0; k < 2; ++k) \
        acc[ai][bj][m][n] = __builtin_amdgcn_mfma_f32_16x16x32_bf16(Bt[n][k], At[m][k], acc[ai][bj][m][n], 0, 0, 0); __builtin_amdgcn_s_setprio(0); } while (0)
#define PG8_WAIT_V(n) asm volatile("s_waitcnt vmcnt(" #n ")" ::: "memory")
#define PG8_WAIT_L(n) asm volatile("s_waitcnt lgkmcnt(" #n ")" ::: "memory")
#define PG8_BAR __builtin_amdgcn_s_barrier()
#define PG8_SCHED __builtin_amdgcn_sched_barrier(0)
    Unit cur, nxt; int ui = 0;
    if (!S.next(0, cur)) return;
    f32x4 acc[2][2][4][2];
#pragma unroll
    for (int a = 0; a < 2; ++a)
#pragma unroll
        for (int b = 0; b < 2; ++b)
#pragma unroll
            for (int m = 0; m < 4; ++m)
#pragma unroll
                for (int n = 0; n < 2; ++n) acc[a][b][m][n] = (f32x4){0.f, 0.f, 0.f, 0.f};
    bf16x8 At[4][2], B0[2][2], B1[2][2];
    const char* cA = (const char*)g.A + (size_t)cur.pm * tstep; const char* cB = (const char*)g.Bt + (size_t)cur.pn * tstep;
    S.a_ready(cur);
    if constexpr (SP2) {
        PG8_STAGE(PG8_SB(0, 0), cB, voffB); PG8_STAGE(PG8_SB(0, 1), cB + hstep, voffB); PG8_STAGE(PG8_SA(0, 0), cA, voffA); PG8_STAGE(PG8_SA(0, 1), cA + hstep, voffA);
        if (wr == 1) PG8_BAR;
        PG8_WAIT_V(2); PG8_BAR;
        PG8_STAGE(PG8_SB(1, 0), cB + kstep, voffB); PG8_STAGE(PG8_SA(1, 0), cA + kstep, voffA); PG8_STAGE(PG8_SB(1, 1), cB + hstep + kstep, voffB);
        PG8_WAIT_V(6); PG8_BAR;
    } else {
        PG8_STAGE(PG8_SB(0, 0), cB, voffB); PG8_STAGE(PG8_SA(0, 0), cA, voffA); PG8_STAGE(PG8_SB(0, 1), cB + hstep, voffB); PG8_STAGE(PG8_SA(0, 1), cA + hstep, voffA);
        if (wr == 1) PG8_BAR;
        PG8_WAIT_V(4); PG8_BAR;
        PG8_STAGE(PG8_SB(1, 0), cB + kstep, voffB); PG8_STAGE(PG8_SA(1, 0), cA + kstep, voffA); PG8_STAGE(PG8_SB(1, 1), cB + hstep + kstep, voffB);
        PG8_WAIT_V(6); PG8_BAR;
    }
    for (;;) {
        const bool has_next = S.next(ui + 1, nxt);
        const char* nA = has_next ? (const char*)g.A + (size_t)nxt.pm * tstep : cA; const char* nB = has_next ? (const char*)g.Bt + (size_t)nxt.pn * tstep : cB;
        for (int t = 0; t < nt; t += 2) {
            const bool last = (t == nt - 2);
            const char* a1 = cA + (size_t)(t + 1) * kstep;
            const char* a2 = last ? nA : cA + (size_t)(t + 2) * kstep; const char* b2 = last ? nB : cB + (size_t)(t + 2) * kstep;
            const char* a3 = a2 + kstep; const char* b3 = b2 + kstep;
            if (last && has_next) S.a_ready(nxt);
            if constexpr (SP2) {
            PG8_LDB(B0, 0, 0); PG8_LDB(B1, 0, 1); PG8_SCHED; PG8_LDA(At, 0, 0); PG8_STAGE(PG8_SA(1, 1), a1 + hstep, voffA);
            PG8_WAIT_V(8); PG8_WAIT_L(0); PG8_BAR; PG8_MMA(0, 0, At, B0); PG8_MMA(0, 1, At, B1); PG8_BAR; PG8_SCHED;
            PG8_LDA(At, 0, 1); PG8_STAGE(PG8_SB(0, 0), b2, voffB); PG8_STAGE(PG8_SB(0, 1), b2 + hstep, voffB); PG8_STAGE(PG8_SA(0, 0), a2, voffA);
            PG8_WAIT_V(8); PG8_WAIT_L(0); PG8_BAR; PG8_MMA(1, 0, At, B0); PG8_MMA(1, 1, At, B1); PG8_BAR; PG8_SCHED;
            PG8_LDB(B0, 1, 0); PG8_LDB(B1, 1, 1); PG8_SCHED; PG8_LDA(At, 1, 0); PG8_STAGE(PG8_SA(0, 1), a2 + hstep, voffA);
            PG8_WAIT_V(8); PG8_WAIT_L(0); PG8_BAR; PG8_MMA(0, 0, At, B0); PG8_MMA(0, 1, At, B1); PG8_BAR; PG8_SCHED;
            PG8_LDA(At, 1, 1); PG8_STAGE(PG8_SB(1, 0), b3, voffB); PG8_STAGE(PG8_SB(1, 1), b3 + hstep, voffB); PG8_STAGE(PG8_SA(1, 0), a3, voffA);
            PG8_WAIT_V(8); PG8_WAIT_L(0); PG8_BAR; PG8_MMA(1, 0, At, B0); PG8_MMA(1, 1, At, B1); PG8_BAR; PG8_SCHED;
            } else {
            PG8_LDB(B0, 0, 0); PG8_SCHED; PG8_LDA(At, 0, 0); PG8_STAGE(PG8_SA(1, 1), a1 + hstep, voffA);
            PG8_WAIT_L(8); PG8_BAR; PG8_WAIT_L(0); PG8_MMA(0, 0, At, B0); PG8_BAR; PG8_SCHED;
            PG8_LDB(B1, 0, 1); PG8_STAGE(PG8_SB(0, 0), b2, voffB);
            PG8_BAR; PG8_WAIT_L(0); PG8_MMA(0, 1, At, B1); PG8_BAR;
            PG8_LDA(At, 0, 1); PG8_STAGE(PG8_SA(0, 0), a2, voffA);
            PG8_BAR; PG8_WAIT_L(0); PG8_MMA(1, 0, At, B0); PG8_BAR; PG8_SCHED;
            PG8_STAGE(PG8_SB(0, 1), b2 + hstep, voffB);
            PG8_WAIT_V(6); PG8_BAR; PG8_MMA(1, 1, At, B1); PG8_BAR;
            PG8_LDB(B0, 1, 0); PG8_SCHED; PG8_LDA(At, 1, 0); PG8_STAGE(PG8_SA(0, 1), a2 + hstep, voffA);
            PG8_WAIT_L(8); PG8_BAR; PG8_WAIT_L(0); PG8_MMA(0, 0, At, B0); PG8_BAR; PG8_SCHED;
            PG8_LDB(B1, 1, 1); PG8_STAGE(PG8_SB(1, 0), b3, voffB);
            PG8_BAR; PG8_WAIT_L(0); PG8_MMA(0, 1, At, B1); PG8_BAR;
            PG8_LDA(At, 1, 1); PG8_STAGE(PG8_SA(1, 0), a3, voffA);
            PG8_BAR; PG8_WAIT_L(0); PG8_MMA(1, 0, At, B0); PG8_BAR; PG8_SCHED;
            PG8_STAGE(PG8_SB(1, 1), b3 + hstep, voffB);
            PG8_WAIT_V(6); PG8_BAR; PG8_MMA(1, 1, At, B1); PG8_BAR;
            }
        }
        if constexpr (ALIGN_EPI) { if (wr == 0) PG8_BAR; }
        if constexpr (!Epi::AFTER_DRAIN) { E(acc, cur, wr, wc, fr, fq); S.done(cur); }
        if (!has_next) break;
#pragma unroll
        for (int a = 0; a < 2; ++a)
#pragma unroll
            for (int b = 0; b < 2; ++b)
#pragma unroll
                for (int m = 0; m < 4; ++m)
#pragma unroll
                    for (int n = 0; n < 2; ++n) acc[a][b][m][n] = (f32x4){0.f, 0.f, 0.f, 0.f};
        cur = nxt; cA = nA; cB = nB; ++ui;
        if constexpr (ALIGN_EPI) { if (wr == 1) PG8_BAR; }
    }
    PG8_WAIT_V(0);
    if constexpr (!ALIGN_EPI) { if (wr == 0) PG8_BAR; }
    PG8_BAR;
    if constexpr (Epi::AFTER_DRAIN) { E.fused(acc, cur, wr, wc, fr, fq, lds, wid, lane); S.done(cur); }
#undef PG8_SA
#undef PG8_SB
#undef PG8_STAGE
#undef PG8_LDA
#undef PG8_LDB
#undef PG8_MMA
#undef PG8_WAIT_V
#undef PG8_WAIT_L
#undef PG8_BAR
#undef PG8_SCHED
}
}

#ifndef PG8_SP2
#define PG8_SP2 true
#endif
#ifndef PG8_ALIGN
#define PG8_ALIGN true
#endif
#include <hip/hip_bf16.h>
#include <cmath>
namespace attn_body {
using bf16=__hip_bfloat16;
using bf16x8=__attribute__((ext_vector_type(8)))short;
using s16x4=__attribute__((ext_vector_type(4)))short;
using f32x16=__attribute__((ext_vector_type(16)))float;
using u32x4=__attribute__((ext_vector_type(4)))unsigned;
constexpr int BATCH=2,NHEAD=16,SEQ=8192,D=64,DM=2048,OPITCH=1024;
constexpr int NW=8,QBLK=32,QB=QBLK*NW,KVBLK=64,NQB=SEQ/QB;
constexpr int ATTN_PITCH=DM, ATTN_UNIT_ROWS=QB;
__device__ __forceinline__ int crow(int r,int hi){return (r&3)+8*(r>>2)+4*hi;}
#define SBAR() __builtin_amdgcn_sched_barrier(0)
__device__ __forceinline__ void cmask(f32x16&p0,f32x16&p1,int jb,int qrel,int hi){
  const float NEG=-INFINITY; int kb=64*jb+4*hi;
  #pragma unroll
  for(int r=0;r<16;++r){int kv=kb+(r&3)+8*(r>>2); if(kv>qrel)p0[r]=NEG; if(kv+32>qrel)p1[r]=NEG;}
}

constexpr int NSLOT=3, SLOTB=8192;
constexpr int LDS_K=0, LDS_V=NSLOT*SLOTB, LDS_WS=2*NSLOT*SLOTB, LDS_OST=LDS_WS+NW*64*4, LDS_BYTES=LDS_OST+NW*4096;
constexpr float C2=0.125f*1.4426950408889634f;
__device__ __forceinline__ void glds16(const void*gsrc,unsigned lds_dst){unsigned keep;
  asm volatile("s_mov_b32 %0, m0\n\ts_mov_b32 m0, %2\n\ts_nop 0\n\tglobal_load_lds_dwordx4 %1, off\n\ts_mov_b32 m0, %0":"=&s"(keep):"v"(gsrc),"s"(lds_dst):"memory");}
__device__ __forceinline__ float max3f(float a,float b,float c){float r;asm("v_max3_f32 %0, %1, %2, %3":"=v"(r):"v"(a),"v"(b),"v"(c));return r;}
__device__ __forceinline__ float max2f(float a,float b){float r;asm("v_max_f32_e32 %0, %1, %2":"=v"(r):"v"(a),"v"(b));return r;}
__device__ __forceinline__ float fadd_s(float a,float b){float r;asm("v_add_f32_e32 %0, %1, %2":"=v"(r):"v"(a),"v"(b));return r;}
__device__ __forceinline__ float fsub_s(float a,float b){float r;asm("v_sub_f32_e32 %0, %1, %2":"=v"(r):"v"(a),"v"(b));return r;}
typedef float f32x2_t __attribute__((ext_vector_type(2))); typedef __bf16 bf16x2_t __attribute__((ext_vector_type(2)));
__device__ __forceinline__ unsigned cvtpk_s(float lo,float hi){f32x2_t v={lo,hi};bf16x2_t b=__builtin_convertvector(v,bf16x2_t);return __builtin_bit_cast(unsigned,b);}
typedef unsigned u32x2_t __attribute__((ext_vector_type(2)));
__device__ __forceinline__ unsigned bfb(float x){return cvtpk_s(x,0.f)&0xffffu;}
__device__ __forceinline__ float bff(unsigned b){return __uint_as_float(b<<16);}
#define MFMA8(a,b,c) __builtin_amdgcn_mfma_f32_32x32x8bf16_1k((a),(b),(c),0,0,0)
#define WAIT_BAR(N) asm volatile("s_waitcnt vmcnt(" #N ") lgkmcnt(0)\n\ts_barrier":::"memory")

__device__ __forceinline__ void qkt(f32x16&p0,f32x16&p1,const char*Kslot,const bf16x8*qr,const s16x4 kx0,const s16x4 kx1,const s16x4 qx,int r32,int hi){
  const f32x16 Z=f32x16{}; p0=MFMA8(kx0,qx,Z); p1=MFMA8(kx1,qx,Z);
  const char*kb=Kslot+hi*1024+r32*16;
  #pragma unroll
  for(int d0=0;d0<4;++d0){
    const bf16x8 b0=*reinterpret_cast<const bf16x8*>(kb+d0*2048);
    const bf16x8 b1=*reinterpret_cast<const bf16x8*>(kb+d0*2048+512);
    {p0=__builtin_amdgcn_mfma_f32_32x32x16_bf16(b0,qr[d0],p0,0,0,0);p1=__builtin_amdgcn_mfma_f32_32x32x16_bf16(b1,qr[d0],p1,0,0,0);}}
}
typedef __attribute__((address_space(3))) const char* lds_cptr;
typedef short v4i16_t __attribute__((ext_vector_type(4)));
__device__ __forceinline__ void kload8(bf16x8*kf,lds_cptr kp){
  kf[0]=*(const __attribute__((address_space(3))) bf16x8*)(kp);      kf[1]=*(const __attribute__((address_space(3))) bf16x8*)(kp+512);
  kf[2]=*(const __attribute__((address_space(3))) bf16x8*)(kp+2048); kf[3]=*(const __attribute__((address_space(3))) bf16x8*)(kp+2560);
  kf[4]=*(const __attribute__((address_space(3))) bf16x8*)(kp+4096); kf[5]=*(const __attribute__((address_space(3))) bf16x8*)(kp+4608);
  kf[6]=*(const __attribute__((address_space(3))) bf16x8*)(kp+6144); kf[7]=*(const __attribute__((address_space(3))) bf16x8*)(kp+6656);
}
__device__ __forceinline__ void kload2(bf16x8*kf,lds_cptr kp,int j){ kf[2*j]=*(const __attribute__((address_space(3))) bf16x8*)(kp+j*2048); kf[2*j+1]=*(const __attribute__((address_space(3))) bf16x8*)(kp+j*2048+512); }
__device__ __forceinline__ s16x4 vtr(lds_cptr p){ return __builtin_bit_cast(s16x4,__builtin_amdgcn_ds_read_tr16_b64_v4i16((__attribute__((address_space(3))) v4i16_t*)p)); }
__device__ __forceinline__ float rowmax(const f32x16&p0,const f32x16&p1){
  float a=max3f(p0[0],p0[1],p1[0]),b=max3f(p0[2],p0[3],p1[1]);a=max3f(a,p1[2],p1[3]);
  #pragma unroll
  for(int r=4;r<16;r+=4){a=max3f(a,p0[r],p0[r+1]);b=max3f(b,p0[r+2],p0[r+3]);a=max3f(a,p1[r],p1[r+1]);b=max3f(b,p1[r+2],p1[r+3]);}
  const float m=max2f(a,b);
  auto rr=__builtin_amdgcn_permlane32_swap(__float_as_uint(m),__float_as_uint(m),false,false);
  return max2f(__uint_as_float(rr[0]),__uint_as_float(rr[1]));
}
__device__ __forceinline__ void pv(f32x16*o,int vb,bf16x8 pa0,bf16x8 pa1,bf16x8 pa2,bf16x8 pa3){
  #pragma unroll
  for(int d0=0;d0<2;++d0){s16x4 lo[4],hi[4];
    #pragma unroll
    for(int ks=0;ks<4;++ks){
      asm volatile("ds_read_b64_tr_b16 %0,%1 offset:%c2":"=&v"(lo[ks]):"v"(vb),"i"(d0*4096+ks*1024):"memory");
      asm volatile("ds_read_b64_tr_b16 %0,%1 offset:%c2":"=&v"(hi[ks]):"v"(vb),"i"(d0*4096+ks*1024+512):"memory");}
    asm volatile("s_waitcnt lgkmcnt(0)":::"memory");SBAR();
    #define PK(k) (bf16x8){lo[k][0],lo[k][1],lo[k][2],lo[k][3],hi[k][0],hi[k][1],hi[k][2],hi[k][3]}
    o[d0]=__builtin_amdgcn_mfma_f32_32x32x16_bf16(pa0,PK(0),o[d0],0,0,0);
    o[d0]=__builtin_amdgcn_mfma_f32_32x32x16_bf16(pa1,PK(1),o[d0],0,0,0);
    o[d0]=__builtin_amdgcn_mfma_f32_32x32x16_bf16(pa2,PK(2),o[d0],0,0,0);
    o[d0]=__builtin_amdgcn_mfma_f32_32x32x16_bf16(pa3,PK(3),o[d0],0,0,0);
    #undef PK
  }
}

#ifndef ATTN_STORE16
#define ATTN_STORE16(p,v) (*(u32x4*)(p)=(v))
#endif
template<int THRL> __device__ __forceinline__ void attn_unit(int b,int h,int cm,int vh,int qb,int tskip,const bf16*__restrict__ P,bf16*O,char*shm){
  const int tid=threadIdx.x,lane=tid&63,r32=lane&31,hi=lane>>5; const int wid=__builtin_amdgcn_readfirstlane(tid>>6);
  const long rowbase=(long)b*SEQ; const int q0=qb*QB;
  const bf16*Qw=P+(rowbase+q0+wid*QBLK)*DM+h*128+cm*64;
  const bf16*Kh=P+(rowbase+(long)tskip*KVBLK)*DM+512+h*128+cm*64,*Vh=P+(rowbase+(long)tskip*KVBLK)*DM+1024+h*128+vh*64;
  const unsigned lds0=(unsigned)(uintptr_t)shm;
  float*wsf=(float*)(shm+LDS_WS)+wid*64;
  const bf16*ksrc=Kh+(long)lane*DM+wid*8;
  const bf16*vsrc=Vh+(long)(16*(wid&3)+(lane>>2))*DM+(wid>>2)*32+(lane&3)*8;
  const unsigned kdst=lds0+LDS_K+wid*1024, vdst=lds0+LDS_V+wid*1024;
  #define DMA_K(t,slot) glds16(ksrc+(long)(t)*KVBLK*DM,(unsigned)__builtin_amdgcn_readfirstlane(kdst+(slot)))
  #define DMA_V(t,slot) glds16(vsrc+(long)(t)*KVBLK*DM,(unsigned)__builtin_amdgcn_readfirstlane(vdst+(slot)))
  const int vb0=(int)(lds0+LDS_V)+((lane>>4)&1)*32+(lane&3)*8+(4*hi+((lane&15)>>2))*64;
  const char*Kbase=shm+LDS_K; bf16x8 kf[8];
  const lds_cptr shm3=(lds_cptr)shm; const lds_cptr kp0=shm3+LDS_K+hi*1024+r32*16; const lds_cptr vp0=shm3+LDS_V+((lane>>4)&1)*32+(lane&3)*8+(4*hi+((lane&15)>>2))*64;
  const int NT=(q0+QB)/KVBLK-tskip;
  DMA_K(0,0);DMA_V(0,0);DMA_K(1,SLOTB);
  bf16x8 qr[4];
  #pragma unroll
  for(int d0=0;d0<4;++d0)qr[d0]=*reinterpret_cast<const bf16x8*>(&Qw[(long)r32*DM+d0*16+hi*8]);
  float mhat=0.f,l_reg=0.f;f32x16 o[2];o[0]=f32x16{};o[1]=f32x16{};
  s16x4 qx,kx0,kx1; unsigned jp0,jp1;
  { const float sl2=exp2f(-2.0f*(float)(h+1))*1.4426950408889634f; const unsigned s0=bfb(sl2); const float r1=sl2-bff(s0); const unsigned s1=bfb(r1); const float r2=r1-bff(s1); const unsigned s2=bfb(r2);
    const unsigned a0=s0|(s1<<16), a1=s2|(bfb(64.f*bff(s0))<<16), b0=bfb(64.f*bff(s1))|(bfb(64.f*bff(s2))<<16);
    u32x2_t qq; qq.x=hi?b0:a0; qq.y=hi?0u:a1; qx=__builtin_bit_cast(s16x4,qq);
    jp0=bfb((float)r32); jp1=bfb((float)(r32+32)); }
  #define KXSET(t) do{ const unsigned tb_=__float_as_uint((float)(t))>>16; u32x2_t k0_,k1_; \
    k0_.x=hi?(tb_|(tb_<<16)):(jp0|(jp0<<16)); k0_.y=hi?0x3f803f80u:(jp0|(tb_<<16)); k1_.x=hi?(tb_|(tb_<<16)):(jp1|(jp1<<16)); k1_.y=hi?0x3f803f80u:(jp1|(tb_<<16)); \
    kx0=__builtin_bit_cast(s16x4,k0_); kx1=__builtin_bit_cast(s16x4,k1_); }while(0)
  #define SETRHO(newr,eff) do{ const float nx_=-(newr); const unsigned nh_=bfb(nx_); const float nl_f=nx_-bff(nh_); const unsigned nl_=bfb(nl_f); eff=-(bff(nh_)+bff(nl_)); \
    if(hi){ u32x2_t q_=__builtin_bit_cast(u32x2_t,qx); q_.y=nh_|(nl_<<16); qx=__builtin_bit_cast(s16x4,q_); } }while(0)
  const int qrel=wid*QBLK+r32;
  #define CMASK(P0,P1,t) do{int jb_=(t)-(NT-4); if(jb_>=0)cmask(P0,P1,jb_,qrel,hi);}while(0)
  bool resc=false;
  #define START(P0,P1) do{ const float rm=rowmax(P0,P1); resc=false; \
    { float dl; SETRHO(rm,dl); mhat=dl; \
      _Pragma("unroll") for(int r=0;r<16;++r){P0[r]=fsub_s(P0[r],dl);P1[r]=fsub_s(P1[r],dl);} } \
    _Pragma("unroll") for(int r=0;r<16;++r)P0[r]=__builtin_amdgcn_exp2f(P0[r]); }while(0)
  #define RESC() do{ if(resc){ asm volatile("s_waitcnt lgkmcnt(0)":::"memory"); \
      _Pragma("unroll") for(int d_=0;d_<2;++d_) _Pragma("unroll") for(int r=0;r<16;++r)o[d_][r]*=wsf[crow(r,hi)]; } }while(0)
  f32x16 pA0,pA1,pB0,pB1;
  int sl_prev=0,sl_cur=0,sl_next=SLOTB;
  #define ROT() do{sl_prev=sl_cur;sl_cur=sl_next;sl_next=(sl_next==(NSLOT-1)*SLOTB)?0:sl_next+SLOTB;}while(0)
  DMA_K(2,2*SLOTB);
  WAIT_BAR(3);
  KXSET(0); qkt(pA0,pA1,Kbase,qr,kx0,kx1,qx,r32,hi);asm volatile("s_nop 15\n\ts_nop 7":"+v"(pA0),"+v"(pA1));CMASK(pA0,pA1,0);
  START(pA0,pA1);
  _Pragma("unroll") for(int r=0;r<16;++r)pA1[r]=__builtin_amdgcn_exp2f(pA1[r]);
  WAIT_BAR(0);
  DMA_K(3,0);DMA_V(1,SLOTB);
  ROT();
  kload8(kf,kp0+sl_cur);
  WAIT_BAR(2);
  s16x4 vlo[8],vhi[8]; u32x4 pw0,pw1,pw2,pw3;
  #define PKW(P,B) cvtpk_s(P[B],P[B+1])
  #define PAF(k) __builtin_bit_cast(bf16x8,pw##k)
  #define VFR(i) (bf16x8){vlo[i][0],vlo[i][1],vlo[i][2],vlo[i][3],vhi[i][0],vhi[i][1],vhi[i][2],vhi[i][3]}
  #define PIN(x) asm volatile("":"+v"(x))
  #define MX3(a,b,c) __builtin_fmaxf(__builtin_fmaxf((a),(b)),(c))
  #define GAPA(MF,A0,A1,A2,A3,W0,W1,PW) do{ MF; sacc+=A0; sacc+=A1; sacc+=A2; sacc+=A3; PIN(sacc); W0; W1; PIN(PW); SBAR(); }while(0)
  #define EX(v) __builtin_amdgcn_exp2f(v)
  #define GAPB(MF,X,B) do{ MF; X[B]=EX(X[B]); X[B+1]=EX(X[B+1]); X[B+2]=EX(X[B+2]); X[B+3]=EX(X[B+3]); PIN(X); SBAR(); }while(0)
  #define VRD(i) do{ vlo[i]=vtr(vp_+(((i)>>2)*4096+((i)&3)*1024)); vhi[i]=vtr(vp_+(((i)>>2)*4096+((i)&3)*1024+512)); }while(0)
  #define KRD(G,j) do{ if(G){ kload2(kf,kp0+sl_next,j); SBAR(); } }while(0)
  #define STEP(C0,C1,P0,P1,t,GK,GV,GL) do{ SBAR(); \
    const lds_cptr vp_=vp0+sl_prev; \
    KXSET(t); { const f32x16 Z_=f32x16{}; C0=MFMA8(kx0,qx,Z_); C1=MFMA8(kx1,qx,Z_); } SBAR(); \
    VRD(0); SBAR(); float sacc=(P0[0]+P0[1]); \
    GAPA(C0=__builtin_amdgcn_mfma_f32_32x32x16_bf16(kf[0],qr[0],C0,0,0,0), P0[2],P0[3],P0[4],P0[5],     pw0[0]=PKW(P0,0), pw0[1]=PKW(P0,2), pw0); \
    VRD(4); SBAR(); GAPA(C1=__builtin_amdgcn_mfma_f32_32x32x16_bf16(kf[1],qr[0],C1,0,0,0), P0[6],P0[7],P0[8],P0[9],     pw0[2]=PKW(P0,4), pw0[3]=PKW(P0,6), pw0); \
    VRD(1); SBAR(); GAPA(C0=__builtin_amdgcn_mfma_f32_32x32x16_bf16(kf[2],qr[1],C0,0,0,0),   P0[10],P0[11],P0[12],P0[13], pw1[0]=PKW(P0,8), pw1[1]=PKW(P0,10), pw1); \
    VRD(5); SBAR(); GAPA(C1=__builtin_amdgcn_mfma_f32_32x32x16_bf16(kf[3],qr[1],C1,0,0,0),   P0[14],P0[15],P1[0],P1[1],   pw1[2]=PKW(P0,12),pw1[3]=PKW(P0,14), pw1); \
    VRD(2); SBAR(); GAPA(C0=__builtin_amdgcn_mfma_f32_32x32x16_bf16(kf[4],qr[2],C0,0,0,0),   P1[2],P1[3],P1[4],P1[5],     pw2[0]=PKW(P1,0), pw2[1]=PKW(P1,2), pw2); \
    VRD(6); SBAR(); GAPA(C1=__builtin_amdgcn_mfma_f32_32x32x16_bf16(kf[5],qr[2],C1,0,0,0),   P1[6],P1[7],P1[8],P1[9],     pw2[2]=PKW(P1,4), pw2[3]=PKW(P1,6), pw2); \
    VRD(3); SBAR(); GAPA(C0=__builtin_amdgcn_mfma_f32_32x32x16_bf16(kf[6],qr[3],C0,0,0,0),   P1[10],P1[11],P1[12],P1[13], pw3[0]=PKW(P1,8), pw3[1]=PKW(P1,10), pw3); \
    VRD(7); SBAR(); GAPA(C1=__builtin_amdgcn_mfma_f32_32x32x16_bf16(kf[7],qr[3],C1,0,0,0),   P1[14],P1[15],0.f,0.f,       pw3[2]=PKW(P1,12),pw3[3]=PKW(P1,14), pw3); \
    l_reg+=sacc; \
    if(GK){DMA_K((t)+3,sl_cur);} if(GV){DMA_V((t)+1,sl_next);} \
    CMASK(C0,C1,t); \
    { float a=MX3(C0[0],C0[1],C1[0]),b=MX3(C0[2],C0[3],C1[1]); a=MX3(a,C1[2],C1[3]); \
      _Pragma("unroll") for(int r=4;r<16;r+=4){a=MX3(a,C0[r],C0[r+1]);b=MX3(b,C0[r+2],C0[r+3]);a=MX3(a,C1[r],C1[r+1]);b=MX3(b,C1[r+2],C1[r+3]);} \
      float rm=__builtin_fmaxf(a,b); { auto rr=__builtin_amdgcn_permlane32_swap(__float_as_uint(rm),__float_as_uint(rm),false,false); rm=__builtin_fmaxf(__uint_as_float(rr[0]),__uint_as_float(rr[1])); } \
      resc=false; \
      if(__builtin_expect(__any(rm>(float)THRL),0)){ const float nr_=mhat+__builtin_fmaxf(rm,0.f); float ne_; SETRHO(nr_,ne_); const float dl=ne_-mhat; mhat=ne_; \
        _Pragma("unroll") for(int r=0;r<16;++r){C0[r]-=dl;C1[r]-=dl;} \
        const float f=__builtin_amdgcn_exp2f(-dl); l_reg*=f; if(hi==0)wsf[r32]=f; resc=true; } } \
    SBAR(); \
    GAPB(o[0]=__builtin_amdgcn_mfma_f32_32x32x16_bf16(PAF(0),VFR(0),o[0],0,0,0), C0,0); \
    GAPB(o[1]=__builtin_amdgcn_mfma_f32_32x32x16_bf16(PAF(0),VFR(4),o[1],0,0,0), C0,4); \
    KRD(GL,0); GAPB(o[0]=__builtin_amdgcn_mfma_f32_32x32x16_bf16(PAF(1),VFR(1),o[0],0,0,0), C0,8); \
    KRD(GL,1); GAPB(o[1]=__builtin_amdgcn_mfma_f32_32x32x16_bf16(PAF(1),VFR(5),o[1],0,0,0), C0,12); \
    KRD(GL,2); GAPB(o[0]=__builtin_amdgcn_mfma_f32_32x32x16_bf16(PAF(2),VFR(2),o[0],0,0,0), C1,0); \
    KRD(GL,3); GAPB(o[1]=__builtin_amdgcn_mfma_f32_32x32x16_bf16(PAF(2),VFR(6),o[1],0,0,0), C1,4); \
    GAPB(o[0]=__builtin_amdgcn_mfma_f32_32x32x16_bf16(PAF(3),VFR(3),o[0],0,0,0), C1,8); \
    GAPB(o[1]=__builtin_amdgcn_mfma_f32_32x32x16_bf16(PAF(3),VFR(7),o[1],0,0,0), C1,12); \
    }while(0)
  int t=1;
  #undef CMASK
  #define CMASK(P0,P1,t) do{}while(0)
  for(;t+5<NT;t+=2){
    STEP(pB0,pB1,pA0,pA1,t,true,true,true);     WAIT_BAR(2); RESC(); ROT();
    STEP(pA0,pA1,pB0,pB1,t+1,true,true,true);   WAIT_BAR(2); RESC(); ROT();
  }
  #undef CMASK
  #define CMASK(P0,P1,t) do{int jb_=(t)-(NT-4); if(jb_>=0)cmask(P0,P1,jb_,qrel,hi);}while(0)
  #define ENDW(tt) do{ if((tt)+3<NT){WAIT_BAR(2);} else if((tt)+2<NT){WAIT_BAR(1);} else {WAIT_BAR(0);} }while(0)
  for(;t+1<NT;t+=2){
    STEP(pB0,pB1,pA0,pA1,t,(t+3<NT),(t+1<NT),(t+1<NT));       ENDW(t);   RESC(); ROT();
    STEP(pA0,pA1,pB0,pB1,t+1,(t+4<NT),(t+2<NT),(t+2<NT));     ENDW(t+1); RESC(); ROT();
  }
  STEP(pB0,pB1,pA0,pA1,NT-1,false,false,false); RESC();
  { float sacc=pB0[0]+pB0[1]; _Pragma("unroll") for(int r=2;r<16;++r)sacc+=pB0[r]; _Pragma("unroll") for(int r=0;r<16;++r)sacc+=pB1[r]; l_reg+=sacc;
    pw0=(u32x4){PKW(pB0,0),PKW(pB0,2),PKW(pB0,4),PKW(pB0,6)};pw1=(u32x4){PKW(pB0,8),PKW(pB0,10),PKW(pB0,12),PKW(pB0,14)};pw2=(u32x4){PKW(pB1,0),PKW(pB1,2),PKW(pB1,4),PKW(pB1,6)};pw3=(u32x4){PKW(pB1,8),PKW(pB1,10),PKW(pB1,12),PKW(pB1,14)};
    SBAR(); pv(o,vb0+sl_cur,PAF(0),PAF(1),PAF(2),PAF(3)); }
  #undef PKW
  #undef PAF
  #undef VFR
  #undef PIN
  #undef MX3
  #undef GAPA
  #undef GAPB
  #undef EX
  #undef VRD
  #undef KRD
  #undef STEP
  #undef ENDW
  {auto rr=__builtin_amdgcn_permlane32_swap(__float_as_uint(l_reg),__float_as_uint(l_reg),false,false);l_reg=__uint_as_float(rr[0])+__uint_as_float(rr[1]);}
  if(hi==0)wsf[32+r32]=l_reg;asm volatile("s_waitcnt lgkmcnt(0)":::"memory");
  float rli[16];
  #pragma unroll
  for(int r=0;r<16;++r)rli[r]=__builtin_amdgcn_rcpf(wsf[32+crow(r,hi)]);
  bf16*Ow=O+(rowbase+q0+wid*QBLK)*OPITCH+cm*512+h*128+vh*64;
  { bf16*stg=(bf16*)(shm+LDS_OST)+wid*2048;
    #pragma unroll
    for(int r=0;r<16;++r){const int orow=crow(r,hi);
      #pragma unroll
      for(int d0=0;d0<2;++d0)stg[orow*64+d0*32+r32]=__float2bfloat16(o[d0][r]*rli[r]);}
    asm volatile("s_waitcnt lgkmcnt(0)":::"memory");
    #pragma unroll
    for(int i=0;i<4;++i){const int row=i*8+(lane>>3),ch=lane&7; const u32x4 v=*(const u32x4*)(stg+row*64+ch*8); ATTN_STORE16(Ow+(long)row*OPITCH+ch*8,v);} }
  asm volatile("s_waitcnt lgkmcnt(0)\n\ts_barrier":::"memory");
  #undef DMA_K
  #undef DMA_V
  #undef KXSET
  #undef SETRHO
  #undef CMASK
  #undef START
  #undef RESC
  #undef ROT
}
constexpr int ATTN_LDS_BYTES=LDS_BYTES;
#undef SBAR
#undef WAIT_BAR
}
#define GAS __attribute__((address_space(1)))
#define LAS __attribute__((address_space(3)))
typedef unsigned short bf16;
typedef unsigned v4u __attribute__((ext_vector_type(4)));
typedef float f32x4 __attribute__((ext_vector_type(4)));
typedef short bf16x8 __attribute__((ext_vector_type(8)));
typedef GAS unsigned gu32;
typedef GAS unsigned long long gu64;
#define RLX_AGENT __ATOMIC_RELAXED, __HIP_MEMORY_SCOPE_AGENT
#define LDS_WAIT() asm volatile("s_waitcnt lgkmcnt(0)" ::: "memory")
#define VM_WAIT() asm volatile("s_waitcnt vmcnt(0)" ::: "memory")
__device__ __forceinline__ unsigned long long rt() { return __builtin_amdgcn_s_memrealtime(); }
__device__ __forceinline__ unsigned f2bf(float f) { unsigned u = __builtin_bit_cast(unsigned, f); return (u + 0x7fffu + ((u >> 16) & 1u)) >> 16; }
__device__ __forceinline__ unsigned pk2(float lo, float hi) { return f2bf(lo) | (f2bf(hi) << 16); }

#define XB_TMO      128
#define XB_XCNT(j)  (256  + 64 * (j))
#define XB_XSUB(j)  (1280 + 64 * (j))
#define XB_XGEN(j)  (2304 + 64 * (j))
#define XB_TOP      3328
#define XB_TOPGEN   3392
#define XCD_BAR_WORDS 3456
#define XB_SPIN_CAP (1u << 18)

__device__ __forceinline__ unsigned xb_ld(unsigned* p)              { return __hip_atomic_load(p, __ATOMIC_RELAXED, __HIP_MEMORY_SCOPE_AGENT); }
__device__ __forceinline__ unsigned xb_add(unsigned* p, unsigned v) { return __hip_atomic_fetch_add(p, v, __ATOMIC_RELAXED, __HIP_MEMORY_SCOPE_AGENT); }
__device__ __forceinline__ unsigned xb_xcc_id() { return (unsigned)__builtin_amdgcn_s_getreg((3 << 11) | 20) & 0xFu; }
#define XB_SPIN(cond, bar) do { unsigned _sp = 0; while (cond) { __builtin_amdgcn_s_sleep(1); \
    if ((++_sp & 255u) == 0u) { if (xb_ld(&(bar)[XB_TMO])) break; if (_sp > XB_SPIN_CAP) { atomicAdd(&(bar)[XB_TMO], 1u); break; } } } } while (0)

struct XcdBarrier {
    unsigned* bar; unsigned x;
    volatile LAS unsigned* st;
};

__device__ __forceinline__ XcdBarrier xcd_barrier_post(unsigned* bar, volatile LAS unsigned* st) {
    XcdBarrier b; b.bar = bar; b.x = xb_xcc_id(); b.st = st;
    if (threadIdx.x == 0) (void)xb_add(&bar[XB_XCNT(b.x)], 1u);
    return b;
}
__device__ __forceinline__ void xcd_barrier_complete(unsigned* bar, unsigned x, unsigned& nloc, unsigned& nx) {
    const unsigned G = gridDim.x * gridDim.y * gridDim.z;
    unsigned sum, cnt, mine, sp = 0u;
    for (;;) {
        sum = 0u; cnt = 0u; mine = 0u;
#pragma unroll
        for (unsigned j = 0; j < 16; ++j) { const unsigned c = xb_ld(&bar[XB_XCNT(j)]); sum += c; cnt += (c > 0u) ? 1u : 0u; mine = (j == x) ? c : mine; }
        if (sum == G) break;
        __builtin_amdgcn_s_sleep(1);
        if ((++sp & 255u) == 0u) { if (xb_ld(&bar[XB_TMO])) break; if (sp > XB_SPIN_CAP) { atomicAdd(&bar[XB_TMO], 1u); break; } }
    }
    nloc = mine > 0u ? mine : 1u; nx = cnt > 0u ? cnt : 1u;
}

__device__ __forceinline__ void xcd_barrier(const XcdBarrier& b) {
    asm volatile("s_waitcnt vmcnt(0)" ::: "memory");
    __syncthreads();
    if (threadIdx.x == 0) {
        unsigned* bar = b.bar;
        __builtin_amdgcn_s_waitcnt(0);
        unsigned nloc = b.st[0], nx = b.st[1];
        if (nloc == 0u) { xcd_barrier_complete(bar, b.x, nloc, nx); b.st[0] = nloc; b.st[1] = nx; }
        const unsigned old = xb_add(&bar[XB_XSUB(b.x)], 1u);
        const unsigned gen = old / nloc;
        if (old + 1u == (gen + 1u) * nloc) {
            __builtin_amdgcn_fence(__ATOMIC_RELEASE, "agent");
            asm volatile("s_waitcnt vmcnt(0)" ::: "memory");
            const unsigned og = xb_add(&bar[XB_TOP], 1u);
            const unsigned tg = og / nx;
            if (og + 1u == (tg + 1u) * nx) xb_add(&bar[XB_TOPGEN], 1u);
            else XB_SPIN(xb_ld(&bar[XB_TOPGEN]) == tg, bar);
            __builtin_amdgcn_fence(__ATOMIC_ACQUIRE, "agent");
            xb_add(&bar[XB_XGEN(b.x)], 1u);
            asm volatile("s_waitcnt vmcnt(0)" ::: "memory");
        } else {
            XB_SPIN(xb_ld(&bar[XB_XGEN(b.x)]) == gen, bar);
            __builtin_amdgcn_fence(__ATOMIC_ACQUIRE, "agent");
            asm volatile("s_waitcnt vmcnt(0)" ::: "memory");
        }
    }
    __syncthreads();
}

#include <hip/hip_cooperative_groups.h>
namespace cg = cooperative_groups;
constexpr int NWAVES = 8;
constexpr int SEQ = 8192, D = 1024, M = 16384, DFF = 2816, NUP = 5632, NINP = 3592, NPROJ = 3584;
constexpr float EPS = 1e-6f;
constexpr size_t MiB = 1u << 20;
constexpr size_t WS_CTL = 0, CTL_ZERO_BYTES = 1 * MiB;
constexpr size_t WS_WIN = 2 * MiB, WS_WO = 9 * MiB, WS_WUP = 11 * MiB, WS_WDN = 22 * MiB, WS_GAB = 28 * MiB, WS_HALO = 29 * MiB, WS_GL = 35 * MiB;
constexpr size_t WS_XN = 36 * MiB;
constexpr size_t WS_PREP = 36 * MiB;
constexpr size_t WS_G = 68 * MiB;
constexpr size_t WS_PA = 124 * MiB;
constexpr size_t WS_PG = 188 * MiB;
constexpr size_t WS_OATT = 188 * MiB;
constexpr size_t WS_OG = 220 * MiB;
constexpr size_t WS_X1 = 188 * MiB;
constexpr size_t WS_END = 252 * MiB;
constexpr int CW_NORM = 704;
constexpr int CW_QUEUE = 64;
constexpr int CW_BAR = 4096;
constexpr int PREP_STRIDE = 90112, PO_W = 0, PO_QD = 16384, PO_KDT = 32768, PO_QK = 49152, PO_U = 57344;
constexpr int RING_BYTES = 131072, XH_OFF = RING_BYTES, MISC_OFF = XH_OFF + 8192, LDS_BYTES = 147456;

struct Frame {
    LAS unsigned char* lds; volatile LAS unsigned* MISC;
    int vcu, G;
};
__device__ __forceinline__ float wave_sum(float v) {
#pragma unroll
    for (int o = 1; o < 64; o <<= 1) v += __shfl_xor(v, o);
    return v;
}
__device__ __forceinline__ float bf2f(unsigned short b) { return __uint_as_float(((unsigned)b) << 16); }
typedef float f32x2m_t __attribute__((ext_vector_type(2))); typedef __bf16 bf16x2m_t __attribute__((ext_vector_type(2)));
__device__ __forceinline__ unsigned cvtpk(float lo, float hi) { f32x2m_t v = {lo, hi}; bf16x2m_t b = __builtin_convertvector(v, bf16x2m_t); return __builtin_bit_cast(unsigned, b); }

__device__ __forceinline__ void p0_transpose_item(const float* W, int pitch, int col0, int k0, bf16* WT, int n0, int K, LAS float* scr, int lane) {
#pragma unroll 8
    for (int i = 0; i < 32; ++i) { const int kk = 2 * i + (lane >> 5); scr[kk * 33 + (lane & 31)] = W[(size_t)(k0 + kk) * pitch + col0 + (lane & 31)]; }
    LDS_WAIT(); asm volatile("" ::: "memory");
    const int c = lane & 7;
#pragma unroll
    for (int j = 0; j < 4; ++j) { const int n = (lane >> 3) + 8 * j; const LAS float* s = scr + (8 * c) * 33 + n;
        v4u o; o.x = pk2(s[0 * 33], s[1 * 33]); o.y = pk2(s[2 * 33], s[3 * 33]); o.z = pk2(s[4 * 33], s[5 * 33]); o.w = pk2(s[6 * 33], s[7 * 33]);
        *(GAS v4u*)(WT + (size_t)(n0 + n) * K + k0 + 8 * c) = o; }
    LDS_WAIT(); asm volatile("" ::: "memory");
}
__device__ __forceinline__ void rms_row(const float* xrow, const float* gain, int lane, f32x4 (&v)[4]) {
    const GAS f32x4* xr = (const GAS f32x4*)xrow + lane; const GAS f32x4* gr = (const GAS f32x4*)gain + lane;
    float s = 0.f;
#pragma unroll
    for (int j = 0; j < 4; ++j) { v[j] = xr[64 * j]; s += (v[j].x * v[j].x + v[j].y * v[j].y) + (v[j].z * v[j].z + v[j].w * v[j].w); }
    const float r = 1.0f / sqrtf(wave_sum(s) * (1.f / D) + EPS);
#pragma unroll
    for (int j = 0; j < 4; ++j) { const f32x4 g = gr[64 * j]; v[j] = v[j] * r * g; }
}
__device__ __forceinline__ void store_row_bf16(bf16* orow, int lane, const f32x4 (&v)[4]) {
    GAS unsigned long long* o8 = (GAS unsigned long long*)orow + lane;
#pragma unroll
    for (int j = 0; j < 4; ++j) o8[64 * j] = (unsigned long long)cvtpk(v[j].x, v[j].y) | ((unsigned long long)cvtpk(v[j].z, v[j].w) << 32);
}

namespace gdn {
typedef float f32x16 __attribute__((ext_vector_type(16)));
constexpr int KP = 136, L_KBF = 0, L_KBB = 17408, L_QBF = 34816, L_KDEC = 52224, L_R = 69632, RP = 132, L_LM = 103424, LP = 68, L_GC = 120832, L_BETA = 121088;
__device__ __forceinline__ int crow(int r, int hi) { return (r & 3) + 8 * (r >> 2) + 4 * hi; }
#define GDN_BAR() asm volatile("s_waitcnt lgkmcnt(0)\n\ts_barrier" ::: "memory")
__device__ __forceinline__ void prep_load(v4u (&raw)[8], int tid, int chunk, int tensor, const bf16* PG) {
    asm volatile("" : "+v"(tid));
    const int bh = chunk >> 7, n = chunk & 127, b = bh >> 2, h = bh & 3; const int row0 = b * SEQ + n * 64, sub = tid & 15, pl = tid >> 4;
#pragma unroll
    for (int ph = 0; ph < 2; ++ph)
#pragma unroll
        for (int j = 0; j < 4; ++j) { const int pr = ph * 32 + pl - 3 + j; v4u r = (v4u){0u, 0u, 0u, 0u};
            if (n > 0 || pr >= 0) r = *(const GAS v4u*)(PG + (size_t)(row0 + pr) * 1536 + tensor * 512 + h * 128 + sub * 8);
            raw[ph * 4 + j] = r; }
}
constexpr int L_CW = 121344;
__device__ __forceinline__ void prep_chunk(LAS unsigned char* lds, int tid, int chunk, int next, v4u (&raw)[8], const bf16* PG, const float* GAB, const float* convw, const float* a_log, const float* dt_bias,
                                           unsigned char* prep, float* GL) {
    asm volatile("" : "+v"(tid));
    const int lane = tid & 63, wid = __builtin_amdgcn_readfirstlane(tid >> 6);
    const int bh = chunk >> 7, n = chunk & 127, b = bh >> 2, h = bh & 3; const int row0 = b * SEQ + n * 64;
    LAS float* gcs = (LAS float*)(lds + L_GC); LAS float* betas = (LAS float*)(lds + L_BETA); LAS float* cwl = (LAS float*)(lds + L_CW);
    unsigned char* cb = prep + (size_t)chunk * PREP_STRIDE;
    if (tid >= 64 && tid < 448) { const int t = tid - 64;
#pragma unroll
        for (int j = 0; j < 4; ++j) cwl[j * 384 + t] = convw[j * 1536 + (t >> 7) * 512 + h * 128 + (t & 127)]; }
    if (wid == 0) {
        const float ga = GAB[(size_t)(row0 + lane) * 8 + h], gb = GAB[(size_t)(row0 + lane) * 8 + 4 + h];
        const float xs = ga + dt_bias[h]; const float sp = xs > 20.f ? xs : log1pf(__expf(xs));
        float g = -__expf(a_log[h]) * sp;
#pragma unroll
        for (int o = 1; o < 64; o <<= 1) { const float t = __shfl_up(g, o); if (lane >= o) g += t; }
        gcs[lane] = g; betas[lane] = 1.0f / (1.0f + __expf(-gb));
        if (lane == 63) GL[chunk] = __expf(g);
    }
    GDN_BAR();
    const float gc_last = gcs[63];
    {
        const int sub = tid & 15, pl = tid >> 4;
        v4u rawb[8];
#pragma unroll
        for (int tensor = 0; tensor < 3; ++tensor) {
            if (tensor == 0) prep_load(rawb, tid, chunk, 1, PG); else if (tensor == 1) prep_load(raw, tid, chunk, 2, PG);
            const int col = tensor * 512 + h * 128 + sub * 8;
            f32x4 wv[4][2]; (void)col;
#pragma unroll
            for (int j = 0; j < 4; ++j) { wv[j][0] = *(const LAS f32x4*)(cwl + j * 384 + tensor * 128 + sub * 8); wv[j][1] = *(const LAS f32x4*)(cwl + j * 384 + tensor * 128 + sub * 8 + 4); }
#pragma unroll
            for (int ph = 0; ph < 2; ++ph) {
                const int p = ph * 32 + pl;
                float y[8];
#pragma unroll
                for (int e = 0; e < 8; ++e) y[e] = 0.f;
#pragma unroll
                for (int j = 0; j < 4; ++j) {
                    const v4u rw = (tensor == 1) ? rawb[ph * 4 + j] : raw[ph * 4 + j];
#pragma unroll
                    for (int q = 0; q < 4; ++q) { y[2 * q] += wv[j][q >> 1][(2 * q) & 3] * __uint_as_float(rw[q] << 16); y[2 * q + 1] += wv[j][q >> 1][(2 * q + 1) & 3] * __uint_as_float(rw[q] & 0xffff0000u); }
                }
                float ss = 0.f;
#pragma unroll
                for (int e = 0; e < 8; ++e) { y[e] = pg8::silu_f(y[e]); ss += y[e] * y[e]; }
                const float gcp = gcs[p], bp = betas[p];
                if (tensor < 2) {
                    ss += __shfl_xor(ss, 1); ss += __shfl_xor(ss, 2); ss += __shfl_xor(ss, 4); ss += __shfl_xor(ss, 8);
                    float rn = 1.0f / sqrtf(ss + EPS); if (tensor == 0) rn *= 0.08838834764831845f;
#pragma unroll
                    for (int e = 0; e < 8; ++e) y[e] *= rn;
                    v4u o; o.x = cvtpk(y[0], y[1]); o.y = cvtpk(y[2], y[3]); o.z = cvtpk(y[4], y[5]); o.w = cvtpk(y[6], y[7]);
                    if (tensor == 0) {
                        *(LAS v4u*)(lds + L_QBF + (p * KP + sub * 8) * 2) = o;
                        const float eg = __expf(gcp); v4u d; d.x = cvtpk(y[0] * eg, y[1] * eg); d.y = cvtpk(y[2] * eg, y[3] * eg); d.z = cvtpk(y[4] * eg, y[5] * eg); d.w = cvtpk(y[6] * eg, y[7] * eg);
                        *(GAS v4u*)(cb + PO_QD + ((((p >> 5) * 8 + (sub >> 1)) * 64 + (sub & 1) * 32 + (p & 31)) * 16)) = d;
                    } else {
                        *(LAS v4u*)(lds + L_KBF + (p * KP + sub * 8) * 2) = o;
                        v4u kb; kb.x = cvtpk(y[0] * bp, y[1] * bp); kb.y = cvtpk(y[2] * bp, y[3] * bp); kb.z = cvtpk(y[4] * bp, y[5] * bp); kb.w = cvtpk(y[6] * bp, y[7] * bp);
                        *(LAS v4u*)(lds + L_KBB + (p * KP + sub * 8) * 2) = kb;
                        const float ed = __expf(gc_last - gcp); v4u kd; kd.x = cvtpk(y[0] * ed, y[1] * ed); kd.y = cvtpk(y[2] * ed, y[3] * ed); kd.z = cvtpk(y[4] * ed, y[5] * ed); kd.w = cvtpk(y[6] * ed, y[7] * ed);
                        *(LAS v4u*)(lds + L_KDEC + (p * KP + sub * 8) * 2) = kd;
                    }
                } else {
                    LAS float* R = (LAS float*)(lds + L_R) + p * RP + sub * 8;
                    *(LAS f32x4*)R = (f32x4){y[0] * bp, y[1] * bp, y[2] * bp, y[3] * bp}; *(LAS f32x4*)(R + 4) = (f32x4){y[4] * bp, y[5] * bp, y[6] * bp, y[7] * bp};
                }
            }
        }
    }
    GDN_BAR();
    {
        const int isqk = wid >> 2, tile = wid & 3, ti = tile >> 1, tj = tile & 1, r32 = lane & 31, hi = lane >> 5;
        bf16* qkg = (bf16*)(cb + PO_QK);
        if (!(ti == 0 && tj == 1)) {
            f32x16 acc = f32x16{};
            const LAS unsigned char* ap = lds + (isqk ? L_QBF : L_KBB) + ((32 * ti + r32) * KP + hi * 8) * 2;
            const LAS unsigned char* bp = lds + L_KBF + ((32 * tj + r32) * KP + hi * 8) * 2;
#pragma unroll
            for (int ks = 0; ks < 8; ++ks) acc = __builtin_amdgcn_mfma_f32_32x32x16_bf16(*(const LAS bf16x8*)(ap + ks * 32), *(const LAS bf16x8*)(bp + ks * 32), acc, 0, 0, 0);
            const int j = 32 * tj + r32; const float gcj = gcs[j];
#pragma unroll
            for (int r = 0; r < 16; ++r) {
                const int i = 32 * ti + crow(r, hi);
                const bool keep = isqk ? (j <= i) : (j < i);
                const float val = keep ? acc[r] * __expf(gcs[i] - gcj) : 0.f;
                if (isqk) qkg[(((i >> 5) * 4 + (j >> 4)) * 64 + ((j >> 3) & 1) * 32 + (i & 31)) * 8 + (j & 7)] = (bf16)f2bf(val); else ((LAS float*)(lds + L_LM))[i * LP + j] = val;
            }
        } else if (isqk) {
#pragma unroll
            for (int r = 0; r < 16; ++r) { const int i = crow(r, hi), j = 32 + r32; qkg[(((i >> 5) * 4 + (j >> 4)) * 64 + ((j >> 3) & 1) * 32 + (i & 31)) * 8 + (j & 7)] = 0; }
        }
    }
    GDN_BAR();
    if (wid < 4) {
        const int c = tid; float x[64];
        int z_; asm volatile("v_mov_b32 %0, 0" : "=v"(z_));
        const LAS float* Lm = (const LAS float*)(lds + L_LM) + z_; const LAS float* gcv = gcs + z_;
        if (c < 128) {
#pragma unroll
            for (int p = 0; p < 64; ++p) x[p] = ((const LAS float*)(lds + L_R))[p * RP + c];
        } else {
#pragma unroll
            for (int p = 0; p < 64; ++p) x[p] = bf2f(((const LAS bf16*)(lds + L_KBB))[p * KP + (c - 128)]) * __expf(gcv[p]);
        }
        f32x4 Lq[2][8]; float a4[4] = {0.f, 0.f, 0.f, 0.f};
#define SEG_LOAD(B, I, V0, V1) do { _Pragma("unroll") for (int jj = (V0); jj < (V1); ++jj) Lq[B][jj - (V0)] = *(const LAS f32x4*)(Lm + (I) * LP + 4 * jj); } while (0)
#define SEG_FMA(B, I, V0, V1) do { _Pragma("unroll") for (int jj = (V0); jj < (V1); ++jj) { _Pragma("unroll") for (int e = 0; e < 4; ++e) if (4 * jj + e < (I)) a4[e] -= Lq[B][jj - (V0)][e] * x[4 * jj + e]; } } while (0)
        SEG_LOAD(0, 1, 0, 1);
        SEG_LOAD(1, 2, 0, 1); __builtin_amdgcn_sched_barrier(0); a4[0] = x[1]; a4[1] = 0.f; a4[2] = 0.f; a4[3] = 0.f; SEG_FMA(0, 1, 0, 1); x[1] = (a4[0] + a4[1]) + (a4[2] + a4[3]); __builtin_amdgcn_sched_barrier(0);
        SEG_LOAD(0, 3, 0, 1); __builtin_amdgcn_sched_barrier(0); a4[0] = x[2]; a4[1] = 0.f; a4[2] = 0.f; a4[3] = 0.f; SEG_FMA(1, 2, 0, 1); x[2] = (a4[0] + a4[1]) + (a4[2] + a4[3]); __builtin_amdgcn_sched_barrier(0);
        SEG_LOAD(1, 4, 0, 1); __builtin_amdgcn_sched_barrier(0); a4[0] = x[3]; a4[1] = 0.f; a4[2] = 0.f; a4[3] = 0.f; SEG_FMA(0, 3, 0, 1); x[3] = (a4[0] + a4[1]) + (a4[2] + a4[3]); __builtin_amdgcn_sched_barrier(0);
        SEG_LOAD(0, 5, 0, 2); __builtin_amdgcn_sched_barrier(0); a4[0] = x[4]; a4[1] = 0.f; a4[2] = 0.f; a4[3] = 0.f; SEG_FMA(1, 4, 0, 1); x[4] = (a4[0] + a4[1]) + (a4[2] + a4[3]); __builtin_amdgcn_sched_barrier(0);
        SEG_LOAD(1, 6, 0, 2); __builtin_amdgcn_sched_barrier(0); a4[0] = x[5]; a4[1] = 0.f; a4[2] = 0.f; a4[3] = 0.f; SEG_FMA(0, 5, 0, 2); x[5] = (a4[0] + a4[1]) + (a4[2] + a4[3]); __builtin_amdgcn_sched_barrier(0);
        SEG_LOAD(0, 7, 0, 2); __builtin_amdgcn_sched_barrier(0); a4[0] = x[6]; a4[1] = 0.f; a4[2] = 0.f; a4[3] = 0.f; SEG_FMA(1, 6, 0, 2); x[6] = (a4[0] + a4[1]) + (a4[2] + a4[3]); __builtin_amdgcn_sched_barrier(0);
        SEG_LOAD(1, 8, 0, 2); __builtin_amdgcn_sched_barrier(0); a4[0] = x[7]; a4[1] = 0.f; a4[2] = 0.f; a4[3] = 0.f; SEG_FMA(0, 7, 0, 2); x[7] = (a4[0] + a4[1]) + (a4[2] + a4[3]); __builtin_amdgcn_sched_barrier(0);
        SEG_LOAD(0, 9, 0, 3); __builtin_amdgcn_sched_barrier(0); a4[0] = x[8]; a4[1] = 0.f; a4[2] = 0.f; a4[3] = 0.f; SEG_FMA(1, 8, 0, 2); x[8] = (a4[0] + a4[1]) + (a4[2] + a4[3]); __builtin_amdgcn_sched_barrier(0);
        SEG_LOAD(1, 10, 0, 3); __builtin_amdgcn_sched_barrier(0); a4[0] = x[9]; a4[1] = 0.f; a4[2] = 0.f; a4[3] = 0.f; SEG_FMA(0, 9, 0, 3); x[9] = (a4[0] + a4[1]) + (a4[2] + a4[3]); __builtin_amdgcn_sched_barrier(0);
        SEG_LOAD(0, 11, 0, 3); __builtin_amdgcn_sched_barrier(0); a4[0] = x[10]; a4[1] = 0.f; a4[2] = 0.f; a4[3] = 0.f; SEG_FMA(1, 10, 0, 3); x[10] = (a4[0] + a4[1]) + (a4[2] + a4[3]); __builtin_amdgcn_sched_barrier(0);
        SEG_LOAD(1, 12, 0, 3); __builtin_amdgcn_sched_barrier(0); a4[0] = x[11]; a4[1] = 0.f; a4[2] = 0.f; a4[3] = 0.f; SEG_FMA(0, 11, 0, 3); x[11] = (a4[0] + a4[1]) + (a4[2] + a4[3]); __builtin_amdgcn_sched_barrier(0);
        SEG_LOAD(0, 13, 0, 4); __builtin_amdgcn_sched_barrier(0); a4[0] = x[12]; a4[1] = 0.f; a4[2] = 0.f; a4[3] = 0.f; SEG_FMA(1, 12, 0, 3); x[12] = (a4[0] + a4[1]) + (a4[2] + a4[3]); __builtin_amdgcn_sched_barrier(0);
        SEG_LOAD(1, 14, 0, 4); __builtin_amdgcn_sched_barrier(0); a4[0] = x[13]; a4[1] = 0.f; a4[2] = 0.f; a4[3] = 0.f; SEG_FMA(0, 13, 0, 4); x[13] = (a4[0] + a4[1]) + (a4[2] + a4[3]); __builtin_amdgcn_sched_barrier(0);
        SEG_LOAD(0, 15, 0, 4); __builtin_amdgcn_sched_barrier(0); a4[0] = x[14]; a4[1] = 0.f; a4[2] = 0.f; a4[3] = 0.f; SEG_FMA(1, 14, 0, 4); x[14] = (a4[0] + a4[1]) + (a4[2] + a4[3]); __builtin_amdgcn_sched_barrier(0);
        SEG_LOAD(1, 16, 0, 4); __builtin_amdgcn_sched_barrier(0); a4[0] = x[15]; a4[1] = 0.f; a4[2] = 0.f; a4[3] = 0.f; SEG_FMA(0, 15, 0, 4); x[15] = (a4[0] + a4[1]) + (a4[2] + a4[3]); __builtin_amdgcn_sched_barrier(0);
        SEG_LOAD(0, 17, 0, 5); __builtin_amdgcn_sched_barrier(0); a4[0] = x[16]; a4[1] = 0.f; a4[2] = 0.f; a4[3] = 0.f; SEG_FMA(1, 16, 0, 4); x[16] = (a4[0] + a4[1]) + (a4[2] + a4[3]); __builtin_amdgcn_sched_barrier(0);
        SEG_LOAD(1, 18, 0, 5); __builtin_amdgcn_sched_barrier(0); a4[0] = x[17]; a4[1] = 0.f; a4[2] = 0.f; a4[3] = 0.f; SEG_FMA(0, 17, 0, 5); x[17] = (a4[0] + a4[1]) + (a4[2] + a4[3]); __builtin_amdgcn_sched_barrier(0);
        SEG_LOAD(0, 19, 0, 5); __builtin_amdgcn_sched_barrier(0); a4[0] = x[18]; a4[1] = 0.f; a4[2] = 0.f; a4[3] = 0.f; SEG_FMA(1, 18, 0, 5); x[18] = (a4[0] + a4[1]) + (a4[2] + a4[3]); __builtin_amdgcn_sched_barrier(0);
        SEG_LOAD(1, 20, 0, 5); __builtin_amdgcn_sched_barrier(0); a4[0] = x[19]; a4[1] = 0.f; a4[2] = 0.f; a4[3] = 0.f; SEG_FMA(0, 19, 0, 5); x[19] = (a4[0] + a4[1]) + (a4[2] + a4[3]); __builtin_amdgcn_sched_barrier(0);
        SEG_LOAD(0, 21, 0, 6); __builtin_amdgcn_sched_barrier(0); a4[0] = x[20]; a4[1] = 0.f; a4[2] = 0.f; a4[3] = 0.f; SEG_FMA(1, 20, 0, 5); x[20] = (a4[0] + a4[1]) + (a4[2] + a4[3]); __builtin_amdgcn_sched_barrier(0);
        SEG_LOAD(1, 22, 0, 6); __builtin_amdgcn_sched_barrier(0); a4[0] = x[21]; a4[1] = 0.f; a4[2] = 0.f; a4[3] = 0.f; SEG_FMA(0, 21, 0, 6); x[21] = (a4[0] + a4[1]) + (a4[2] + a4[3]); __builtin_amdgcn_sched_barrier(0);
        SEG_LOAD(0, 23, 0, 6); __builtin_amdgcn_sched_barrier(0); a4[0] = x[22]; a4[1] = 0.f; a4[2] = 0.f; a4[3] = 0.f; SEG_FMA(1, 22, 0, 6); x[22] = (a4[0] + a4[1]) + (a4[2] + a4[3]); __builtin_amdgcn_sched_barrier(0);
        SEG_LOAD(1, 24, 0, 6); __builtin_amdgcn_sched_barrier(0); a4[0] = x[23]; a4[1] = 0.f; a4[2] = 0.f; a4[3] = 0.f; SEG_FMA(0, 23, 0, 6); x[23] = (a4[0] + a4[1]) + (a4[2] + a4[3]); __builtin_amdgcn_sched_barrier(0);
        SEG_LOAD(0, 25, 0, 7); __builtin_amdgcn_sched_barrier(0); a4[0] = x[24]; a4[1] = 0.f; a4[2] = 0.f; a4[3] = 0.f; SEG_FMA(1, 24, 0, 6); x[24] = (a4[0] + a4[1]) + (a4[2] + a4[3]); __builtin_amdgcn_sched_barrier(0);
        SEG_LOAD(1, 26, 0, 7); __builtin_amdgcn_sched_barrier(0); a4[0] = x[25]; a4[1] = 0.f; a4[2] = 0.f; a4[3] = 0.f; SEG_FMA(0, 25, 0, 7); x[25] = (a4[0] + a4[1]) + (a4[2] + a4[3]); __builtin_amdgcn_sched_barrier(0);
        SEG_LOAD(0, 27, 0, 7); __builtin_amdgcn_sched_barrier(0); a4[0] = x[26]; a4[1] = 0.f; a4[2] = 0.f; a4[3] = 0.f; SEG_FMA(1, 26, 0, 7); x[26] = (a4[0] + a4[1]) + (a4[2] + a4[3]); __builtin_amdgcn_sched_barrier(0);
        SEG_LOAD(1, 28, 0, 7); __builtin_amdgcn_sched_barrier(0); a4[0] = x[27]; a4[1] = 0.f; a4[2] = 0.f; a4[3] = 0.f; SEG_FMA(0, 27, 0, 7); x[27] = (a4[0] + a4[1]) + (a4[2] + a4[3]); __builtin_amdgcn_sched_barrier(0);
        SEG_LOAD(0, 29, 0, 8); __builtin_amdgcn_sched_barrier(0); a4[0] = x[28]; a4[1] = 0.f; a4[2] = 0.f; a4[3] = 0.f; SEG_FMA(1, 28, 0, 7); x[28] = (a4[0] + a4[1]) + (a4[2] + a4[3]); __builtin_amdgcn_sched_barrier(0);
        SEG_LOAD(1, 30, 0, 8); __builtin_amdgcn_sched_barrier(0); a4[0] = x[29]; a4[1] = 0.f; a4[2] = 0.f; a4[3] = 0.f; SEG_FMA(0, 29, 0, 8); x[29] = (a4[0] + a4[1]) + (a4[2] + a4[3]); __builtin_amdgcn_sched_barrier(0);
        SEG_LOAD(0, 31, 0, 8); __builtin_amdgcn_sched_barrier(0); a4[0] = x[30]; a4[1] = 0.f; a4[2] = 0.f; a4[3] = 0.f; SEG_FMA(1, 30, 0, 8); x[30] = (a4[0] + a4[1]) + (a4[2] + a4[3]); __builtin_amdgcn_sched_barrier(0);
        SEG_LOAD(1, 32, 0, 8); __builtin_amdgcn_sched_barrier(0); a4[0] = x[31]; a4[1] = 0.f; a4[2] = 0.f; a4[3] = 0.f; SEG_FMA(0, 31, 0, 8); x[31] = (a4[0] + a4[1]) + (a4[2] + a4[3]); __builtin_amdgcn_sched_barrier(0);
        SEG_LOAD(0, 33, 0, 8); __builtin_amdgcn_sched_barrier(0); a4[0] = x[32]; a4[1] = 0.f; a4[2] = 0.f; a4[3] = 0.f; SEG_FMA(1, 32, 0, 8); x[32] = (a4[0] + a4[1]) + (a4[2] + a4[3]); __builtin_amdgcn_sched_barrier(0);
        SEG_LOAD(1, 33, 8, 9); __builtin_amdgcn_sched_barrier(0); a4[0] = x[33]; a4[1] = 0.f; a4[2] = 0.f; a4[3] = 0.f; SEG_FMA(0, 33, 0, 8); __builtin_amdgcn_sched_barrier(0);
        SEG_LOAD(0, 34, 0, 8); __builtin_amdgcn_sched_barrier(0); SEG_FMA(1, 33, 8, 9); x[33] = (a4[0] + a4[1]) + (a4[2] + a4[3]); __builtin_amdgcn_sched_barrier(0);
        SEG_LOAD(1, 34, 8, 9); __builtin_amdgcn_sched_barrier(0); a4[0] = x[34]; a4[1] = 0.f; a4[2] = 0.f; a4[3] = 0.f; SEG_FMA(0, 34, 0, 8); __builtin_amdgcn_sched_barrier(0);
        SEG_LOAD(0, 35, 0, 8); __builtin_amdgcn_sched_barrier(0); SEG_FMA(1, 34, 8, 9); x[34] = (a4[0] + a4[1]) + (a4[2] + a4[3]); __builtin_amdgcn_sched_barrier(0);
        SEG_LOAD(1, 35, 8, 9); __builtin_amdgcn_sched_barrier(0); a4[0] = x[35]; a4[1] = 0.f; a4[2] = 0.f; a4[3] = 0.f; SEG_FMA(0, 35, 0, 8); __builtin_amdgcn_sched_barrier(0);
        SEG_LOAD(0, 36, 0, 8); __builtin_amdgcn_sched_barrier(0); SEG_FMA(1, 35, 8, 9); x[35] = (a4[0] + a4[1]) + (a4[2] + a4[3]); __builtin_amdgcn_sched_barrier(0);
        SEG_LOAD(1, 36, 8, 9); __builtin_amdgcn_sched_barrier(0); a4[0] = x[36]; a4[1] = 0.f; a4[2] = 0.f; a4[3] = 0.f; SEG_FMA(0, 36, 0, 8); __builtin_amdgcn_sched_barrier(0);
        SEG_LOAD(0, 37, 0, 8); __builtin_amdgcn_sched_barrier(0); SEG_FMA(1, 36, 8, 9); x[36] = (a4[0] + a4[1]) + (a4[2] + a4[3]); __builtin_amdgcn_sched_barrier(0);
        SEG_LOAD(1, 37, 8, 10); __builtin_amdgcn_sched_barrier(0); a4[0] = x[37]; a4[1] = 0.f; a4[2] = 0.f; a4[3] = 0.f; SEG_FMA(0, 37, 0, 8); __builtin_amdgcn_sched_barrier(0);
        SEG_LOAD(0, 38, 0, 8); __builtin_amdgcn_sched_barrier(0); SEG_FMA(1, 37, 8, 10); x[37] = (a4[0] + a4[1]) + (a4[2] + a4[3]); __builtin_amdgcn_sched_barrier(0);
        SEG_LOAD(1, 38, 8, 10); __builtin_amdgcn_sched_barrier(0); a4[0] = x[38]; a4[1] = 0.f; a4[2] = 0.f; a4[3] = 0.f; SEG_FMA(0, 38, 0, 8); __builtin_amdgcn_sched_barrier(0);
        SEG_LOAD(0, 39, 0, 8); __builtin_amdgcn_sched_barrier(0); SEG_FMA(1, 38, 8, 10); x[38] = (a4[0] + a4[1]) + (a4[2] + a4[3]); __builtin_amdgcn_sched_barrier(0);
        SEG_LOAD(1, 39, 8, 10); __builtin_amdgcn_sched_barrier(0); a4[0] = x[39]; a4[1] = 0.f; a4[2] = 0.f; a4[3] = 0.f; SEG_FMA(0, 39, 0, 8); __builtin_amdgcn_sched_barrier(0);
        SEG_LOAD(0, 40, 0, 8); __builtin_amdgcn_sched_barrier(0); SEG_FMA(1, 39, 8, 10); x[39] = (a4[0] + a4[1]) + (a4[2] + a4[3]); __builtin_amdgcn_sched_barrier(0);
        SEG_LOAD(1, 40, 8, 10); __builtin_amdgcn_sched_barrier(0); a4[0] = x[40]; a4[1] = 0.f; a4[2] = 0.f; a4[3] = 0.f; SEG_FMA(0, 40, 0, 8); __builtin_amdgcn_sched_barrier(0);
        SEG_LOAD(0, 41, 0, 8); __builtin_amdgcn_sched_barrier(0); SEG_FMA(1, 40, 8, 10); x[40] = (a4[0] + a4[1]) + (a4[2] + a4[3]); __builtin_amdgcn_sched_barrier(0);
        SEG_LOAD(1, 41, 8, 11); __builtin_amdgcn_sched_barrier(0); a4[0] = x[41]; a4[1] = 0.f; a4[2] = 0.f; a4[3] = 0.f; SEG_FMA(0, 41, 0, 8); __builtin_amdgcn_sched_barrier(0);
        SEG_LOAD(0, 42, 0, 8); __builtin_amdgcn_sched_barrier(0); SEG_FMA(1, 41, 8, 11); x[41] = (a4[0] + a4[1]) + (a4[2] + a4[3]); __builtin_amdgcn_sched_barrier(0);
        SEG_LOAD(1, 42, 8, 11); __builtin_amdgcn_sched_barrier(0); a4[0] = x[42]; a4[1] = 0.f; a4[2] = 0.f; a4[3] = 0.f; SEG_FMA(0, 42, 0, 8); __builtin_amdgcn_sched_barrier(0);
        SEG_LOAD(0, 43, 0, 8); __builtin_amdgcn_sched_barrier(0); SEG_FMA(1, 42, 8, 11); x[42] = (a4[0] + a4[1]) + (a4[2] + a4[3]); __builtin_amdgcn_sched_barrier(0);
        SEG_LOAD(1, 43, 8, 11); __builtin_amdgcn_sched_barrier(0); a4[0] = x[43]; a4[1] = 0.f; a4[2] = 0.f; a4[3] = 0.f; SEG_FMA(0, 43, 0, 8); __builtin_amdgcn_sched_barrier(0);
        SEG_LOAD(0, 44, 0, 8); __builtin_amdgcn_sched_barrier(0); SEG_FMA(1, 43, 8, 11); x[43] = (a4[0] + a4[1]) + (a4[2] + a4[3]); __builtin_amdgcn_sched_barrier(0);
        SEG_LOAD(1, 44, 8, 11); __builtin_amdgcn_sched_barrier(0); a4[0] = x[44]; a4[1] = 0.f; a4[2] = 0.f; a4[3] = 0.f; SEG_FMA(0, 44, 0, 8); __builtin_amdgcn_sched_barrier(0);
        SEG_LOAD(0, 45, 0, 8); __builtin_amdgcn_sched_barrier(0); SEG_FMA(1, 44, 8, 11); x[44] = (a4[0] + a4[1]) + (a4[2] + a4[3]); __builtin_amdgcn_sched_barrier(0);
        SEG_LOAD(1, 45, 8, 12); __builtin_amdgcn_sched_barrier(0); a4[0] = x[45]; a4[1] = 0.f; a4[2] = 0.f; a4[3] = 0.f; SEG_FMA(0, 45, 0, 8); __builtin_amdgcn_sched_barrier(0);
        SEG_LOAD(0, 46, 0, 8); __builtin_amdgcn_sched_barrier(0); SEG_FMA(1, 45, 8, 12); x[45] = (a4[0] + a4[1]) + (a4[2] + a4[3]); __builtin_amdgcn_sched_barrier(0);
        SEG_LOAD(1, 46, 8, 12); __builtin_amdgcn_sched_barrier(0); a4[0] = x[46]; a4[1] = 0.f; a4[2] = 0.f; a4[3] = 0.f; SEG_FMA(0, 46, 0, 8); __builtin_amdgcn_sched_barrier(0);
        SEG_LOAD(0, 47, 0, 8); __builtin_amdgcn_sched_barrier(0); SEG_FMA(1, 46, 8, 12); x[46] = (a4[0] + a4[1]) + (a4[2] + a4[3]); __builtin_amdgcn_sched_barrier(0);
        SEG_LOAD(1, 47, 8, 12); __builtin_amdgcn_sched_barrier(0); a4[0] = x[47]; a4[1] = 0.f; a4[2] = 0.f; a4[3] = 0.f; SEG_FMA(0, 47, 0, 8); __builtin_amdgcn_sched_barrier(0);
        SEG_LOAD(0, 48, 0, 8); __builtin_amdgcn_sched_barrier(0); SEG_FMA(1, 47, 8, 12); x[47] = (a4[0] + a4[1]) + (a4[2] + a4[3]); __builtin_amdgcn_sched_barrier(0);
        SEG_LOAD(1, 48, 8, 12); __builtin_amdgcn_sched_barrier(0); a4[0] = x[48]; a4[1] = 0.f; a4[2] = 0.f; a4[3] = 0.f; SEG_FMA(0, 48, 0, 8); __builtin_amdgcn_sched_barrier(0);
        SEG_LOAD(0, 49, 0, 8); __builtin_amdgcn_sched_barrier(0); SEG_FMA(1, 48, 8, 12); x[48] = (a4[0] + a4[1]) + (a4[2] + a4[3]); __builtin_amdgcn_sched_barrier(0);
        SEG_LOAD(1, 49, 8, 13); __builtin_amdgcn_sched_barrier(0); a4[0] = x[49]; a4[1] = 0.f; a4[2] = 0.f; a4[3] = 0.f; SEG_FMA(0, 49, 0, 8); __builtin_amdgcn_sched_barrier(0);
        SEG_LOAD(0, 50, 0, 8); __builtin_amdgcn_sched_barrier(0); SEG_FMA(1, 49, 8, 13); x[49] = (a4[0] + a4[1]) + (a4[2] + a4[3]); __builtin_amdgcn_sched_barrier(0);
        SEG_LOAD(1, 50, 8, 13); __builtin_amdgcn_sched_barrier(0); a4[0] = x[50]; a4[1] = 0.f; a4[2] = 0.f; a4[3] = 0.f; SEG_FMA(0, 50, 0, 8); __builtin_amdgcn_sched_barrier(0);
        SEG_LOAD(0, 51, 0, 8); __builtin_amdgcn_sched_barrier(0); SEG_FMA(1, 50, 8, 13); x[50] = (a4[0] + a4[1]) + (a4[2] + a4[3]); __builtin_amdgcn_sched_barrier(0);
        SEG_LOAD(1, 51, 8, 13); __builtin_amdgcn_sched_barrier(0); a4[0] = x[51]; a4[1] = 0.f; a4[2] = 0.f; a4[3] = 0.f; SEG_FMA(0, 51, 0, 8); __builtin_amdgcn_sched_barrier(0);
        SEG_LOAD(0, 52, 0, 8); __builtin_amdgcn_sched_barrier(0); SEG_FMA(1, 51, 8, 13); x[51] = (a4[0] + a4[1]) + (a4[2] + a4[3]); __builtin_amdgcn_sched_barrier(0);
        SEG_LOAD(1, 52, 8, 13); __builtin_amdgcn_sched_barrier(0); a4[0] = x[52]; a4[1] = 0.f; a4[2] = 0.f; a4[3] = 0.f; SEG_FMA(0, 52, 0, 8); __builtin_amdgcn_sched_barrier(0);
        SEG_LOAD(0, 53, 0, 8); __builtin_amdgcn_sched_barrier(0); SEG_FMA(1, 52, 8, 13); x[52] = (a4[0] + a4[1]) + (a4[2] + a4[3]); __builtin_amdgcn_sched_barrier(0);
        SEG_LOAD(1, 53, 8, 14); __builtin_amdgcn_sched_barrier(0); a4[0] = x[53]; a4[1] = 0.f; a4[2] = 0.f; a4[3] = 0.f; SEG_FMA(0, 53, 0, 8); __builtin_amdgcn_sched_barrier(0);
        SEG_LOAD(0, 54, 0, 8); __builtin_amdgcn_sched_barrier(0); SEG_FMA(1, 53, 8, 14); x[53] = (a4[0] + a4[1]) + (a4[2] + a4[3]); __builtin_amdgcn_sched_barrier(0);
        SEG_LOAD(1, 54, 8, 14); __builtin_amdgcn_sched_barrier(0); a4[0] = x[54]; a4[1] = 0.f; a4[2] = 0.f; a4[3] = 0.f; SEG_FMA(0, 54, 0, 8); __builtin_amdgcn_sched_barrier(0);
        SEG_LOAD(0, 55, 0, 8); __builtin_amdgcn_sched_barrier(0); SEG_FMA(1, 54, 8, 14); x[54] = (a4[0] + a4[1]) + (a4[2] + a4[3]); __builtin_amdgcn_sched_barrier(0);
        SEG_LOAD(1, 55, 8, 14); __builtin_amdgcn_sched_barrier(0); a4[0] = x[55]; a4[1] = 0.f; a4[2] = 0.f; a4[3] = 0.f; SEG_FMA(0, 55, 0, 8); __builtin_amdgcn_sched_barrier(0);
        SEG_LOAD(0, 56, 0, 8); __builtin_amdgcn_sched_barrier(0); SEG_FMA(1, 55, 8, 14); x[55] = (a4[0] + a4[1]) + (a4[2] + a4[3]); __builtin_amdgcn_sched_barrier(0);
        SEG_LOAD(1, 56, 8, 14); __builtin_amdgcn_sched_barrier(0); a4[0] = x[56]; a4[1] = 0.f; a4[2] = 0.f; a4[3] = 0.f; SEG_FMA(0, 56, 0, 8); __builtin_amdgcn_sched_barrier(0);
        SEG_LOAD(0, 57, 0, 8); __builtin_amdgcn_sched_barrier(0); SEG_FMA(1, 56, 8, 14); x[56] = (a4[0] + a4[1]) + (a4[2] + a4[3]); __builtin_amdgcn_sched_barrier(0);
        SEG_LOAD(1, 57, 8, 15); __builtin_amdgcn_sched_barrier(0); a4[0] = x[57]; a4[1] = 0.f; a4[2] = 0.f; a4[3] = 0.f; SEG_FMA(0, 57, 0, 8); __builtin_amdgcn_sched_barrier(0);
        SEG_LOAD(0, 58, 0, 8); __builtin_amdgcn_sched_barrier(0); SEG_FMA(1, 57, 8, 15); x[57] = (a4[0] + a4[1]) + (a4[2] + a4[3]); __builtin_amdgcn_sched_barrier(0);
        SEG_LOAD(1, 58, 8, 15); __builtin_amdgcn_sched_barrier(0); a4[0] = x[58]; a4[1] = 0.f; a4[2] = 0.f; a4[3] = 0.f; SEG_FMA(0, 58, 0, 8); __builtin_amdgcn_sched_barrier(0);
        SEG_LOAD(0, 59, 0, 8); __builtin_amdgcn_sched_barrier(0); SEG_FMA(1, 58, 8, 15); x[58] = (a4[0] + a4[1]) + (a4[2] + a4[3]); __builtin_amdgcn_sched_barrier(0);
        SEG_LOAD(1, 59, 8, 15); __builtin_amdgcn_sched_barrier(0); a4[0] = x[59]; a4[1] = 0.f; a4[2] = 0.f; a4[3] = 0.f; SEG_FMA(0, 59, 0, 8); __builtin_amdgcn_sched_barrier(0);
        SEG_LOAD(0, 60, 0, 8); __builtin_amdgcn_sched_barrier(0); SEG_FMA(1, 59, 8, 15); x[59] = (a4[0] + a4[1]) + (a4[2] + a4[3]); __builtin_amdgcn_sched_barrier(0);
        SEG_LOAD(1, 60, 8, 15); __builtin_amdgcn_sched_barrier(0); a4[0] = x[60]; a4[1] = 0.f; a4[2] = 0.f; a4[3] = 0.f; SEG_FMA(0, 60, 0, 8); __builtin_amdgcn_sched_barrier(0);
        SEG_LOAD(0, 61, 0, 8); __builtin_amdgcn_sched_barrier(0); SEG_FMA(1, 60, 8, 15); x[60] = (a4[0] + a4[1]) + (a4[2] + a4[3]); __builtin_amdgcn_sched_barrier(0);
        SEG_LOAD(1, 61, 8, 16); __builtin_amdgcn_sched_barrier(0); a4[0] = x[61]; a4[1] = 0.f; a4[2] = 0.f; a4[3] = 0.f; SEG_FMA(0, 61, 0, 8); __builtin_amdgcn_sched_barrier(0);
        SEG_LOAD(0, 62, 0, 8); __builtin_amdgcn_sched_barrier(0); SEG_FMA(1, 61, 8, 16); x[61] = (a4[0] + a4[1]) + (a4[2] + a4[3]); __builtin_amdgcn_sched_barrier(0);
        SEG_LOAD(1, 62, 8, 16); __builtin_amdgcn_sched_barrier(0); a4[0] = x[62]; a4[1] = 0.f; a4[2] = 0.f; a4[3] = 0.f; SEG_FMA(0, 62, 0, 8); __builtin_amdgcn_sched_barrier(0);
        SEG_LOAD(0, 63, 0, 8); __builtin_amdgcn_sched_barrier(0); SEG_FMA(1, 62, 8, 16); x[62] = (a4[0] + a4[1]) + (a4[2] + a4[3]); __builtin_amdgcn_sched_barrier(0);
        SEG_LOAD(1, 63, 8, 16); __builtin_amdgcn_sched_barrier(0); a4[0] = x[63]; a4[1] = 0.f; a4[2] = 0.f; a4[3] = 0.f; SEG_FMA(0, 63, 0, 8); __builtin_amdgcn_sched_barrier(0);
        SEG_FMA(1, 63, 8, 16); x[63] = (a4[0] + a4[1]) + (a4[2] + a4[3]); __builtin_amdgcn_sched_barrier(0);
#undef SEG_LOAD
#undef SEG_FMA
        if (c < 128) {
            float* ug = (float*)(cb + PO_U);
#pragma unroll
            for (int g = 0; g < 16; ++g) *(f32x4*)(ug + (g * 128 + c) * 4) = (f32x4){x[4 * g], x[4 * g + 1], x[4 * g + 2], x[4 * g + 3]};
        } else {
            bf16* wg = (bf16*)(cb + PO_W);
#pragma unroll
            for (int p = 0; p < 64; ++p) { const int dk = c - 128; wg[((((p >> 5) * 8 + (dk >> 4)) * 64 + ((dk >> 3) & 1) * 32 + (p & 31)) * 8) + (dk & 7)] = (bf16)f2bf(x[p]); }
        }
    } else {
        const int t2 = tid - 256;
#pragma unroll
        for (int it = 0; it < 2; ++it) {
            const int item = t2 + 256 * it, dk = item & 127, pgp = item >> 7;
            const LAS bf16* src = (const LAS bf16*)(lds + L_KDEC) + (16 * pgp) * KP + dk;
            unsigned w[8];
#pragma unroll
            for (int q = 0; q < 8; ++q) w[q] = (unsigned)src[(2 * q) * KP] | ((unsigned)src[(2 * q + 1) * KP] << 16);
            GAS v4u* dst = (GAS v4u*)(cb + PO_KDT) + (((dk >> 5) * 4 + pgp) * 64 + (dk & 31));
            dst[0] = (v4u){w[0], w[1], w[2], w[3]}; dst[32] = (v4u){w[4], w[5], w[6], w[7]};
        }
    }
    if (next < 1024) prep_load(raw, tid, next, 0, PG);
    GDN_BAR();
}

__device__ __forceinline__ void scan(LAS unsigned char* lds, int tid, int bh, int s, const unsigned char* prep, const float* GL, bf16* OG) {
    const int lane = tid & 63, wid = __builtin_amdgcn_readfirstlane(tid >> 6), r32 = lane & 31, hi = lane >> 5;
    const int b = bh >> 2, h = bh & 3;
    constexpr int SP = 136, VP = 72, L_ST = 0, L_VN = 32 * SP * 2;
    for (int i = tid; i < (32 * SP * 2 + 32 * VP * 2) / 4; i += 512) ((LAS unsigned*)lds)[i] = 0u;
    f32x16 Sacc = f32x16{};
    const int role = wid < 2 ? 0 : (wid < 4 ? 1 : 2);
    const int rb = wid & 1, db = wid & 3;
    const unsigned char* base = prep + (size_t)(bh * 128) * PREP_STRIDE;
    const unsigned char* pB = base + (role == 0 ? PO_U + (((rb * 8 + hi) * 128 + 32 * s + r32) * 4) * 4 : (role == 1 ? PO_QK + ((rb * 4) * 64 + lane) * 16 : PO_KDT + ((db * 4) * 64 + lane) * 16));
    const int strideB = role == 0 ? 4096 : 1024;
    const unsigned char* pA = role == 2 ? pB : base + (role == 0 ? PO_W : PO_QD) + ((rb * 8) * 64 + lane) * 16;
    const int strideA = role == 2 ? 0 : 1024;
    v4u RA[3][8], RB[3][4]; float RG[3];
#pragma unroll
    for (int q = 0; q < 3; ++q) { RG[q] = 1.f;
#pragma unroll
        for (int k = 0; k < 8; ++k) RA[q][k] = (v4u){0u, 0u, 0u, 0u};
#pragma unroll
        for (int k = 0; k < 4; ++k) RB[q][k] = (v4u){0u, 0u, 0u, 0u}; }
#define SCAN_LOAD(S, ci) do { const int ci_ = (ci) < 128 ? (ci) : 127; const size_t off_ = (size_t)ci_ * PREP_STRIDE; \
        _Pragma("unroll") for (int ks = 0; ks < 8; ++ks) RA[S][ks] = *(const GAS v4u*)(pA + off_ + ks * strideA); \
        _Pragma("unroll") for (int ks = 0; ks < 4; ++ks) RB[S][ks] = *(const GAS v4u*)(pB + off_ + ks * strideB); \
        RG[S] = GL[bh * 128 + ci_]; } while (0)
    const LAS unsigned char* stp = lds + L_ST + (r32 * SP + 8 * hi) * 2;
    const LAS unsigned char* vnp = lds + L_VN + (r32 * VP + 8 * hi) * 2;
    typedef unsigned u32x2v __attribute__((ext_vector_type(2)));
#define SCAN_STEP(S, SL, ii) do { const int i_ = (ii); SCAN_LOAD(SL, i_ + 2); \
        f32x16 acc = f32x16{}; \
        if (role < 2) { f32x16 acc1 = f32x16{}; \
            _Pragma("unroll") for (int ks = 0; ks < 8; ks += 2) { \
                acc = __builtin_amdgcn_mfma_f32_32x32x16_bf16(__builtin_bit_cast(bf16x8, RA[S][ks]), *(const LAS bf16x8*)(stp + ks * 32), acc, 0, 0, 0); \
                acc1 = __builtin_amdgcn_mfma_f32_32x32x16_bf16(__builtin_bit_cast(bf16x8, RA[S][ks + 1]), *(const LAS bf16x8*)(stp + (ks + 1) * 32), acc1, 0, 0, 0); } \
            acc = acc + acc1; \
            if (role == 0) { \
                _Pragma("unroll") for (int q = 0; q < 4; ++q) { u32x2v w; \
                    w.x = cvtpk(__uint_as_float(RB[S][q][0]) - acc[4 * q], __uint_as_float(RB[S][q][1]) - acc[4 * q + 1]); w.y = cvtpk(__uint_as_float(RB[S][q][2]) - acc[4 * q + 2], __uint_as_float(RB[S][q][3]) - acc[4 * q + 3]); \
                    *(LAS u32x2v*)(lds + L_VN + (r32 * VP + 32 * rb + 8 * q + 4 * hi) * 2) = w; } } } \
        GDN_BAR(); \
        if (role == 1) { \
            _Pragma("unroll") for (int ks = 0; ks < 4; ++ks) acc = __builtin_amdgcn_mfma_f32_32x32x16_bf16(__builtin_bit_cast(bf16x8, RB[S][ks]), *(const LAS bf16x8*)(vnp + ks * 32), acc, 0, 0, 0); \
            bf16* og = OG + (size_t)(b * SEQ + i_ * 64 + 32 * rb) * 512 + h * 128 + 32 * s + r32; \
            _Pragma("unroll") for (int r = 0; r < 16; r += 2) { const unsigned pk = cvtpk(acc[r], acc[r + 1]); og[(size_t)crow(r, hi) * 512] = (bf16)(pk & 0xffffu); og[(size_t)crow(r + 1, hi) * 512] = (bf16)(pk >> 16); } \
        } else if (role == 2) { \
            Sacc = Sacc * RG[S]; \
            _Pragma("unroll") for (int ks = 0; ks < 4; ++ks) Sacc = __builtin_amdgcn_mfma_f32_32x32x16_bf16(__builtin_bit_cast(bf16x8, RB[S][ks]), *(const LAS bf16x8*)(vnp + ks * 32), Sacc, 0, 0, 0); \
            _Pragma("unroll") for (int q = 0; q < 4; ++q) { u32x2v w; w.x = cvtpk(Sacc[4 * q], Sacc[4 * q + 1]); w.y = cvtpk(Sacc[4 * q + 2], Sacc[4 * q + 3]); \
                *(LAS u32x2v*)(lds + L_ST + (r32 * SP + 32 * db + 8 * q + 4 * hi) * 2) = w; } } \
        GDN_BAR(); } while (0)
    SCAN_LOAD(0, 0); SCAN_LOAD(1, 1);
    GDN_BAR();
    for (int i = 0; i < 126; i += 3) { SCAN_STEP(0, 2, i); SCAN_STEP(1, 0, i + 1); SCAN_STEP(2, 1, i + 2); }
    SCAN_STEP(0, 2, 126); SCAN_STEP(1, 0, 127);
#undef SCAN_LOAD
#undef SCAN_STEP
}
}

struct Args { const float* in[19]; float* out; unsigned char* ws; };
__global__ void __launch_bounds__(NWAVES * 64, 2) mega_fwd(Args) {
    extern __shared__ __attribute__((aligned(16))) unsigned char lds[];
    cg::grid_group grid = cg::this_grid();
    Frame F;
    F.lds = (LAS unsigned char*)lds; F.MISC = (volatile LAS unsigned*)(F.lds + MISC_OFF);
    F.G = gridDim.x; { const int bx = blockIdx.x; F.vcu = (F.G % 8 == 0) ? (bx % 8) * (F.G / 8) + bx / 8 : bx; }
#define KARGP() const __attribute__((address_space(4))) unsigned long long* kp_ = (const __attribute__((address_space(4))) unsigned long long*)__builtin_amdgcn_kernarg_segment_ptr(); asm volatile("" : "+s"(kp_))
#define INP(k) ((const float*)(GAS const float*)(kp_[k]))
#define WSB ((unsigned char*)(GAS unsigned char*)(kp_[20]))
#define OUT ((float*)(GAS float*)(kp_[19]))
#define in_x INP(0)
#define attn_g INP(1)
#define w_in INP(2)
#define lq1 INP(3)
#define lk1 INP(4)
#define lq2 INP(5)
#define lk2 INP(6)
#define subln_g INP(7)
#define gconv_w INP(8)
#define a_log INP(9)
#define dt_bias INP(10)
#define gnorm_g INP(11)
#define w_out INP(12)
#define ffn_g INP(13)
#define w_up INP(14)
#define fconv_w INP(15)
#define fconv_b INP(16)
#define w_down INP(17)
#define final_g INP(18)
#define WinT ((bf16*)(WSB + WS_WIN))
#define WoT ((bf16*)(WSB + WS_WO))
#define WupT ((bf16*)(WSB + WS_WUP))
#define WdnT ((bf16*)(WSB + WS_WDN))
#define GAB ((float*)(WSB + WS_GAB))
#define HALO ((float*)(WSB + WS_HALO))
#define GL ((float*)(WSB + WS_GL))
#define XN ((bf16*)(WSB + WS_XN))
#define PREP (WSB + WS_PREP)
#define Gb ((bf16*)(WSB + WS_G))
#define PA ((bf16*)(WSB + WS_PA))
#define PGb ((bf16*)(WSB + WS_PG))
#define OATT ((bf16*)(WSB + WS_OATT))
#define OGb ((bf16*)(WSB + WS_OG))
#define X1 ((float*)(WSB + WS_X1))
#define CTLP ((gu32*)(GAS unsigned*)(kp_[20]))
    for (int u = threadIdx.x; u < (LDS_BYTES - MISC_OFF) / 4; u += NWAVES * 64) ((LAS unsigned*)(F.lds + MISC_OFF))[u] = 0u;
    __syncthreads();
    { KARGP(); (void)xcd_barrier_post((unsigned*)(CTLP + CW_BAR), F.MISC + 8); }
    grid.sync();
#ifdef TSTAMP
    if (blockIdx.x == 0 && threadIdx.x == 0) { KARGP(); ((unsigned long long*)(CTLP + 600))[0] = __builtin_amdgcn_s_memrealtime(); }
#endif
#define GRID_BAR() do { const __attribute__((address_space(4))) unsigned long long* kq_ = (const __attribute__((address_space(4))) unsigned long long*)__builtin_amdgcn_kernarg_segment_ptr(); asm volatile("" : "+s"(kq_)); \
        XcdBarrier b_; b_.bar = (unsigned*)(GAS unsigned*)(kq_[20]) + CW_BAR; b_.x = xb_xcc_id(); b_.st = F.MISC + 8; xcd_barrier(b_); } while (0)
#define PHASE_IDS() int tid = threadIdx.x; asm volatile("" : "+v"(tid)); const int lane = tid & 63, wave = __builtin_amdgcn_readfirstlane(tid >> 6); const int gw = F.vcu * NWAVES + wave, NGW = F.G * NWAVES; (void)lane; (void)gw; (void)NGW; KARGP()

    {
        PHASE_IDS();
        LAS float* scr = (LAS float*)(F.lds + wave * 16384);
        constexpr int I_IN = 112 * 16, I_O = 32 * 16, I_UP = 176 * 16, I_DN = 32 * 44, NITEMS = I_IN + I_O + I_UP + I_DN;
        for (int it = gw; it < NITEMS; it += NGW) {
            int r = it;
            if (r < I_IN) { const int nb = r % 112, kb = r / 112, n0 = 32 * nb; const int c0 = n0 < 1536 ? n0 : (n0 < 2048 ? 3080 + (n0 - 1536) : 1536 + (n0 - 2048));
                p0_transpose_item(w_in, NINP, c0, 64 * kb, WinT, n0, D, scr, lane); continue; } r -= I_IN;
            if (r < I_O) { const int nb = r % 32, kb = r / 32; p0_transpose_item(w_out, D, 32 * nb, 64 * kb, WoT, 32 * nb, D, scr, lane); continue; } r -= I_O;
            if (r < I_UP) { const int nb = r % 176, kb = r / 176; const int c0 = ((nb >> 2) & 1) * DFF + 128 * (nb >> 3) + 32 * (nb & 3);
                p0_transpose_item(w_up, NUP, c0, 64 * kb, WupT, 32 * nb, D, scr, lane); continue; } r -= I_UP;
            { const int nb = r % 32, kb = r / 32; p0_transpose_item(w_down, D, 32 * nb, 64 * kb, WdnT, 32 * nb, DFF, scr, lane); }
        }
        __syncthreads();
        LAS float* Wab = (LAS float*)F.lds;
        for (int i = tid; i < 2048; i += NWAVES * 64) { const int k = i >> 1, hf = i & 1; *(LAS f32x4*)(Wab + k * 8 + 4 * hf) = *(const f32x4*)(w_in + (size_t)k * NINP + 3072 + 4 * hf); }
        __syncthreads();
        for (int m = gw; m < M; m += NGW) {
            f32x4 v[4]; rms_row(in_x + (size_t)m * D, attn_g, lane, v);
            store_row_bf16(XN + (size_t)m * D, lane, v);
            float d8[8];
#pragma unroll
            for (int e = 0; e < 8; ++e) d8[e] = 0.f;
#pragma unroll
            for (int j = 0; j < 4; ++j)
#pragma unroll
                for (int q = 0; q < 4; ++q) { const int k = 4 * lane + 256 * j + q; const f32x4 wa = *(const LAS f32x4*)(Wab + k * 8), wb = *(const LAS f32x4*)(Wab + k * 8 + 4); const float hv = v[j][q];
                    d8[0] += hv * wa.x; d8[1] += hv * wa.y; d8[2] += hv * wa.z; d8[3] += hv * wa.w; d8[4] += hv * wb.x; d8[5] += hv * wb.y; d8[6] += hv * wb.z; d8[7] += hv * wb.w; }
#pragma unroll
            for (int e = 0; e < 8; ++e) d8[e] = wave_sum(d8[e]);
            if (lane == 0) { *(f32x4*)(GAB + (size_t)m * 8) = (f32x4){d8[0], d8[1], d8[2], d8[3]}; *(f32x4*)(GAB + (size_t)m * 8 + 4) = (f32x4){d8[4], d8[5], d8[6], d8[7]}; }
        }
    }
    GRID_BAR();
#ifdef TSTAMP
    if (blockIdx.x == 0 && threadIdx.x == 0) { KARGP(); ((unsigned long long*)(CTLP + 600))[1] = __builtin_amdgcn_s_memrealtime(); }
#endif
    {
        KARGP();
        pg8::Gemm g{XN, WinT, M, NPROJ, D}; pg8::StaticOrder S; S.init(M, NPROJ, F.G, (int)blockIdx.x);
        pg8::EpiProj E{PA, PGb, attn_body::C2};
        pg8::gemm_phase<pg8::EpiProj, pg8::StaticOrder, true, true>(F.lds, g, S, E);
    }
    GRID_BAR();
#ifdef TSTAMP
    if (blockIdx.x == 0 && threadIdx.x == 0) { KARGP(); ((unsigned long long*)(CTLP + 600))[2] = __builtin_amdgcn_s_memrealtime(); }
#endif
    { PHASE_IDS(); v4u raw[8]; gdn::prep_load(raw, tid, F.vcu, 0, PGb);
      for (int ch = F.vcu; ch < 1024; ch += F.G) gdn::prep_chunk(F.lds, tid, ch, ch + F.G, raw, PGb, GAB, gconv_w, a_log, dt_bias, PREP, GL);
      float mx0 = 0.f, mx1 = 0.f;
      for (int m0 = gw; m0 < M; m0 += 4 * NGW) {
          v4u r0[4], r1[4];
#pragma unroll
          for (int k = 0; k < 4; ++k) { const int m = m0 + k * NGW; const bool ok = m < M; const size_t o = (size_t)(ok ? m : gw) * 2048 + 16 * lane; r0[k] = *(const GAS v4u*)(PA + o); r1[k] = *(const GAS v4u*)(PA + o + 8); }
#pragma unroll
          for (int k = 0; k < 4; ++k) { const int m = m0 + k * NGW; float ss = 0.f;
#pragma unroll
              for (int q = 0; q < 4; ++q) { const float a0 = __uint_as_float(r0[k][q] << 16), a1 = __uint_as_float(r0[k][q] & 0xffff0000u), b0 = __uint_as_float(r1[k][q] << 16), b1 = __uint_as_float(r1[k][q] & 0xffff0000u); ss += a0 * a0 + a1 * a1 + b0 * b0 + b1 * b1; }
              ss += __shfl_xor(ss, 1); ss += __shfl_xor(ss, 2);
              if (m < M) { if ((m >> 13) == 0) mx0 = fmaxf(mx0, ss); else mx1 = fmaxf(mx1, ss); } } }
      if ((lane & 3) == 0) { atomicMax((unsigned*)(CTLP + CW_NORM + (lane >> 2)), __float_as_uint(mx0)); atomicMax((unsigned*)(CTLP + CW_NORM + 16 + (lane >> 2)), __float_as_uint(mx1)); }
    }
    GRID_BAR();
#ifdef TSTAMP
    if (blockIdx.x == 0 && threadIdx.x == 0) { KARGP(); ((unsigned long long*)(CTLP + 600))[3] = __builtin_amdgcn_s_memrealtime(); }
#endif
    {
        PHASE_IDS();
        if ((int)blockIdx.x >= F.G - 32) { const int si = (int)blockIdx.x - (F.G - 32); gdn::scan(F.lds, tid, si >> 2, si & 3, PREP, GL, OGb); }
        for (;;) {
            if (tid == 0) F.MISC[4] = __hip_atomic_fetch_add(CTLP + CW_QUEUE, 1u, __ATOMIC_RELAXED, __HIP_MEMORY_SCOPE_AGENT);
            __syncthreads();
            const int u = (int)F.MISC[4];
            __syncthreads();
            if (u >= 1024) break;
            const int qb = 31 - (u >> 5), vhd = u & 31; const int ab = vhd >> 4, ah = (vhd >> 2) & 3, ac = (vhd >> 1) & 1;
            int tsk = 0;
            { const float q2 = __uint_as_float(__hip_atomic_load((const unsigned*)(CTLP + CW_NORM + ab * 16 + ah * 2 + ac), __ATOMIC_RELAXED, __HIP_MEMORY_SCOPE_AGENT));
              const float k2 = __uint_as_float(__hip_atomic_load((const unsigned*)(CTLP + CW_NORM + ab * 16 + 8 + ah * 2 + ac), __ATOMIC_RELAXED, __HIP_MEMORY_SCOPE_AGENT));
              const float smax = sqrtf(q2 * k2) * 1.001f, sl2 = exp2f(-2.0f * (float)(ah + 1)) * 1.4426950408889634f;
              const float xk = (float)(256 * qb - 63) - (2.0f * smax + 40.0f) / sl2;
              if (xk >= 0.f) { tsk = ((int)(xk * (1.0f / 64.0f)) + 1) & ~1; if (tsk > 4 * qb) tsk = 4 * qb; }
              tsk = __builtin_amdgcn_readfirstlane(tsk); }
            attn_body::attn_unit<32>(ab, ah, ac, vhd & 1, qb, tsk, (const attn_body::bf16*)PA, (attn_body::bf16*)OATT, (char*)lds);
        }
    }
    GRID_BAR();
#ifdef TSTAMP
    if (blockIdx.x == 0 && threadIdx.x == 0) { KARGP(); ((unsigned long long*)(CTLP + 600))[4] = __builtin_amdgcn_s_memrealtime(); }
#endif
    {
        PHASE_IDS();
        float s1 = lq1[lane] * lk1[lane], s2 = lq2[lane] * lk2[lane];
        const float lam = __expf(wave_sum(s1)) - __expf(wave_sum(s2)) + 0.2f;
        const int a0 = 8 * lane, dd = 8 * (lane & 15);
        float sg[8], gg[8];
#pragma unroll
        for (int e = 0; e < 8; ++e) { sg[e] = subln_g[dd + e] * 0.8f; gg[e] = gnorm_g[dd + e]; }
        for (int m = gw; m < M; m += NGW) {
            const v4u o0 = *(const GAS v4u*)(OATT + (size_t)m * 1024 + a0), o1 = *(const GAS v4u*)(OATT + (size_t)m * 1024 + 512 + a0);
            const v4u og = *(const GAS v4u*)(OGb + (size_t)m * 512 + a0), zz = *(const GAS v4u*)(PA + (size_t)m * 2048 + 1536 + a0);
            float oa[8], ob[8], zf[8]; float ssa = 0.f, ssb = 0.f;
#pragma unroll
            for (int q = 0; q < 4; ++q) {
                oa[2 * q] = __uint_as_float(o0[q] << 16) - lam * __uint_as_float(o1[q] << 16); oa[2 * q + 1] = __uint_as_float(o0[q] & 0xffff0000u) - lam * __uint_as_float(o1[q] & 0xffff0000u);
                ob[2 * q] = __uint_as_float(og[q] << 16); ob[2 * q + 1] = __uint_as_float(og[q] & 0xffff0000u);
                zf[2 * q] = __uint_as_float(zz[q] << 16); zf[2 * q + 1] = __uint_as_float(zz[q] & 0xffff0000u);
            }
#pragma unroll
            for (int e = 0; e < 8; ++e) { ssa += oa[e] * oa[e]; ssb += ob[e] * ob[e]; }
#pragma unroll
            for (int o = 1; o < 16; o <<= 1) { ssa += __shfl_xor(ssa, o); ssb += __shfl_xor(ssb, o); }
            const float ra = 1.0f / sqrtf(ssa * (1.f / 128.f) + EPS), rb = 1.0f / sqrtf(ssb * (1.f / 128.f) + EPS);
            float ya[8], yb[8];
#pragma unroll
            for (int e = 0; e < 8; ++e) { ya[e] = oa[e] * ra * sg[e]; yb[e] = ob[e] * rb * gg[e] * pg8::silu_f(zf[e]); }
            *(GAS v4u*)(XN + (size_t)m * 1024 + a0) = (v4u){cvtpk(ya[0], ya[1]), cvtpk(ya[2], ya[3]), cvtpk(ya[4], ya[5]), cvtpk(ya[6], ya[7])};
            *(GAS v4u*)(XN + (size_t)m * 1024 + 512 + a0) = (v4u){cvtpk(yb[0], yb[1]), cvtpk(yb[2], yb[3]), cvtpk(yb[4], yb[5]), cvtpk(yb[6], yb[7])};
        }
    }
    GRID_BAR();
#ifdef TSTAMP
    if (blockIdx.x == 0 && threadIdx.x == 0) { KARGP(); ((unsigned long long*)(CTLP + 600))[5] = __builtin_amdgcn_s_memrealtime(); }
#endif
    {
        KARGP();
        pg8::Gemm g{XN, WoT, M, D, D}; pg8::StaticOrder S; S.init(M, D, F.G, (int)blockIdx.x);
        pg8::EpiResF32 E{in_x, X1, D};
        pg8::gemm_phase<pg8::EpiResF32, pg8::StaticOrder, true, true>(F.lds, g, S, E);
    }
    GRID_BAR();
#ifdef TSTAMP
    if (blockIdx.x == 0 && threadIdx.x == 0) { KARGP(); ((unsigned long long*)(CTLP + 600))[6] = __builtin_amdgcn_s_memrealtime(); }
#endif
    { PHASE_IDS(); for (int m = gw; m < M; m += NGW) { f32x4 v[4]; rms_row(X1 + (size_t)m * D, ffn_g, lane, v); store_row_bf16(XN + (size_t)m * D, lane, v); } }
    GRID_BAR();
#ifdef TSTAMP
    if (blockIdx.x == 0 && threadIdx.x == 0) { KARGP(); ((unsigned long long*)(CTLP + 600))[7] = __builtin_amdgcn_s_memrealtime(); }
#endif
    {
        KARGP();
        pg8::Gemm g{XN, WupT, M, NUP, D}; pg8::StaticOrder S; S.init(M, NUP, F.G, (int)blockIdx.x);
        pg8::EpiConvGLU E{Gb, fconv_w, fconv_b, HALO, (PG8_LAS float*)(F.lds + XH_OFF)};
        pg8::gemm_phase<pg8::EpiConvGLU, pg8::StaticOrder, true, true>(F.lds, g, S, E);
    }
    GRID_BAR();
#ifdef TSTAMP
    if (blockIdx.x == 0 && threadIdx.x == 0) { KARGP(); ((unsigned long long*)(CTLP + 600))[8] = __builtin_amdgcn_s_memrealtime(); }
#endif
    {
        PHASE_IDS();
        const int gt = blockIdx.x * (NWAVES * 64) + tid, NT = F.G * NWAVES * 64;
        for (int it = gt; it < 64 * DFF; it += NT) {
            const int pm = it / DFF, c = it % DFF; if ((pm & 31) == 0) continue;
            const int j = c >> 7, i = c & 127, cg_ = 256 * j + i, cv_ = cg_ + 128;
            const float* hp = HALO + (size_t)(pm - 1) * 4 * NUP; const float* hc = HALO + (size_t)pm * 4 * NUP;
            const float gm2 = hp[2 * NUP + cg_], gm1 = hp[3 * NUP + cg_], g0 = hc[cg_], g1 = hc[NUP + cg_];
            const float vm2 = hp[2 * NUP + cv_], vm1 = hp[3 * NUP + cv_], v0 = hc[cv_], v1 = hc[NUP + cv_];
            const float wg0 = fconv_w[c], wg1 = fconv_w[NUP + c], wg2 = fconv_w[2 * NUP + c], bg = fconv_b[c];
            const float wv0 = fconv_w[DFF + c], wv1 = fconv_w[NUP + DFF + c], wv2 = fconv_w[2 * NUP + DFF + c], bv = fconv_b[DFF + c];
            const float ug0 = wg0 * gm2 + wg1 * gm1 + wg2 * g0 + bg, ug1 = wg0 * gm1 + wg1 * g0 + wg2 * g1 + bg;
            const float uv0 = wv0 * vm2 + wv1 * vm1 + wv2 * v0 + bv, uv1 = wv0 * vm1 + wv1 * v0 + wv2 * v1 + bv;
            Gb[(size_t)(pm * 256) * DFF + c] = (bf16)f2bf(pg8::silu_f(ug0) * uv0);
            Gb[(size_t)(pm * 256 + 1) * DFF + c] = (bf16)f2bf(pg8::silu_f(ug1) * uv1);
        }
    }
    GRID_BAR();
#ifdef TSTAMP
    if (blockIdx.x == 0 && threadIdx.x == 0) { KARGP(); ((unsigned long long*)(CTLP + 600))[9] = __builtin_amdgcn_s_memrealtime(); }
#endif
    {
        KARGP();
        pg8::Gemm g{Gb, WdnT, M, D, DFF}; pg8::StaticOrder S; S.init(M, D, F.G, (int)blockIdx.x);
        pg8::EpiResF32 E{X1, OUT, D};
        pg8::gemm_phase<pg8::EpiResF32, pg8::StaticOrder, true, true>(F.lds, g, S, E);
    }
    GRID_BAR();
#ifdef TSTAMP
    if (blockIdx.x == 0 && threadIdx.x == 0) { KARGP(); ((unsigned long long*)(CTLP + 600))[10] = __builtin_amdgcn_s_memrealtime(); }
#endif
    { PHASE_IDS();
    for (int m = gw; m < M; m += NGW) {
        f32x4 v[4]; rms_row(OUT + (size_t)m * D, final_g, lane, v);
        GAS f32x4* o = (GAS f32x4*)(OUT + (size_t)m * D) + lane;
#pragma unroll
        for (int j = 0; j < 4; ++j) o[64 * j] = v[j];
    } }

#ifdef TSTAMP
    GRID_BAR();
    if (blockIdx.x == 0 && threadIdx.x == 0) { KARGP(); const unsigned long long* ts = (const unsigned long long*)(CTLP + 600); const unsigned long long tend = __builtin_amdgcn_s_memrealtime();
        const unsigned long long t1 = (TSTAMP + 1 > 10) ? tend : ts[TSTAMP + 1]; float us = (float)(t1 - ts[TSTAMP]) * 0.01f;
        float q = 1.f; while (us >= 100.f) { us *= 0.1f; q *= 10.f; } us = floorf(us + 0.5f) * q;
        OUT[0] = us; }
#endif
}

extern "C" void kernel_launch(void* const* d_in, const int* in_sizes, int n_in, void* d_out, int out_size, void* d_ws, size_t ws_size, hipStream_t stream) {
    static int grid = 0;
    if (grid == 0) {
        if (n_in != 19 || ws_size < WS_END) { fprintf(stderr, "kernel_launch: unexpected inputs (n_in %d, ws %zu)\n", n_in, ws_size); grid = -1; return; }
        int dev = 0, cus = 0, per_cu = 0;
        hipGetDevice(&dev); hipDeviceGetAttribute(&cus, hipDeviceAttributeMultiprocessorCount, dev);
        hipFuncSetAttribute((const void*)mega_fwd, hipFuncAttributeMaxDynamicSharedMemorySize, LDS_BYTES);
        hipOccupancyMaxActiveBlocksPerMultiprocessor(&per_cu, (const void*)mega_fwd, NWAVES * 64, LDS_BYTES);
        (void)hipGetLastError();
        if (per_cu < 1) per_cu = 1;
        grid = cus;
        if (grid > 256) grid = 256;
    }
    if (grid < 0) return;
    hipMemsetAsync((char*)d_ws + WS_CTL, 0, CTL_ZERO_BYTES, stream);
    Args a{};
    for (int i = 0; i < 19; ++i) a.in[i] = (const float*)d_in[i];
    a.out = (float*)d_out; a.ws = (unsigned char*)d_ws;
    void* kargs[] = {&a};
    hipError_t e = hipLaunchCooperativeKernel((const void*)mega_fwd, dim3(grid), dim3(NWAVES * 64), kargs, LDS_BYTES, stream);
    if (e != hipSuccess) fprintf(stderr, "cooperative launch failed: %s (grid %d)\n", hipGetErrorString(e), grid);
}
```
